# Optimizing an MI355X kernel written in HIP

```python
import math
import jax, jax.numpy as jnp
from jax import lax
import numpy as np

D_MODEL = 1024
BATCH = 8
SEQ = 4096
DEPTH = 4

HEAD_DIM = 64
D_ATTN = D_MODEL // 2
ATTN_HEADS = D_ATTN // HEAD_DIM
Q_BLOCK = 128
D_CONV = D_MODEL // 4
CONV_K = 3
D_POOL = D_MODEL // 4
POOL_WINDOWS = (2, 4, 8, 16)
POOL_GROUPS = len(POOL_WINDOWS)
POOL_GROUP_DIM = D_POOL // POOL_GROUPS
POOL_OUT_DIM = D_MODEL // POOL_GROUPS
N_BRANCHES = 3
D_FF = -(-8 * D_MODEL // (3 * 256)) * 256
EPS = 1e-6

IN_SIZES = (D_ATTN, D_ATTN, D_ATTN, ATTN_HEADS, D_CONV, D_CONV, D_CONV, D_POOL, N_BRANCHES * D_MODEL)
D_IN = sum(IN_SIZES)
IN_SPLITS = tuple(int(v) for v in np.cumsum(IN_SIZES)[:-1])

kernel_name = "fox_conv_pool_gated_hybrid"


def rmsnorm(x, g):
    xf = x.astype(jnp.float32)
    y = xf * lax.rsqrt(jnp.mean(xf * xf, axis=-1, keepdims=True) + EPS)
    return (y * g.astype(jnp.float32)).astype(x.dtype)


def forgetting_attention(q, k, v, logf):
    S = q.shape[2]
    c = jnp.cumsum(logf, axis=-1)
    scale = HEAD_DIM ** -0.5
    outs = []
    for i in range(S // Q_BLOCK):
        q0, q1 = i * Q_BLOCK, (i + 1) * Q_BLOCK
        qb = q[:, :, q0:q1]
        kb = k[:, :, :q1]
        vb = v[:, :, :q1]
        logits = jnp.einsum('bhqd,bhkd->bhqk', qb, kb, preferred_element_type=jnp.float32) * scale
        logits = logits + (c[:, :, q0:q1, None] - c[:, :, None, :q1])
        causal = (q0 + jnp.arange(Q_BLOCK))[:, None] >= jnp.arange(q1)[None, :]
        logits = jnp.where(causal, logits, -jnp.inf)
        p = jax.nn.softmax(logits, axis=-1)
        outs.append(jnp.einsum('bhqk,bhkd->bhqd', p.astype(vb.dtype), vb))
    return jnp.concatenate(outs, axis=2)


def short_conv_mixer(u, b_gate, c_gate, w):
    S = u.shape[1]
    z = c_gate * u
    zp = jnp.pad(z, ((0, 0), (CONV_K - 1, 0), (0, 0)))
    conv = w[0] * zp[:, 0:S]
    for j in range(1, CONV_K):
        conv = conv + w[j] * zp[:, j:j + S]
    return b_gate * conv


def pooling_mixer(u, w_grp, scale):
    Bsz, S, _ = u.shape
    uf = u.astype(jnp.float32)
    cs = jnp.cumsum(uf, axis=1)
    t = jnp.arange(S, dtype=jnp.float32)
    groups = []
    for g, w in enumerate(POOL_WINDOWS):
        sl = slice(g * POOL_GROUP_DIM, (g + 1) * POOL_GROUP_DIM)
        csg = cs[:, :, sl]
        lagged = jnp.pad(csg[:, :S - w], ((0, 0), (w, 0), (0, 0)))
        counts = jnp.minimum(t + 1.0, float(w))[None, :, None]
        groups.append((csg - lagged) / counts - uf[:, :, sl])
    d = jnp.stack(groups, axis=2).astype(u.dtype)
    out = jnp.einsum('bsgc,gcd->bsgd', d, w_grp).reshape(Bsz, S, D_MODEL)
    return out * scale


def setup_inputs(seed: int = 0) -> dict:
    key = jax.random.key(seed)
    ks = jax.random.split(key, 16)
    nrm = lambda k, shape, fan_in: jax.random.normal(k, shape, jnp.float32) * (fan_in ** -0.5)
    return {
        "x": jax.random.normal(ks[0], (BATCH, SEQ, D_MODEL), jnp.float32),
        "norm_mix_g": 1.0 + 0.02 * jax.random.normal(ks[1], (DEPTH, D_MODEL), jnp.float32),
        "w_in": nrm(ks[2], (DEPTH, D_MODEL, D_IN), D_MODEL),
        "forget_b": jax.random.uniform(ks[3], (DEPTH, ATTN_HEADS), jnp.float32, 2.0, 5.0),
        "q_norm_g": 1.0 + 0.02 * jax.random.normal(ks[4], (DEPTH, HEAD_DIM), jnp.float32),
        "k_norm_g": 1.0 + 0.02 * jax.random.normal(ks[5], (DEPTH, HEAD_DIM), jnp.float32),
        "w_attn_out": nrm(ks[6], (DEPTH, D_ATTN, D_MODEL), D_ATTN),
        "conv_w": nrm(ks[7], (DEPTH, CONV_K, D_CONV), CONV_K),
        "w_conv_out": nrm(ks[8], (DEPTH, D_CONV, D_MODEL), D_CONV),
        "pool_w": nrm(ks[9], (DEPTH, POOL_GROUPS, POOL_GROUP_DIM, POOL_OUT_DIM), POOL_GROUP_DIM),
        "pool_scale": 1.0 + 0.1 * jax.random.normal(ks[10], (DEPTH, D_MODEL), jnp.float32),
        "w_o": nrm(ks[11], (DEPTH, D_MODEL, D_MODEL), D_MODEL),
        "norm_ffn_g": 1.0 + 0.02 * jax.random.normal(ks[12], (DEPTH, D_MODEL), jnp.float32),
        "w_ffn_in": nrm(ks[13], (DEPTH, D_MODEL, 2 * D_FF), D_MODEL),
        "w_ffn_out": nrm(ks[14], (DEPTH, D_FF, D_MODEL), D_FF),
    }


def reference(x, norm_mix_g, w_in, forget_b, q_norm_g, k_norm_g, w_attn_out, conv_w,
              w_conv_out, pool_w, pool_scale, w_o, norm_ffn_g, w_ffn_in, w_ffn_out):
    Bsz, S, _ = x.shape

    def heads(t):
        return t.reshape(Bsz, S, ATTN_HEADS, HEAD_DIM).transpose(0, 2, 1, 3)

    for l in range(DEPTH):
        h = rmsnorm(x, norm_mix_g[l])
        proj = h @ w_in[l]
        q, k, v, f_logit, cx, cb, cc, px, gate_logit = jnp.split(proj, IN_SPLITS, axis=-1)

        qh = rmsnorm(heads(q), q_norm_g[l])
        kh = rmsnorm(heads(k), k_norm_g[l])
        vh = heads(v)
        logf = jax.nn.log_sigmoid((f_logit + forget_b[l]).astype(jnp.float32)).transpose(0, 2, 1)
        a = forgetting_attention(qh, kh, vh, logf).transpose(0, 2, 1, 3).reshape(Bsz, S, D_ATTN)
        y_attn = a @ w_attn_out[l]

        y_conv = short_conv_mixer(cx, cb, cc, conv_w[l]) @ w_conv_out[l]

        y_pool = pooling_mixer(px, pool_w[l], pool_scale[l])

        g = jax.nn.sigmoid(gate_logit).reshape(Bsz, S, N_BRANCHES, D_MODEL)
        merged = g[:, :, 0] * y_attn + g[:, :, 1] * y_conv + g[:, :, 2] * y_pool
        x = x + merged @ w_o[l]

        h = rmsnorm(x, norm_ffn_g[l])
        gt, up = jnp.split(h @ w_ffn_in[l], 2, axis=-1)
        x = x + (jax.nn.silu(gt) * up) @ w_ffn_out[l]
    return x
```

```cpp
#include <hip/hip_runtime.h>
#include <hip/hip_cooperative_groups.h>
#include <hip/hip_bf16.h>
#include <cstdio>
#include <cstdint>
#include <cmath>
namespace cg = cooperative_groups;

#ifndef PHM
#define PHM 0xff
#endif
constexpr int NB = 8, SEQ_ = 4096, DMODEL = 1024, NLAYER = 4;
constexpr int MTOK = NB * SEQ_;
constexpr int DATT = 512, NHEADS = 8, DCONV = 256, DPOOL = 256, DFF = 2816;
constexpr int DIN_SRC = 5640;
constexpr int NIN = 5632;
constexpr float EPSN = 1e-6f;
constexpr float LOG2E = 1.4426950408889634f;
constexpr float QSCALE = 0.125f * LOG2E;

__device__ __forceinline__ int opaque_i(int v) { asm volatile("" : "+v"(v)); return v; }
namespace pg8 {
#define PG8_LAS __attribute__((address_space(3)))
typedef unsigned short bf16_t;
typedef short bf16x8 __attribute__((ext_vector_type(8)));
typedef float f32x4 __attribute__((ext_vector_type(4)));
typedef unsigned u32x4 __attribute__((ext_vector_type(4)));
constexpr int BM = 256, BK = 64, HALF = 128, HTB = HALF * BK * 2, STAGE_BYTES = 8 * HTB, NXCD = 8, WGM = 8;

__host__ __device__ __forceinline__ int lds_byte(int r, int c) { const int st = (r >> 4) * 2 + (c >> 5), rr = r & 15, cc = c & 31, ob = rr * 64 + cc * 2; return st * 1024 + (ob ^ (((ob >> 9) & 1) << 5)); }
__host__ __device__ __forceinline__ void stage_rc(int b, int& R, int& C) { const int st = b / 1024, sb = b % 1024, swz = sb ^ (((sb >> 9) & 1) << 5); R = (st >> 1) * 16 + swz / 64; C = (st & 1) * 32 + (swz % 64) / 2; }
__host__ __device__ __forceinline__ int perm32(int rho) { const int n = rho >> 4, i = rho & 15; return 8 * (i >> 2) + 4 * n + (i & 3); }

struct Unit { int pm, pn, sub; };
struct UMem { const char* A; const char* B; int nt; };

template <int NSUB> struct StaticOrder {
    int nM, nN, nwg, G, c;
    __device__ void init(int M, int N, int G_, int c_) { nM = M / BM; nN = N / BM; nwg = nM * nN; G = G_; c = c_; }
    __device__ bool next(int i, Unit& u) const {
        const int it = i / NSUB; u.sub = i - it * NSUB;
        const long L = (long)it * G + c; if (L >= nwg) return false;
        int wgid = (int)L; { const int q = nwg / NXCD, r = nwg % NXCD, xcd = wgid % NXCD, off = wgid / NXCD; wgid = (xcd < r ? xcd * (q + 1) : r * (q + 1) + (xcd - r) * q) + off; }
        const int nig = WGM * nN, gid = wgid / nig, fm = gid * WGM, gsz = (nM - fm) < WGM ? (nM - fm) : WGM;
        u.pm = fm + ((wgid % nig) % gsz); u.pn = (wgid % nig) / gsz; return true;
    }
};

__device__ __forceinline__ unsigned cvt_pk_bf16(float lo, float hi) { unsigned r; asm volatile("v_cvt_pk_bf16_f32 %0, %1, %2" : "=v"(r) : "v"(lo), "v"(hi)); return r; }
__device__ __forceinline__ f32x4 bf_lo4(unsigned a, unsigned b) { return (f32x4){__uint_as_float(a << 16), __uint_as_float(a & 0xffff0000u), __uint_as_float(b << 16), __uint_as_float(b & 0xffff0000u)}; }
__device__ __forceinline__ u32x4 pack8(f32x4 v0, f32x4 v1) { u32x4 w; w.x = cvt_pk_bf16(v0[0], v0[1]); w.y = cvt_pk_bf16(v0[2], v0[3]); w.z = cvt_pk_bf16(v1[0], v1[1]); w.w = cvt_pk_bf16(v1[2], v1[3]); return w; }
__device__ __forceinline__ float row_ssq(const float* p, int row) { const f32x4* q = (const f32x4*)(p + (size_t)row * 16); const f32x4 s = (q[0] + q[1]) + (q[2] + q[3]); return (s[0] + s[1]) + (s[2] + s[3]); }
__device__ __forceinline__ float fast_sigmoid(float v) { return __builtin_amdgcn_rcpf(1.0f + __expf(-v)); }


struct EpiInProj {
    const float* ssq; const float* qg; const float* kg; bf16_t* Q; bf16_t* Kb; bf16_t* V; bf16_t* CP; bf16_t* G;
    __device__ __forceinline__ bool keep(const Unit&) const { return false; }
    __device__ __forceinline__ void operator()(f32x4 (&acc)[2][2][4][2], const Unit& u, int wr, int wc, int fr, int fq) const {
        const int pn = u.pn; bf16_t* base; int ld, colt, mode; float post = 1.f; const float* gain = qg;
        if (pn < 2) { base = Q; ld = 512; colt = pn * 256; mode = 1; post = QSCALE; gain = qg; }
        else if (pn < 4) { base = Kb; ld = 512; colt = (pn - 2) * 256; mode = 1; gain = kg; }
        else if (pn < 6) { base = V; ld = 512; colt = (pn - 4) * 256; mode = 0; }
        else if (pn < 10) { base = CP; ld = 1024; colt = (pn - 6) * 256; mode = 0; }
        else { base = G; ld = 3072; colt = (pn - 10) * 256; mode = 2; }
        const int row0 = u.pm * BM + wr * 64 + fr, colw = colt + 64 * wc + 8 * fq;
        f32x4 gv[2][2];
#pragma unroll
        for (int bj = 0; bj < 2; ++bj)
#pragma unroll
            for (int n = 0; n < 2; ++n) gv[bj][n] = *(const f32x4*)(gain + 32 * bj + 8 * fq + 4 * n) * post;
#pragma unroll
        for (int ai = 0; ai < 2; ++ai)
#pragma unroll
            for (int m = 0; m < 4; ++m) {
                const int row = row0 + ai * HALF + m * 16;
                const float r = rsqrtf(row_ssq(ssq, row) * (1.0f / 1024.0f) + EPSN);
                f32x4 v[2][2];
#pragma unroll
                for (int bj = 0; bj < 2; ++bj)
#pragma unroll
                    for (int n = 0; n < 2; ++n) v[bj][n] = acc[ai][bj][m][n] * r;
                if (mode == 1) {
                    float s = 0.f;
#pragma unroll
                    for (int bj = 0; bj < 2; ++bj)
#pragma unroll
                        for (int n = 0; n < 2; ++n) { const f32x4 x = v[bj][n]; s += (x[0] * x[0] + x[1] * x[1]) + (x[2] * x[2] + x[3] * x[3]); }
                    s += __shfl_xor(s, 16); s += __shfl_xor(s, 32);
                    const float rn = rsqrtf(s * (1.0f / 64.0f) + EPSN);
#pragma unroll
                    for (int bj = 0; bj < 2; ++bj)
#pragma unroll
                        for (int n = 0; n < 2; ++n) v[bj][n] = v[bj][n] * rn * gv[bj][n];
                } else if (mode == 2) {
#pragma unroll
                    for (int bj = 0; bj < 2; ++bj)
#pragma unroll
                        for (int n = 0; n < 2; ++n) { f32x4 x = v[bj][n];
                            x[0] = fmaxf(fast_sigmoid(x[0]), 1e-20f); x[1] = fmaxf(fast_sigmoid(x[1]), 1e-20f); x[2] = fmaxf(fast_sigmoid(x[2]), 1e-20f); x[3] = fmaxf(fast_sigmoid(x[3]), 1e-20f); v[bj][n] = x; }
                }
                bf16_t* rowp = base + (size_t)row * ld + colw;
#pragma unroll
                for (int bj = 0; bj < 2; ++bj) *(u32x4*)(rowp + 32 * bj) = pack8(v[bj][0], v[bj][1]);
            }
    }
};

struct EpiMerge {
    const bf16_t* G; bf16_t* Mg;
    __device__ __forceinline__ bool keep(const Unit& u) const { return u.sub < 2; }
    __device__ __forceinline__ void operator()(f32x4 (&acc)[2][2][4][2], const Unit& u, int wr, int wc, int fr, int fq) const {
        const int row0 = u.pm * BM + wr * 64 + fr, col0 = u.pn * BM + wc * 32 + 8 * fq, sub = u.sub;
#pragma unroll
        for (int ai = 0; ai < 2; ++ai)
#pragma unroll
            for (int m = 0; m < 4; ++m) {
                const int row = row0 + ai * HALF + m * 16;
                const bf16_t* gp = G + (size_t)row * 3072 + col0 + (sub == 0 ? 0 : sub == 1 ? 1024 : 2048);
#pragma unroll
                for (int bj = 0; bj < 2; ++bj) {
                    const u32x4 ga = *(const u32x4*)(gp + bj * HALF);
                    f32x4 f0 = bf_lo4(ga.x, ga.y), f1 = bf_lo4(ga.z, ga.w);
                    if (sub < 2) {
                        const u32x4 gb = *(const u32x4*)(gp + 1024 + bj * HALF);
                        const f32x4 d0 = bf_lo4(gb.x, gb.y), d1 = bf_lo4(gb.z, gb.w);
#pragma unroll
                        for (int j = 0; j < 4; ++j) { f0[j] *= __builtin_amdgcn_rcpf(d0[j]); f1[j] *= __builtin_amdgcn_rcpf(d1[j]); }
                        acc[ai][bj][m][0] *= f0; acc[ai][bj][m][1] *= f1;
                    } else {
                        *(u32x4*)(Mg + (size_t)row * 1024 + col0 + bj * HALF) = pack8(acc[ai][bj][m][0] * f0, acc[ai][bj][m][1] * f1);
                    }
                }
            }
    }
};

struct EpiResid {
    const float* base; float* out; bf16_t* XB; float* ssq_next;
    __device__ __forceinline__ bool keep(const Unit&) const { return false; }
    __device__ __forceinline__ void operator()(f32x4 (&acc)[2][2][4][2], const Unit& u, int wr, int wc, int fr, int fq) const {
        const int row0 = u.pm * BM + wr * 64 + fr, col0 = u.pn * BM + wc * 32 + 8 * fq;
#pragma unroll
        for (int ai = 0; ai < 2; ++ai)
#pragma unroll
            for (int m = 0; m < 4; ++m) {
                const int row = row0 + ai * HALF + m * 16; const size_t off = (size_t)row * 1024 + col0;
                float s = 0.f;
#pragma unroll
                for (int bj = 0; bj < 2; ++bj) {
                    const f32x4 x0 = *(const f32x4*)(base + off + bj * HALF) + acc[ai][bj][m][0];
                    const f32x4 x1 = *(const f32x4*)(base + off + bj * HALF + 4) + acc[ai][bj][m][1];
                    *(f32x4*)(out + off + bj * HALF) = x0; *(f32x4*)(out + off + bj * HALF + 4) = x1;
                    *(u32x4*)(XB + off + bj * HALF) = pack8(x0, x1);
                    s += (x0[0] * x0[0] + x0[1] * x0[1]) + (x0[2] * x0[2] + x0[3] * x0[3]) + (x1[0] * x1[0] + x1[1] * x1[1]) + (x1[2] * x1[2] + x1[3] * x1[3]);
                }
                if (ssq_next) { s += __shfl_xor(s, 16); s += __shfl_xor(s, 32); if (fq == 0) ssq_next[(size_t)row * 16 + u.pn * 4 + wc] = s; }
            }
    }
};

struct EpiSwiGLU {
    const float* ssq; bf16_t* ACT;
    __device__ __forceinline__ bool keep(const Unit&) const { return false; }
    __device__ __forceinline__ void operator()(f32x4 (&acc)[2][2][4][2], const Unit& u, int wr, int wc, int fr, int fq) const {
        const int row0 = u.pm * BM + wr * 64 + fr, col0 = u.pn * HALF + wc * 32 + 8 * fq;
#pragma unroll
        for (int ai = 0; ai < 2; ++ai)
#pragma unroll
            for (int m = 0; m < 4; ++m) {
                const int row = row0 + ai * HALF + m * 16;
                const float r = rsqrtf(row_ssq(ssq, row) * (1.0f / 1024.0f) + EPSN);
                f32x4 o[2];
#pragma unroll
                for (int n = 0; n < 2; ++n) { const f32x4 g = acc[ai][0][m][n] * r, up = acc[ai][1][m][n] * r;
#pragma unroll
                    for (int j = 0; j < 4; ++j) o[n][j] = g[j] * fast_sigmoid(g[j]) * up[j]; }
                *(u32x4*)(ACT + (size_t)row * DFF + col0) = pack8(o[0], o[1]);
            }
    }
};

struct ProbSimple { const char* A; const char* B; int lda, ldb, nt;
    __device__ __forceinline__ UMem mem(const Unit& u) const { UMem m; m.A = A + (size_t)u.pm * BM * lda * 2; m.B = B + (size_t)u.pn * BM * ldb * 2; m.nt = nt; return m; } };
struct ProbMerge { const char* O; const char* CZ; const char* WM; int lda, ldb;
    __device__ __forceinline__ UMem mem(const Unit& u) const { UMem m; const size_t ar = (size_t)u.pm * BM * 512 * 2, br = (size_t)u.pn * BM * 896 * 2;
        if (u.sub == 0) { m.A = O + ar; m.B = WM + br; m.nt = 8; }
        else if (u.sub == 1) { m.A = CZ + ar; m.B = WM + br + 512 * 2; m.nt = 4; }
        else { m.A = CZ + ar + (256 + 128 * (u.pn >> 1)) * 2; m.B = WM + br + 768 * 2; m.nt = 2; }
        return m; } };

template <class Prob, class Epi, class Sched, bool ALIGN_EPI, bool SP2>
__device__ __forceinline__ void gemm_phase(PG8_LAS unsigned char* lds, const Prob& P, const Sched& S, const Epi& E) {
    const int tid = opaque_i(threadIdx.x), wid = __builtin_amdgcn_readfirstlane(tid >> 6), lane = tid & 63, wr = wid >> 2, wc = wid & 3, fr = lane & 15, fq = lane >> 4;
    unsigned voffA[2], voffB[2];
#pragma unroll
    for (int i = 0; i < 2; ++i) { int R, C; stage_rc(tid * 16 + i * 8192, R, C); const int Rb = (R & ~31) + perm32(R & 31);
        voffA[i] = (unsigned)(R * P.lda + C) * 2u; voffB[i] = (unsigned)(Rb * P.ldb + C) * 2u; }
    const size_t kstep = (size_t)(BK * 2);
    const size_t hstepA = (size_t)HALF * P.lda * 2, hstepB = (size_t)HALF * P.ldb * 2;
    const unsigned ldsw = (unsigned)wid * 1024u;
    const int aoff = lds_byte(wr * 64 + fr, fq * 8), boff = lds_byte(wc * 32 + fr, fq * 8);
#define PG8_SA(b, h) (((b) * 2 + (h)) * HTB)
#define PG8_SB(b, h) ((4 + (b) * 2 + (h)) * HTB)
#define PG8_STAGE(bufoff, gbase, voff) do { _Pragma("unroll") for (int _i = 0; _i < 2; ++_i) \
        __builtin_amdgcn_global_load_lds((const unsigned*)((const char*)(gbase) + (voff)[_i]), (PG8_LAS unsigned*)(lds + (bufoff) + ldsw + _i * 8192), 16, 0, 0); } while (0)
#define PG8_LDA(dst, b, h) do { _Pragma("unroll") for (int m = 0; m < 4; ++m) _Pragma("unroll") for (int k = 0; k < 2; ++k) dst[m][k] = *(const PG8_LAS bf16x8*)(lds + PG8_SA(b, h) + aoff + m * 2048 + k * 1024); } while (0)
#define PG8_LDB(dst, b, h) do { _Pragma("unroll") for (int n = 0; n < 2; ++n) _Pragma("unroll") for (int k = 0; k < 2; ++k) dst[n][k] = *(const PG8_LAS bf16x8*)(lds + PG8_SB(b, h) + boff + n * 2048 + k * 1024); } while (0)
#define PG8_MMA(ai, bj, At, Bt) do { __builtin_amdgcn_s_setprio(1); _Pragma("unroll") for (int m = 0; m < 4; ++m) _Pragma("unroll") for (int n = 0; n < 2; ++n) _Pragma("unroll") for (int k = 0; k < 2; ++k) \
        acc[ai][bj][m][n] = __builtin_amdgcn_mfma_f32_16x16x32_bf16(Bt[n][k], At[m][k], acc[ai][bj][m][n], 0, 0, 0); __builtin_amdgcn_s_setprio(0); } while (0)
#define PG8_WAIT_V(n) asm volatile("s_waitcnt vmcnt(" #n ")" ::: "memory")
#define PG8_WAIT_L(n) asm volatile("s_waitcnt lgkmcnt(" #n ")" ::: "memory")
#define PG8_BAR __builtin_amdgcn_s_barrier()
#define PG8_SCHED __builtin_amdgcn_sched_barrier(0)
    Unit cur, nxt; int ui = 0;
    if (!S.next(0, cur)) return;
    f32x4 acc[2][2][4][2];
#pragma unroll
    for (int a = 0; a < 2; ++a)
#pragma unroll
        for (int b = 0; b < 2; ++b)
#pragma unroll
            for (int m = 0; m < 4; ++m)
#pragma unroll
                for (int n = 0; n < 2; ++n) acc[a][b][m][n] = (f32x4){0.f, 0.f, 0.f, 0.f};
    bf16x8 At[4][2], B0[2][2], B1[2][2];
    UMem cm = P.mem(cur);
    const char* cA = cm.A; const char* cB = cm.B; int nt = cm.nt;
    if constexpr (SP2) {
        PG8_STAGE(PG8_SB(0, 0), cB, voffB); PG8_STAGE(PG8_SB(0, 1), cB + hstepB, voffB); PG8_STAGE(PG8_SA(0, 0), cA, voffA); PG8_STAGE(PG8_SA(0, 1), cA + hstepA, voffA);
        if (wr == 1) PG8_BAR;
        PG8_WAIT_V(2); PG8_BAR;
        PG8_STAGE(PG8_SB(1, 0), cB + kstep, voffB); PG8_STAGE(PG8_SA(1, 0), cA + kstep, voffA); PG8_STAGE(PG8_SB(1, 1), cB + hstepB + kstep, voffB);
        PG8_WAIT_V(6); PG8_BAR;
    } else {
        PG8_STAGE(PG8_SB(0, 0), cB, voffB); PG8_STAGE(PG8_SA(0, 0), cA, voffA); PG8_STAGE(PG8_SB(0, 1), cB + hstepB, voffB); PG8_STAGE(PG8_SA(0, 1), cA + hstepA, voffA);
        if (wr == 1) PG8_BAR;
        PG8_WAIT_V(4); PG8_BAR;
        PG8_STAGE(PG8_SB(1, 0), cB + kstep, voffB); PG8_STAGE(PG8_SA(1, 0), cA + kstep, voffA); PG8_STAGE(PG8_SB(1, 1), cB + hstepB + kstep, voffB);
        PG8_WAIT_V(6); PG8_BAR;
    }
    for (;;) {
        const bool has_next = S.next(ui + 1, nxt);
        UMem nm = cm; if (has_next) nm = P.mem(nxt);
        const char* nA = has_next ? nm.A : cA; const char* nB = has_next ? nm.B : cB;
        for (int t = 0; t < nt; t += 2) {
            const bool last = (t == nt - 2);
            const char* a1 = cA + (size_t)(t + 1) * kstep;
            const char* a2 = last ? nA : cA + (size_t)(t + 2) * kstep; const char* b2 = last ? nB : cB + (size_t)(t + 2) * kstep;
            const char* a3 = a2 + kstep; const char* b3 = b2 + kstep;
            if constexpr (SP2) {
            PG8_LDB(B0, 0, 0); PG8_LDB(B1, 0, 1); PG8_SCHED; PG8_LDA(At, 0, 0); PG8_STAGE(PG8_SA(1, 1), a1 + hstepA, voffA);
            PG8_WAIT_V(8); PG8_WAIT_L(0); PG8_BAR; PG8_MMA(0, 0, At, B0); PG8_MMA(0, 1, At, B1); PG8_BAR; PG8_SCHED;
            PG8_LDA(At, 0, 1); PG8_STAGE(PG8_SB(0, 0), b2, voffB); PG8_STAGE(PG8_SB(0, 1), b2 + hstepB, voffB); PG8_STAGE(PG8_SA(0, 0), a2, voffA);
            PG8_WAIT_V(8); PG8_WAIT_L(0); PG8_BAR; PG8_MMA(1, 0, At, B0); PG8_MMA(1, 1, At, B1); PG8_BAR; PG8_SCHED;
            PG8_LDB(B0, 1, 0); PG8_LDB(B1, 1, 1); PG8_SCHED; PG8_LDA(At, 1, 0); PG8_STAGE(PG8_SA(0, 1), a2 + hstepA, voffA);
            PG8_WAIT_V(8); PG8_WAIT_L(0); PG8_BAR; PG8_MMA(0, 0, At, B0); PG8_MMA(0, 1, At, B1); PG8_BAR; PG8_SCHED;
            PG8_LDA(At, 1, 1); PG8_STAGE(PG8_SB(1, 0), b3, voffB); PG8_STAGE(PG8_SB(1, 1), b3 + hstepB, voffB); PG8_STAGE(PG8_SA(1, 0), a3, voffA);
            PG8_WAIT_V(8); PG8_WAIT_L(0); PG8_BAR; PG8_MMA(1, 0, At, B0); PG8_MMA(1, 1, At, B1); PG8_BAR; PG8_SCHED;
            } else {
            PG8_LDB(B0, 0, 0); PG8_SCHED; PG8_LDA(At, 0, 0); PG8_STAGE(PG8_SA(1, 1), a1 + hstepA, voffA);
            PG8_WAIT_L(8); PG8_BAR; PG8_WAIT_L(0); PG8_MMA(0, 0, At, B0); PG8_BAR; PG8_SCHED;
            PG8_LDB(B1, 0, 1); PG8_STAGE(PG8_SB(0, 0), b2, voffB);
            PG8_BAR; PG8_WAIT_L(0); PG8_MMA(0, 1, At, B1); PG8_BAR;
            PG8_LDA(At, 0, 1); PG8_STAGE(PG8_SA(0, 0), a2, voffA);
            PG8_BAR; PG8_WAIT_L(0); PG8_MMA(1, 0, At, B0); PG8_BAR; PG8_SCHED;
            PG8_STAGE(PG8_SB(0, 1), b2 + hstepB, voffB);
            PG8_WAIT_V(6); PG8_BAR; PG8_MMA(1, 1, At, B1); PG8_BAR;
            PG8_LDB(B0, 1, 0); PG8_SCHED; PG8_LDA(At, 1, 0); PG8_STAGE(PG8_SA(0, 1), a2 + hstepA, voffA);
            PG8_WAIT_L(8); PG8_BAR; PG8_WAIT_L(0); PG8_MMA(0, 0, At, B0); PG8_BAR; PG8_SCHED;
            PG8_LDB(B1, 1, 1); PG8_STAGE(PG8_SB(1, 0), b3, voffB);
            PG8_BAR; PG8_WAIT_L(0); PG8_MMA(0, 1, At, B1); PG8_BAR;
            PG8_LDA(At, 1, 1); PG8_STAGE(PG8_SA(1, 0), a3, voffA);
            PG8_BAR; PG8_WAIT_L(0); PG8_MMA(1, 0, At, B0); PG8_BAR; PG8_SCHED;
            PG8_STAGE(PG8_SB(1, 1), b3 + hstepB, voffB);
            PG8_WAIT_V(6); PG8_BAR; PG8_MMA(1, 1, At, B1); PG8_BAR;
            }
        }
        if constexpr (ALIGN_EPI) { if (wr == 0) PG8_BAR; }
        E(acc, cur, wr, wc, fr, fq);
        if (!has_next) break;
        if (!E.keep(cur)) {
#pragma unroll
        for (int a = 0; a < 2; ++a)
#pragma unroll
            for (int b = 0; b < 2; ++b)
#pragma unroll
                for (int m = 0; m < 4; ++m)
#pragma unroll
                    for (int n = 0; n < 2; ++n) acc[a][b][m][n] = (f32x4){0.f, 0.f, 0.f, 0.f};
        }
        cur = nxt; cm = nm; cA = nA; cB = nB; nt = nm.nt; ++ui;
        if constexpr (ALIGN_EPI) { if (wr == 1) PG8_BAR; }
    }
    PG8_WAIT_V(0);
    if constexpr (!ALIGN_EPI) { if (wr == 0) PG8_BAR; }
    PG8_BAR;
#undef PG8_SA
#undef PG8_SB
#undef PG8_STAGE
#undef PG8_LDA
#undef PG8_LDB
#undef PG8_MMA
#undef PG8_WAIT_V
#undef PG8_WAIT_L
#undef PG8_BAR
#undef PG8_SCHED
}
}
namespace attn_body {
using bf16=__hip_bfloat16;
using bf16x8=__attribute__((ext_vector_type(8)))short;
using s16x4=__attribute__((ext_vector_type(4)))short;
using f32x16=__attribute__((ext_vector_type(16)))float;
using u32x4=__attribute__((ext_vector_type(4)))unsigned;
using f32x4v=__attribute__((ext_vector_type(4)))float;
constexpr int BATCH=8,NHEAD=8,SEQ=4096,D=64,DM=NHEAD*D;
constexpr int NW=8,QBLK=32,QB=QBLK*NW,KVBLK=64,NQB=SEQ/QB;
constexpr int ATTN_PITCH=DM, ATTN_UNIT_ROWS=QB;
__device__ __forceinline__ int crow(int r,int hi){return (r&3)+8*(r>>2)+4*hi;}
#define SBAR() __builtin_amdgcn_sched_barrier(0)
__device__ __forceinline__ void cmask(f32x16&p0,f32x16&p1,int jb,int qrel,int hi){
  const float NEG=-INFINITY; int kb=64*jb+4*hi;
  #pragma unroll
  for(int r=0;r<16;++r){int kv=kb+(r&3)+8*(r>>2); if(kv>qrel)p0[r]=NEG; if(kv+32>qrel)p1[r]=NEG;}
}

constexpr int NSLOT=3, SLOTB=8192;
constexpr int LDS_K=0, LDS_V=NSLOT*SLOTB, LDS_WS=2*NSLOT*SLOTB, LDS_OST=LDS_WS+NW*64*4, LDS_C2=LDS_OST+NW*4096, LDS_WSUM=LDS_C2+SEQ*4, LDS_BYTES=LDS_WSUM+64;
constexpr float C2=0.125f*1.4426950408889634f;
__device__ __forceinline__ void glds16(const void*gsrc,unsigned lds_dst){unsigned keep;
  asm volatile("s_mov_b32 %0, m0\n\ts_mov_b32 m0, %2\n\ts_nop 0\n\tglobal_load_lds_dwordx4 %1, off\n\ts_mov_b32 m0, %0":"=&s"(keep):"v"(gsrc),"s"(lds_dst):"memory");}
__device__ __forceinline__ float max3f(float a,float b,float c){float r;asm("v_max3_f32 %0, %1, %2, %3":"=v"(r):"v"(a),"v"(b),"v"(c));return r;}
__device__ __forceinline__ float max2f(float a,float b){float r;asm("v_max_f32_e32 %0, %1, %2":"=v"(r):"v"(a),"v"(b));return r;}
__device__ __forceinline__ float fadd_s(float a,float b){float r;asm("v_add_f32_e32 %0, %1, %2":"=v"(r):"v"(a),"v"(b));return r;}
__device__ __forceinline__ float fsub_s(float a,float b){float r;asm("v_sub_f32_e32 %0, %1, %2":"=v"(r):"v"(a),"v"(b));return r;}
typedef float f32x2_t __attribute__((ext_vector_type(2))); typedef __bf16 bf16x2_t __attribute__((ext_vector_type(2)));
__device__ __forceinline__ unsigned cvtpk_s(float lo,float hi){f32x2_t v={lo,hi};bf16x2_t b=__builtin_convertvector(v,bf16x2_t);return __builtin_bit_cast(unsigned,b);}
#define WAIT_BAR(N) asm volatile("s_waitcnt vmcnt(" #N ") lgkmcnt(0)\n\ts_barrier":::"memory")

__device__ __forceinline__ void qkt(f32x16&p0,f32x16&p1,const char*Kslot,const bf16x8*qr,int r32,int hi){
  const char*kb=Kslot+hi*1024+r32*16;
  #pragma unroll
  for(int d0=0;d0<4;++d0){
    const bf16x8 b0=*reinterpret_cast<const bf16x8*>(kb+d0*2048);
    const bf16x8 b1=*reinterpret_cast<const bf16x8*>(kb+d0*2048+512);
    {p0=__builtin_amdgcn_mfma_f32_32x32x16_bf16(b0,qr[d0],p0,0,0,0);p1=__builtin_amdgcn_mfma_f32_32x32x16_bf16(b1,qr[d0],p1,0,0,0);}}
}
typedef __attribute__((address_space(3))) const char* lds_cptr;
typedef short v4i16_t __attribute__((ext_vector_type(4)));
__device__ __forceinline__ void kload8(bf16x8*kf,lds_cptr kp){
  kf[0]=*(const __attribute__((address_space(3))) bf16x8*)(kp);      kf[1]=*(const __attribute__((address_space(3))) bf16x8*)(kp+512);
  kf[2]=*(const __attribute__((address_space(3))) bf16x8*)(kp+2048); kf[3]=*(const __attribute__((address_space(3))) bf16x8*)(kp+2560);
  kf[4]=*(const __attribute__((address_space(3))) bf16x8*)(kp+4096); kf[5]=*(const __attribute__((address_space(3))) bf16x8*)(kp+4608);
  kf[6]=*(const __attribute__((address_space(3))) bf16x8*)(kp+6144); kf[7]=*(const __attribute__((address_space(3))) bf16x8*)(kp+6656);
}
__device__ __forceinline__ void kload2(bf16x8*kf,lds_cptr kp,int j){ kf[2*j]=*(const __attribute__((address_space(3))) bf16x8*)(kp+j*2048); kf[2*j+1]=*(const __attribute__((address_space(3))) bf16x8*)(kp+j*2048+512); }
__device__ __forceinline__ s16x4 vtr(lds_cptr p){ return __builtin_bit_cast(s16x4,__builtin_amdgcn_ds_read_tr16_b64_v4i16((__attribute__((address_space(3))) v4i16_t*)p)); }
__device__ __forceinline__ float rowmax(const f32x16&p0,const f32x16&p1){
  float a=max3f(p0[0],p0[1],p1[0]),b=max3f(p0[2],p0[3],p1[1]);a=max3f(a,p1[2],p1[3]);
  #pragma unroll
  for(int r=4;r<16;r+=4){a=max3f(a,p0[r],p0[r+1]);b=max3f(b,p0[r+2],p0[r+3]);a=max3f(a,p1[r],p1[r+1]);b=max3f(b,p1[r+2],p1[r+3]);}
  const float m=max2f(a,b);
  auto rr=__builtin_amdgcn_permlane32_swap(__float_as_uint(m),__float_as_uint(m),false,false);
  return max2f(__uint_as_float(rr[0]),__uint_as_float(rr[1]));
}
__device__ __forceinline__ void pv(f32x16*o,int vb,bf16x8 pa0,bf16x8 pa1,bf16x8 pa2,bf16x8 pa3){
  #pragma unroll
  for(int d0=0;d0<2;++d0){s16x4 lo[4],hi[4];
    #pragma unroll
    for(int ks=0;ks<4;++ks){
      asm volatile("ds_read_b64_tr_b16 %0,%1 offset:%c2":"=&v"(lo[ks]):"v"(vb),"i"(d0*4096+ks*1024):"memory");
      asm volatile("ds_read_b64_tr_b16 %0,%1 offset:%c2":"=&v"(hi[ks]):"v"(vb),"i"(d0*4096+ks*1024+512):"memory");}
    asm volatile("s_waitcnt lgkmcnt(0)":::"memory");SBAR();
    #define PK(k) (bf16x8){lo[k][0],lo[k][1],lo[k][2],lo[k][3],hi[k][0],hi[k][1],hi[k][2],hi[k][3]}
    o[d0]=__builtin_amdgcn_mfma_f32_32x32x16_bf16(pa0,PK(0),o[d0],0,0,0);
    o[d0]=__builtin_amdgcn_mfma_f32_32x32x16_bf16(pa1,PK(1),o[d0],0,0,0);
    o[d0]=__builtin_amdgcn_mfma_f32_32x32x16_bf16(pa2,PK(2),o[d0],0,0,0);
    o[d0]=__builtin_amdgcn_mfma_f32_32x32x16_bf16(pa3,PK(3),o[d0],0,0,0);
    #undef PK
  }
}

#ifndef ATTN_STORE16
#define ATTN_STORE16(p,v) (*(u32x4*)(p)=(v))
#endif
template<int THRL> __device__ __forceinline__ void attn_unit(int b,int h,int qb,const bf16*Q,const bf16*__restrict__ K,const bf16*__restrict__ V,bf16*O,char*shm){
  typedef __attribute__((address_space(3))) const float* lds_cf; typedef __attribute__((address_space(3))) const f32x4v* lds_cf4;
  const int tid=opaque_i(threadIdx.x),lane=tid&63,r32=lane&31,hi=lane>>5; const int wid=__builtin_amdgcn_readfirstlane(tid>>6);
  const long rowbase=(long)b*SEQ; const int q0=qb*QB;
  const bf16*Qw=Q+(rowbase+q0+wid*QBLK)*DM+h*D;
  const bf16*Kh=K+rowbase*DM+h*D,*Vh=V+rowbase*DM+h*D;
  const unsigned lds0=(unsigned)(uintptr_t)shm;
  float*wsf=(float*)(shm+LDS_WS)+wid*64;
  const bf16*ksrc=Kh+(long)lane*DM+wid*8;
  const bf16*vsrc=Vh+(long)(16*(wid&3)+(lane>>2))*DM+(wid>>2)*32+(lane&3)*8;
  const unsigned kdst=lds0+LDS_K+wid*1024, vdst=lds0+LDS_V+wid*1024;
  #define DMA_K(t,slot) glds16(ksrc+(long)(t)*KVBLK*DM,(unsigned)__builtin_amdgcn_readfirstlane(kdst+(slot)))
  #define DMA_V(t,slot) glds16(vsrc+(long)(t)*KVBLK*DM,(unsigned)__builtin_amdgcn_readfirstlane(vdst+(slot)))
  const int vb0=(int)(lds0+LDS_V)+((lane>>4)&1)*32+(lane&3)*8+(4*hi+((lane&15)>>2))*64;
  const char*Kbase=shm+LDS_K; bf16x8 kf[8];
  const lds_cptr shm3=(lds_cptr)shm; const lds_cptr kp0=shm3+LDS_K+hi*1024+r32*16; const lds_cptr vp0=shm3+LDS_V+((lane>>4)&1)*32+(lane&3)*8+(4*hi+((lane&15)>>2))*64;
  const int NT=(q0+QB)/KVBLK;
  DMA_K(0,0);DMA_V(0,0);DMA_K(1,SLOTB);
  bf16x8 qr[4];
  #pragma unroll
  for(int d0=0;d0<4;++d0)qr[d0]=*reinterpret_cast<const bf16x8*>(&Qw[(long)r32*DM+d0*16+hi*8]);
  float mhat=0.f,l_reg=0.f;f32x16 o[2];o[0]=f32x16{};o[1]=f32x16{};
  const lds_cf c2p=(lds_cf)((lds_cptr)shm+LDS_C2)+4*hi; const float c2ref=((lds_cf)((lds_cptr)shm+LDS_C2))[q0+QB-1];
  #define CINIT1(C,t,OFF) do{ const float k0_=-(c2ref+mhat); const lds_cf cb_=c2p+(t)*KVBLK+(OFF); \
    _Pragma("unroll") for(int g_=0;g_<4;++g_){ const f32x4v u_=*(lds_cf4)(cb_+8*g_); \
      C[4*g_]=u_[0]+k0_;C[4*g_+1]=u_[1]+k0_;C[4*g_+2]=u_[2]+k0_;C[4*g_+3]=u_[3]+k0_; } }while(0)
  #define CINIT(C0,C1,t) do{ CINIT1(C0,t,0); CINIT1(C1,t,32); }while(0)
  const int qrel=wid*QBLK+r32;
  #define CMASK(P0,P1,t) do{int jb_=(t)-(NT-4); if(jb_>=0)cmask(P0,P1,jb_,qrel,hi);}while(0)
  bool resc=false;
  #define START(P0,P1) do{ const float rm=rowmax(P0,P1); resc=false; \
    { const float dl=rm; mhat=fadd_s(mhat,dl); \
      _Pragma("unroll") for(int r=0;r<16;++r){P0[r]=fsub_s(P0[r],dl);P1[r]=fsub_s(P1[r],dl);} \
      } \
    _Pragma("unroll") for(int r=0;r<16;++r)P0[r]=__builtin_amdgcn_exp2f(P0[r]); }while(0)
  #define RESC() do{ if(resc){ asm volatile("s_waitcnt lgkmcnt(0)":::"memory"); \
      _Pragma("unroll") for(int d_=0;d_<2;++d_) _Pragma("unroll") for(int r=0;r<16;++r)o[d_][r]*=wsf[crow(r,hi)]; } }while(0)
  f32x16 pA0,pA1,pB0,pB1;
  int sl_prev=0,sl_cur=0,sl_next=SLOTB;
  #define ROT() do{sl_prev=sl_cur;sl_cur=sl_next;sl_next=(sl_next==(NSLOT-1)*SLOTB)?0:sl_next+SLOTB;}while(0)
  DMA_K(2,2*SLOTB);
  WAIT_BAR(3);
  CINIT(pA0,pA1,0); qkt(pA0,pA1,Kbase,qr,r32,hi);asm volatile("s_nop 15\n\ts_nop 7":"+v"(pA0),"+v"(pA1));CMASK(pA0,pA1,0);
  START(pA0,pA1);
  _Pragma("unroll") for(int r=0;r<16;++r)pA1[r]=__builtin_amdgcn_exp2f(pA1[r]);
  WAIT_BAR(0);
  DMA_K(3,0);DMA_V(1,SLOTB);
  ROT();
  kload8(kf,kp0+sl_cur);
  WAIT_BAR(2);
  s16x4 vlo[8],vhi[8]; u32x4 pw0,pw1,pw2,pw3;
  #define PKW(P,B) cvtpk_s(P[B],P[B+1])
  #define PAF(k) __builtin_bit_cast(bf16x8,pw##k)
  #define VFR(i) (bf16x8){vlo[i][0],vlo[i][1],vlo[i][2],vlo[i][3],vhi[i][0],vhi[i][1],vhi[i][2],vhi[i][3]}
  #define PIN(x) asm volatile("":"+v"(x))
  #define MX3(a,b,c) __builtin_fmaxf(__builtin_fmaxf((a),(b)),(c))
  #define GAPA(MF,A0,A1,A2,A3,W0,W1,PW) do{ MF; sacc+=A0; sacc+=A1; sacc+=A2; sacc+=A3; PIN(sacc); W0; W1; PIN(PW); SBAR(); }while(0)
  #define EX(v) __builtin_amdgcn_exp2f(v)
  #define GAPB(MF,X,B) do{ MF; X[B]=EX(X[B]); X[B+1]=EX(X[B+1]); X[B+2]=EX(X[B+2]); X[B+3]=EX(X[B+3]); PIN(X); SBAR(); }while(0)
  #define VRD(i) do{ vlo[i]=vtr(vp_+(((i)>>2)*4096+((i)&3)*1024)); vhi[i]=vtr(vp_+(((i)>>2)*4096+((i)&3)*1024+512)); }while(0)
  #define KRD(G,j) do{ if(G){ kload2(kf,kp0+sl_next,j); SBAR(); } }while(0)
  #define STEP(C0,C1,P0,P1,t,GK,GV,GL) do{ SBAR(); CINIT1(C0,t,0); SBAR(); \
    const lds_cptr vp_=vp0+sl_prev; \
    VRD(0); SBAR(); float sacc=(P0[0]+P0[1]); \
    GAPA(C0=__builtin_amdgcn_mfma_f32_32x32x16_bf16(kf[0],qr[0],C0,0,0,0), P0[2],P0[3],P0[4],P0[5],     pw0[0]=PKW(P0,0), pw0[1]=PKW(P0,2), pw0); \
    CINIT1(C1,t,32); SBAR(); VRD(4); SBAR(); GAPA(C1=__builtin_amdgcn_mfma_f32_32x32x16_bf16(kf[1],qr[0],C1,0,0,0), P0[6],P0[7],P0[8],P0[9],     pw0[2]=PKW(P0,4), pw0[3]=PKW(P0,6), pw0); \
    VRD(1); SBAR(); GAPA(C0=__builtin_amdgcn_mfma_f32_32x32x16_bf16(kf[2],qr[1],C0,0,0,0),   P0[10],P0[11],P0[12],P0[13], pw1[0]=PKW(P0,8), pw1[1]=PKW(P0,10), pw1); \
    VRD(5); SBAR(); GAPA(C1=__builtin_amdgcn_mfma_f32_32x32x16_bf16(kf[3],qr[1],C1,0,0,0),   P0[14],P0[15],P1[0],P1[1],   pw1[2]=PKW(P0,12),pw1[3]=PKW(P0,14), pw1); \
    VRD(2); SBAR(); GAPA(C0=__builtin_amdgcn_mfma_f32_32x32x16_bf16(kf[4],qr[2],C0,0,0,0),   P1[2],P1[3],P1[4],P1[5],     pw2[0]=PKW(P1,0), pw2[1]=PKW(P1,2), pw2); \
    VRD(6); SBAR(); GAPA(C1=__builtin_amdgcn_mfma_f32_32x32x16_bf16(kf[5],qr[2],C1,0,0,0),   P1[6],P1[7],P1[8],P1[9],     pw2[2]=PKW(P1,4), pw2[3]=PKW(P1,6), pw2); \
    VRD(3); SBAR(); GAPA(C0=__builtin_amdgcn_mfma_f32_32x32x16_bf16(kf[6],qr[3],C0,0,0,0),   P1[10],P1[11],P1[12],P1[13], pw3[0]=PKW(P1,8), pw3[1]=PKW(P1,10), pw3); \
    VRD(7); SBAR(); GAPA(C1=__builtin_amdgcn_mfma_f32_32x32x16_bf16(kf[7],qr[3],C1,0,0,0),   P1[14],P1[15],0.f,0.f,       pw3[2]=PKW(P1,12),pw3[3]=PKW(P1,14), pw3); \
    l_reg+=sacc; \
    if(GK){DMA_K((t)+3,sl_cur);} if(GV){DMA_V((t)+1,sl_next);} \
    CMASK(C0,C1,t); \
    { float a=MX3(C0[0],C0[1],C1[0]),b=MX3(C0[2],C0[3],C1[1]); a=MX3(a,C1[2],C1[3]); \
      _Pragma("unroll") for(int r=4;r<16;r+=4){a=MX3(a,C0[r],C0[r+1]);b=MX3(b,C0[r+2],C0[r+3]);a=MX3(a,C1[r],C1[r+1]);b=MX3(b,C1[r+2],C1[r+3]);} \
      float rm=__builtin_fmaxf(a,b); { auto rr=__builtin_amdgcn_permlane32_swap(__float_as_uint(rm),__float_as_uint(rm),false,false); rm=__builtin_fmaxf(__uint_as_float(rr[0]),__uint_as_float(rr[1])); } \
      resc=false; \
      if(__builtin_expect(__any(rm>(float)THRL),0)){ const float dl=__builtin_fmaxf(rm,0.f); mhat+=dl; \
        _Pragma("unroll") for(int r=0;r<16;++r){C0[r]-=dl;C1[r]-=dl;} \
        const float f=__builtin_amdgcn_exp2f(-dl); l_reg*=f; if(hi==0)wsf[r32]=f; resc=true; } } \
    SBAR(); \
    GAPB(o[0]=__builtin_amdgcn_mfma_f32_32x32x16_bf16(PAF(0),VFR(0),o[0],0,0,0), C0,0); \
    GAPB(o[1]=__builtin_amdgcn_mfma_f32_32x32x16_bf16(PAF(0),VFR(4),o[1],0,0,0), C0,4); \
    KRD(GL,0); GAPB(o[0]=__builtin_amdgcn_mfma_f32_32x32x16_bf16(PAF(1),VFR(1),o[0],0,0,0), C0,8); \
    KRD(GL,1); GAPB(o[1]=__builtin_amdgcn_mfma_f32_32x32x16_bf16(PAF(1),VFR(5),o[1],0,0,0), C0,12); \
    KRD(GL,2); GAPB(o[0]=__builtin_amdgcn_mfma_f32_32x32x16_bf16(PAF(2),VFR(2),o[0],0,0,0), C1,0); \
    KRD(GL,3); GAPB(o[1]=__builtin_amdgcn_mfma_f32_32x32x16_bf16(PAF(2),VFR(6),o[1],0,0,0), C1,4); \
    GAPB(o[0]=__builtin_amdgcn_mfma_f32_32x32x16_bf16(PAF(3),VFR(3),o[0],0,0,0), C1,8); \
    GAPB(o[1]=__builtin_amdgcn_mfma_f32_32x32x16_bf16(PAF(3),VFR(7),o[1],0,0,0), C1,12); \
    }while(0)
  int t=1;
  #undef CMASK
  #define CMASK(P0,P1,t) do{}while(0)
  for(;t+5<NT;t+=2){
    STEP(pB0,pB1,pA0,pA1,t,true,true,true);     WAIT_BAR(2); RESC(); ROT();
    STEP(pA0,pA1,pB0,pB1,t+1,true,true,true);   WAIT_BAR(2); RESC(); ROT();
  }
  #undef CMASK
  #define CMASK(P0,P1,t) do{int jb_=(t)-(NT-4); if(jb_>=0)cmask(P0,P1,jb_,qrel,hi);}while(0)
  #define ENDW(tt) do{ if((tt)+3<NT){WAIT_BAR(2);} else if((tt)+2<NT){WAIT_BAR(1);} else {WAIT_BAR(0);} }while(0)
  for(;t+1<NT;t+=2){
    STEP(pB0,pB1,pA0,pA1,t,(t+3<NT),(t+1<NT),(t+1<NT));       ENDW(t);   RESC(); ROT();
    STEP(pA0,pA1,pB0,pB1,t+1,(t+4<NT),(t+2<NT),(t+2<NT));     ENDW(t+1); RESC(); ROT();
  }
  STEP(pB0,pB1,pA0,pA1,NT-1,false,false,false); RESC();
  { float sacc=pB0[0]+pB0[1]; _Pragma("unroll") for(int r=2;r<16;++r)sacc+=pB0[r]; _Pragma("unroll") for(int r=0;r<16;++r)sacc+=pB1[r]; l_reg+=sacc;
    pw0=(u32x4){PKW(pB0,0),PKW(pB0,2),PKW(pB0,4),PKW(pB0,6)};pw1=(u32x4){PKW(pB0,8),PKW(pB0,10),PKW(pB0,12),PKW(pB0,14)};pw2=(u32x4){PKW(pB1,0),PKW(pB1,2),PKW(pB1,4),PKW(pB1,6)};pw3=(u32x4){PKW(pB1,8),PKW(pB1,10),PKW(pB1,12),PKW(pB1,14)};
    SBAR(); pv(o,vb0+sl_cur,PAF(0),PAF(1),PAF(2),PAF(3)); }
  #undef PKW
  #undef PAF
  #undef VFR
  #undef PIN
  #undef MX3
  #undef GAPA
  #undef GAPB
  #undef EX
  #undef VRD
  #undef KRD
  #undef STEP
  #undef ENDW
  {auto rr=__builtin_amdgcn_permlane32_swap(__float_as_uint(l_reg),__float_as_uint(l_reg),false,false);l_reg=__uint_as_float(rr[0])+__uint_as_float(rr[1]);}
  if(hi==0)wsf[32+r32]=l_reg;asm volatile("s_waitcnt lgkmcnt(0)":::"memory");
  float rli[16];
  #pragma unroll
  for(int r=0;r<16;++r)rli[r]=__builtin_amdgcn_rcpf(wsf[32+crow(r,hi)]);
  bf16*Ow=O+(rowbase+q0+wid*QBLK)*DM+h*D;
  { bf16*stg=(bf16*)(shm+LDS_OST)+wid*2048;
    #pragma unroll
    for(int r=0;r<16;++r){const int orow=crow(r,hi);
      #pragma unroll
      for(int d0=0;d0<2;++d0)stg[orow*64+d0*32+r32]=__float2bfloat16(o[d0][r]*rli[r]);}
    asm volatile("s_waitcnt lgkmcnt(0)":::"memory");
    #pragma unroll
    for(int i=0;i<4;++i){const int row=i*8+(lane>>3),ch=lane&7; const u32x4 v=*(const u32x4*)(stg+row*64+ch*8); ATTN_STORE16(Ow+(long)row*DM+ch*8,v);} }
  asm volatile("s_waitcnt lgkmcnt(0)\n\ts_barrier":::"memory");
  #undef CINIT
  #undef CINIT1
  #undef DMA_K
  #undef DMA_V
  #undef CMASK
  #undef START
  #undef RESC
  #undef ROT
}
constexpr int ATTN_LDS_BYTES=LDS_BYTES;
struct AttnTensors { const bf16* Q; const bf16* K; const bf16* V; bf16* O; };
struct AttnUnit { int bh; int qb; };
struct StaticOrder {
  int vcu;
  __device__ __forceinline__ explicit StaticOrder(int grid,int block):vcu((block%8)*(grid/8)+block/8){}
  __device__ __forceinline__ bool next(int i,AttnUnit&u)const{ if(i>=4)return false; const int s=vcu&3; u.bh=vcu>>2; u.qb=(i==0)?15-s:(i==1)?8+s:(i==2)?7-s:s; return true; }
  __device__ __forceinline__ void a_ready(const AttnUnit&)const{}
  __device__ __forceinline__ void done(const AttnUnit&)const{}
};
template<class Sched,int THRL=8> __device__ __forceinline__ void attn_phase(char*lds,const AttnTensors&T,const Sched&S){
  AttnUnit u;
  for(int i=0;S.next(i,u);++i){ S.a_ready(u); attn_unit<THRL>(u.bh/NHEAD,u.bh%NHEAD,u.qb,T.Q,T.K,T.V,T.O,lds); S.done(u); }
}
#undef SBAR
#undef WAIT_BAR
}
constexpr size_t MiB = 1u << 20;
constexpr size_t WS_SSQ_MIX = 0;
constexpr size_t WS_LOGF = 2 * MiB;
constexpr size_t WS_WF = 3 * MiB;
constexpr size_t WS_W = 4 * MiB, W_PAR = 32 * MiB;
constexpr size_t W_WIN = 0, W_WM = 11 * MiB, W_WO = 13 * MiB, W_WFI = 15 * MiB, W_WFO = 26 * MiB;
constexpr size_t WS_XB = 68 * MiB;
constexpr size_t WS_Q = 132 * MiB, WS_K = 164 * MiB, WS_V = 196 * MiB;
constexpr size_t WS_CP = 228 * MiB;
constexpr size_t WS_G = 292 * MiB;
constexpr size_t WS_SSQ_FFN = 484 * MiB;
constexpr size_t WS_END = 486 * MiB;
constexpr int LDS_BYTES = 147456;
constexpr int NWAVES = 8;

#define GAS __attribute__((address_space(1)))
#define LAS __attribute__((address_space(3)))
typedef unsigned short bf16;
typedef unsigned v4u __attribute__((ext_vector_type(4)));
typedef float f32x4 __attribute__((ext_vector_type(4)));
#define LDS_WAIT() asm volatile("s_waitcnt lgkmcnt(0)" ::: "memory")
__device__ __forceinline__ unsigned f2bf(float f) { unsigned u = __builtin_bit_cast(unsigned, f); return (u + 0x7fffu + ((u >> 16) & 1u)) >> 16; }
__device__ __forceinline__ unsigned pk2(float lo, float hi) { return f2bf(lo) | (f2bf(hi) << 16); }
__device__ __forceinline__ float wave_sum(float v) {
#pragma unroll
    for (int o = 1; o < 64; o <<= 1) v += __shfl_xor(v, o);
    return v;
}

__device__ __forceinline__ void tr_item(const float* W, int ldn, int n0, int k0, const float* gain, bf16* WT, int ldk, int drow0, int koff, LAS float* scr, int lane) {
#pragma unroll 8
    for (int i = 0; i < 32; ++i) { const int kk = 2 * i + (lane >> 5); float w = W[(size_t)(k0 + kk) * ldn + n0 + (lane & 31)]; if (gain) w *= gain[k0 + kk]; scr[kk * 33 + (lane & 31)] = w; }
    LDS_WAIT(); asm volatile("" ::: "memory");
    const int c = lane & 7;
#pragma unroll
    for (int j = 0; j < 4; ++j) { const int n = (lane >> 3) + 8 * j; const LAS float* s = scr + (8 * c) * 33 + n;
        v4u o; o.x = pk2(s[0 * 33], s[1 * 33]); o.y = pk2(s[2 * 33], s[3 * 33]); o.z = pk2(s[4 * 33], s[5 * 33]); o.w = pk2(s[6 * 33], s[7 * 33]);
        *(v4u*)(WT + (size_t)(drow0 + n) * ldk + koff + k0 + 8 * c) = o; }
    LDS_WAIT(); asm volatile("" ::: "memory");
}

struct Args { const float* in[15]; float* out; unsigned char* ws; };

__device__ __forceinline__ void convert_layer(const Args& a, int l, int par, LAS unsigned char* lds, int gw, int NGW, int wave, int lane) {
    lane = opaque_i(lane);
    LAS float* scr = (LAS float*)(lds + wave * 16384);
    unsigned char* wb = a.ws + WS_W + (size_t)par * W_PAR;
    bf16* WIN = (bf16*)(wb + W_WIN); bf16* WM = (bf16*)(wb + W_WM); bf16* WO = (bf16*)(wb + W_WO); bf16* WFI = (bf16*)(wb + W_WFI); bf16* WFO = (bf16*)(wb + W_WFO);
    float* WF = (float*)(a.ws + WS_WF) + (size_t)par * 8192;
    const float* g_mix = a.in[1] + (size_t)l * 1024; const float* w_in = a.in[2] + (size_t)l * 1024 * DIN_SRC;
    const float* w_ao = a.in[6] + (size_t)l * 512 * 1024; const float* w_co = a.in[8] + (size_t)l * 256 * 1024;
    const float* pool_w = a.in[9] + (size_t)l * 4 * 64 * 256; const float* pool_s = a.in[10] + (size_t)l * 1024;
    const float* w_o = a.in[11] + (size_t)l * 1024 * 1024; const float* g_ffn = a.in[12] + (size_t)l * 1024;
    const float* w_fi = a.in[13] + (size_t)l * 1024 * 5632; const float* w_fo = a.in[14] + (size_t)l * 2816 * 1024;
    constexpr int I_WIN = 16 * 176, I_WFI = 16 * 176, I_WO = 16 * 32, I_WFO = 44 * 32, I_WA = 8 * 32, I_WC = 4 * 32, I_WP = 1024, I_WF = 8;
    constexpr int NITEMS = I_WIN + I_WFI + I_WO + I_WFO + I_WA + I_WC + I_WP + I_WF;
    for (int it = gw; it < NITEMS; it += NGW) {
        int r = it;
        if (r < I_WIN) { const int kb = r / 176, nb = r % 176, pn = nb >> 3, rem = nb & 7, bj = rem >> 2, w = rem & 3; const int nl = 256 * pn + 64 * w + 32 * bj; const int src = nl < 1536 ? nl : nl + 8;
            tr_item(w_in, DIN_SRC, src, 64 * kb, g_mix, WIN, 1024, 32 * nb, 0, scr, lane); continue; } r -= I_WIN;
        if (r < I_WFI) { const int kb = r / 176, nb = r % 176, pn = nb >> 3, rem = nb & 7, bj = rem >> 2, w = rem & 3; const int src = bj * DFF + 128 * pn + 32 * w;
            tr_item(w_fi, 5632, src, 64 * kb, g_ffn, WFI, 1024, 32 * nb, 0, scr, lane); continue; } r -= I_WFI;
        if (r < I_WO) { const int kb = r >> 5, nb = r & 31; tr_item(w_o, 1024, 32 * nb, 64 * kb, nullptr, WO, 1024, 32 * nb, 0, scr, lane); continue; } r -= I_WO;
        if (r < I_WFO) { const int kb = r >> 5, nb = r & 31; tr_item(w_fo, 1024, 32 * nb, 64 * kb, nullptr, WFO, DFF, 32 * nb, 0, scr, lane); continue; } r -= I_WFO;
        if (r < I_WA) { const int kb = r >> 5, nb = r & 31; tr_item(w_ao, 1024, 32 * nb, 64 * kb, nullptr, WM, 896, 32 * nb, 0, scr, lane); continue; } r -= I_WA;
        if (r < I_WC) { const int kb = r >> 5, nb = r & 31; tr_item(w_co, 1024, 32 * nb, 64 * kb, nullptr, WM, 896, 32 * nb, 512, scr, lane); continue; } r -= I_WC;
        if (r < I_WP) { const int n = r, g = n >> 8, d = n & 255; const float w = pool_w[((size_t)g * 64 + lane) * 256 + d] * pool_s[n]; const bf16 wv = (bf16)f2bf(w);
            WM[(size_t)n * 896 + 768 + lane] = (g & 1) ? (bf16)0 : wv; WM[(size_t)n * 896 + 768 + 64 + lane] = (g & 1) ? wv : (bf16)0; continue; } r -= I_WP;
        { const int h = r;
#pragma unroll 4
            for (int i = 0; i < 16; ++i) { const int k = lane + 64 * i; WF[h * 1024 + k] = w_in[(size_t)k * DIN_SRC + 1536 + h] * g_mix[k]; } }
    }
}

__global__ void __launch_bounds__(NWAVES * 64, 2) fwd_kernel(Args args) {
    extern __shared__ __attribute__((aligned(16))) unsigned char lds[];
    cg::grid_group grid = cg::this_grid();
#define GSYNC() do { asm volatile("s_waitcnt vmcnt(0)" ::: "memory"); grid.sync(); __builtin_amdgcn_fence(__ATOMIC_ACQUIRE, "agent"); asm volatile("s_waitcnt vmcnt(0)" ::: "memory"); } while (0)
    LAS unsigned char* ldsl = (LAS unsigned char*)lds;
    const int tid = threadIdx.x, lane = tid & 63, wave = __builtin_amdgcn_readfirstlane(tid >> 6);
    const int G = gridDim.x; const int bx = blockIdx.x; const int vcu = (G % 8 == 0) ? (bx % 8) * (G / 8) + bx / 8 : bx;
    const int gw = vcu * NWAVES + wave, NGW = G * NWAVES;
    unsigned char* ws = args.ws;
    float* SSQ_MIX = (float*)(ws + WS_SSQ_MIX); float* SSQ_FFN = (float*)(ws + WS_SSQ_FFN); float* LOGF = (float*)(ws + WS_LOGF);
    bf16* XB = (bf16*)(ws + WS_XB); bf16* CZ = XB; bf16* QO = (bf16*)(ws + WS_Q); bf16* KB = (bf16*)(ws + WS_K); bf16* VB = (bf16*)(ws + WS_V); bf16* MG = KB;
    bf16* CP = (bf16*)(ws + WS_CP); bf16* GT = (bf16*)(ws + WS_G); bf16* ACT = GT;
    const float* x_in = args.in[0]; float* out = args.out;

    convert_layer(args, 0, 0, ldsl, gw, NGW, wave, lane);
    for (int m = gw; m < MTOK; m += NGW) {
        const int lane = opaque_i(tid) & 63;
        const f32x4* xr = (const f32x4*)(x_in + (size_t)m * 1024) + lane; f32x4 v[4]; float s = 0.f;
#pragma unroll
        for (int j = 0; j < 4; ++j) { v[j] = xr[64 * j]; s += (v[j].x * v[j].x + v[j].y * v[j].y) + (v[j].z * v[j].z + v[j].w * v[j].w); }
        s = wave_sum(s);
        unsigned long long* o8 = (unsigned long long*)(XB + (size_t)m * 1024) + lane;
#pragma unroll
        for (int j = 0; j < 4; ++j) o8[64 * j] = (unsigned long long)pk2(v[j].x, v[j].y) | ((unsigned long long)pk2(v[j].z, v[j].w) << 32);
        if (lane < 16) SSQ_MIX[(size_t)m * 16 + lane] = lane == 0 ? s : 0.f;
    }
    GSYNC();

    for (int l = 0; l < NLAYER; ++l) {
        const int par = l & 1;
        unsigned char* wb = ws + WS_W + (size_t)par * W_PAR;
        const float* ssq_mix = SSQ_MIX; float* ssq_ffn = SSQ_FFN;
        float* ssq_nextmix = (l + 1 < NLAYER) ? SSQ_MIX : nullptr;

#if (PHM >> 1) & 1
        {
            const float* WF = (const float*)(ws + WS_WF) + (size_t)par * 8192; const float* fb = args.in[3] + l * 8;
            for (int m = gw; m < MTOK; m += NGW) {
                const int lane = opaque_i(tid) & 63;
                const v4u* xr = (const v4u*)(XB + (size_t)m * 1024) + lane * 2; const v4u a = xr[0], b = xr[1];
                const f32x4 x0 = pg8::bf_lo4(a.x, a.y), x1 = pg8::bf_lo4(a.z, a.w), x2 = pg8::bf_lo4(b.x, b.y), x3 = pg8::bf_lo4(b.z, b.w);
                float res = 0.f;
#pragma unroll
                for (int h = 0; h < 8; ++h) { const f32x4* w = (const f32x4*)(WF + h * 1024 + lane * 16); const f32x4 p = x0 * w[0] + x1 * w[1] + x2 * w[2] + x3 * w[3];
                    const float d = wave_sum((p.x + p.y) + (p.z + p.w)); if (lane == h) res = d; }
                if (lane < 8) { const float r = rsqrtf(pg8::row_ssq(ssq_mix, m) * (1.0f / 1024.0f) + EPSN); const float f = res * r + fb[lane];
                    const float lf = fminf(f, 0.f) - log1pf(expf(-fabsf(f))); LOGF[((size_t)(m >> 12) * 8 + lane) * SEQ_ + (m & (SEQ_ - 1))] = lf; }
            }
            pg8::ProbSimple P{(const char*)XB, (const char*)(wb + W_WIN), 1024, 1024, 16}; pg8::StaticOrder<1> S; S.init(MTOK, NIN, G, bx);
            pg8::EpiInProj E{ssq_mix, args.in[4] + l * 64, args.in[5] + l * 64, QO, KB, VB, CP, GT};
            pg8::gemm_phase<pg8::ProbSimple, pg8::EpiInProj, pg8::StaticOrder<1>, true, true>(ldsl, P, S, E);
        }
#endif
        GSYNC();

#if (PHM >> 2) & 1
        {
            if (l + 1 < NLAYER) convert_layer(args, l + 1, (l + 1) & 1, ldsl, gw, NGW, wave, lane);
            {
                const float* cw = args.in[7] + (size_t)l * 3 * 256;
                const int lane = opaque_i(tid) & 63;
                const int cgp = wave * 8 + (lane & 7), rsub = lane >> 3;
                for (int it = 0; it < 16; ++it) {
                    const int row = vcu * 128 + it * 8 + rsub, tl = row & (SEQ_ - 1);
                    const bf16* cpr = CP + (size_t)row * 1024; f32x4 o0, o1;
                    if (cgp < 32) {
                        const int c0 = cgp * 8; f32x4 a0 = {0.f, 0.f, 0.f, 0.f}, a1 = a0;
#pragma unroll
                        for (int j = 0; j < 3; ++j) { if (tl >= 2 - j) { const bf16* pr = cpr - (size_t)(2 - j) * 1024; const v4u xv = *(const v4u*)(pr + c0), cv = *(const v4u*)(pr + 512 + c0);
                                const f32x4 w0 = *(const f32x4*)(cw + j * 256 + c0), w1 = *(const f32x4*)(cw + j * 256 + c0 + 4);
                                a0 += w0 * (pg8::bf_lo4(xv.x, xv.y) * pg8::bf_lo4(cv.x, cv.y)); a1 += w1 * (pg8::bf_lo4(xv.z, xv.w) * pg8::bf_lo4(cv.z, cv.w)); } }
                        const v4u bv = *(const v4u*)(cpr + 256 + c0); o0 = a0 * pg8::bf_lo4(bv.x, bv.y); o1 = a1 * pg8::bf_lo4(bv.z, bv.w);
                    } else {
                        const int p0 = (cgp - 32) * 8, g = (cgp - 32) >> 3, w = 2 << g, n = (tl + 1) < w ? (tl + 1) : w;
                        const v4u cur = *(const v4u*)(cpr + 768 + p0); const f32x4 u0 = pg8::bf_lo4(cur.x, cur.y), u1 = pg8::bf_lo4(cur.z, cur.w); f32x4 s0 = u0, s1 = u1;
                        for (int j = 1; j < n; ++j) { const v4u pv = *(const v4u*)(cpr - (size_t)j * 1024 + 768 + p0); s0 += pg8::bf_lo4(pv.x, pv.y); s1 += pg8::bf_lo4(pv.z, pv.w); }
                        const float inv = 1.0f / (float)n; o0 = s0 * inv - u0; o1 = s1 * inv - u1;
                    }
                    *(v4u*)(CZ + (size_t)row * 512 + cgp * 8) = pg8::pack8(o0, o1);
                }
            }
            {
                __syncthreads();
                const int tid = opaque_i(threadIdx.x), lane = tid & 63;
                const int bh = vcu >> 2; LAS float* c2 = (LAS float*)(ldsl + attn_body::LDS_C2); LAS float* wsum = (LAS float*)(ldsl + attn_body::LDS_WSUM);
                const f32x4* p = (const f32x4*)(LOGF + (size_t)bh * SEQ_ + tid * 8); const f32x4 a = p[0], b = p[1];
                float v0 = a.x, v1 = v0 + a.y, v2 = v1 + a.z, v3 = v2 + a.w, v4 = v3 + b.x, v5 = v4 + b.y, v6 = v5 + b.z, v7 = v6 + b.w;
                float s = v7;
#pragma unroll
                for (int o = 1; o < 64; o <<= 1) { const float y = __shfl_up(s, o); if (lane >= o) s += y; }
                if (lane == 63) wsum[wave] = s;
                __syncthreads();
                float off = 0.f;
#pragma unroll
                for (int w = 0; w < 8; ++w) { const float t = wsum[w]; if (w < wave) off += t; }
                const float e = off + s - v7;
                f32x4 r0 = {-(e + v0) * LOG2E, -(e + v1) * LOG2E, -(e + v2) * LOG2E, -(e + v3) * LOG2E}, r1 = {-(e + v4) * LOG2E, -(e + v5) * LOG2E, -(e + v6) * LOG2E, -(e + v7) * LOG2E};
                *(LAS f32x4*)(c2 + tid * 8) = r0; *(LAS f32x4*)(c2 + tid * 8 + 4) = r1;
                __syncthreads();
            }
            const attn_body::AttnTensors AT{(const attn_body::bf16*)QO, (const attn_body::bf16*)KB, (const attn_body::bf16*)VB, (attn_body::bf16*)QO};
            const attn_body::StaticOrder S(G, bx);
            attn_body::attn_phase<attn_body::StaticOrder>((char*)lds, AT, S);
        }
#endif
        GSYNC();

#if (PHM >> 3) & 1
        {
            pg8::ProbMerge P{(const char*)QO, (const char*)CZ, (const char*)(wb + W_WM), 512, 896}; pg8::StaticOrder<3> S; S.init(MTOK, 1024, G, bx);
            pg8::EpiMerge E{GT, MG};
            pg8::gemm_phase<pg8::ProbMerge, pg8::EpiMerge, pg8::StaticOrder<3>, true, true>(ldsl, P, S, E);
        }
#endif
        GSYNC();

#if (PHM >> 4) & 1
        {
            pg8::ProbSimple P{(const char*)MG, (const char*)(wb + W_WO), 1024, 1024, 16}; pg8::StaticOrder<1> S; S.init(MTOK, 1024, G, bx);
            pg8::EpiResid E{l == 0 ? x_in : (const float*)out, out, XB, ssq_ffn};
            pg8::gemm_phase<pg8::ProbSimple, pg8::EpiResid, pg8::StaticOrder<1>, true, true>(ldsl, P, S, E);
        }
#endif
        GSYNC();

#if (PHM >> 5) & 1
        {
            pg8::ProbSimple P{(const char*)XB, (const char*)(wb + W_WFI), 1024, 1024, 16}; pg8::StaticOrder<1> S; S.init(MTOK, 2 * DFF, G, bx);
            pg8::EpiSwiGLU E{ssq_ffn, ACT};
            pg8::gemm_phase<pg8::ProbSimple, pg8::EpiSwiGLU, pg8::StaticOrder<1>, true, true>(ldsl, P, S, E);
        }
#endif
        GSYNC();

#if (PHM >> 6) & 1
        {
            pg8::ProbSimple P{(const char*)ACT, (const char*)(wb + W_WFO), DFF, DFF, DFF / 64}; pg8::StaticOrder<1> S; S.init(MTOK, 1024, G, bx);
            pg8::EpiResid E{(const float*)out, out, XB, ssq_nextmix};
            pg8::gemm_phase<pg8::ProbSimple, pg8::EpiResid, pg8::StaticOrder<1>, true, true>(ldsl, P, S, E);
        }
#endif
        if (l + 1 < NLAYER) GSYNC();
    }
}

extern "C" void kernel_launch(void* const* d_in, const int* in_sizes, int n_in, void* d_out, int out_size, void* d_ws, size_t ws_size, hipStream_t stream) {
    static int grid = 0;
    if (grid == 0) {
        if (n_in != 15 || out_size != MTOK * DMODEL || ws_size < WS_END) { fprintf(stderr, "kernel_launch: unexpected shapes (n_in %d out %d ws %zu)\n", n_in, out_size, ws_size); grid = -1; return; }
        int dev = 0, cus = 0, per_cu = 0;
        hipGetDevice(&dev); hipDeviceGetAttribute(&cus, hipDeviceAttributeMultiprocessorCount, dev);
        if (hipFuncSetAttribute((const void*)fwd_kernel, hipFuncAttributeMaxDynamicSharedMemorySize, LDS_BYTES) != hipSuccess) { fprintf(stderr, "kernel_launch: hipFuncSetAttribute failed\n"); grid = -1; return; }
        if (hipOccupancyMaxActiveBlocksPerMultiprocessor(&per_cu, (const void*)fwd_kernel, NWAVES * 64, LDS_BYTES) != hipSuccess || per_cu < 1) { fprintf(stderr, "kernel_launch: occupancy query says %d\n", per_cu); per_cu = 1; }
        (void)hipGetLastError();
        grid = cus;
        if (grid != 256) fprintf(stderr, "kernel_launch: %d CUs (built for 256)\n", grid);
    }
    if (grid < 0) return;
    Args a{};
    for (int i = 0; i < 15; ++i) a.in[i] = (const float*)d_in[i];
    a.out = (float*)d_out; a.ws = (unsigned char*)d_ws;
    void* kargs[] = {&a};
    hipError_t e = hipLaunchCooperativeKernel((const void*)fwd_kernel, dim3(grid), dim3(NWAVES * 64), kargs, LDS_BYTES, stream);
    if (e != hipSuccess) fprintf(stderr, "cooperative launch failed: %s (grid %d)\n", hipGetErrorString(e), grid);
}
```

```cpp
#include <hip/hip_runtime.h>
#include <hip/hip_cooperative_groups.h>
#include <hip/hip_bf16.h>
#include <cstdio>
#include <cstdint>
#include <cmath>
namespace cg = cooperative_groups;

#ifndef PHM
#define PHM 0xff
#endif
constexpr int NB = 8, SEQ_ = 4096, DMODEL = 1024, NLAYER = 4;
constexpr int MTOK = NB * SEQ_;
constexpr int DATT = 512, NHEADS = 8, DCONV = 256, DPOOL = 256, DFF = 2816;
constexpr int DIN_SRC = 5640;
constexpr int NIN = 5632;
constexpr float EPSN = 1e-6f;
constexpr float LOG2E = 1.4426950408889634f;
constexpr float QSCALE = 0.125f * LOG2E;

__device__ __forceinline__ int opaque_i(int v) { asm volatile("" : "+v"(v)); return v; }
namespace pg8 {
#define PG8_LAS __attribute__((address_space(3)))
typedef unsigned short bf16_t;
typedef short bf16x8 __attribute__((ext_vector_type(8)));
typedef float f32x4 __attribute__((ext_vector_type(4)));
typedef unsigned u32x4 __attribute__((ext_vector_type(4)));
constexpr int BM = 256, BK = 64, HALF = 128, HTB = HALF * BK * 2, STAGE_BYTES = 8 * HTB, NXCD = 8, WGM = 8;

__host__ __device__ __forceinline__ int lds_byte(int r, int c) { const int st = (r >> 4) * 2 + (c >> 5), rr = r & 15, cc = c & 31, ob = rr * 64 + cc * 2; return st * 1024 + (ob ^ (((ob >> 9) & 1) << 5)); }
__host__ __device__ __forceinline__ void stage_rc(int b, int& R, int& C) { const int st = b / 1024, sb = b % 1024, swz = sb ^ (((sb >> 9) & 1) << 5); R = (st >> 1) * 16 + swz / 64; C = (st & 1) * 32 + (swz % 64) / 2; }
__host__ __device__ __forceinline__ int perm32(int rho) { const int n = rho >> 4, i = rho & 15; return 8 * (i >> 2) + 4 * n + (i & 3); }

struct Unit { int pm, pn, sub; };
struct UMem { const char* A; const char* B; int nt; };

template <int NSUB> struct StaticOrder {
    int nM, nN, nwg, G, c;
    __device__ void init(int M, int N, int G_, int c_) { nM = M / BM; nN = N / BM; nwg = nM * nN; G = G_; c = c_; }
    __device__ bool next(int i, Unit& u) const {
        const int it = i / NSUB; u.sub = i - it * NSUB;
        const long L = (long)it * G + c; if (L >= nwg) return false;
        int wgid = (int)L; { const int q = nwg / NXCD, r = nwg % NXCD, xcd = wgid % NXCD, off = wgid / NXCD; wgid = (xcd < r ? xcd * (q + 1) : r * (q + 1) + (xcd - r) * q) + off; }
        const int nig = WGM * nN, gid = wgid / nig, fm = gid * WGM, gsz = (nM - fm) < WGM ? (nM - fm) : WGM;
        u.pm = fm + ((wgid % nig) % gsz); u.pn = (wgid % nig) / gsz; return true;
    }
};

__device__ __forceinline__ unsigned cvt_pk_bf16(float lo, float hi) { unsigned r; asm volatile("v_cvt_pk_bf16_f32 %0, %1, %2" : "=v"(r) : "v"(lo), "v"(hi)); return r; }
__device__ __forceinline__ f32x4 bf_lo4(unsigned a, unsigned b) { return (f32x4){__uint_as_float(a << 16), __uint_as_float(a & 0xffff0000u), __uint_as_float(b << 16), __uint_as_float(b & 0xffff0000u)}; }
__device__ __forceinline__ u32x4 pack8(f32x4 v0, f32x4 v1) { u32x4 w; w.x = cvt_pk_bf16(v0[0], v0[1]); w.y = cvt_pk_bf16(v0[2], v0[3]); w.z = cvt_pk_bf16(v1[0], v1[1]); w.w = cvt_pk_bf16(v1[2], v1[3]); return w; }
__device__ __forceinline__ float row_ssq(const float* p, int row) { const f32x4* q = (const f32x4*)(p + (size_t)row * 16); const f32x4 s = (q[0] + q[1]) + (q[2] + q[3]); return (s[0] + s[1]) + (s[2] + s[3]); }
__device__ __forceinline__ float row_ssq_q(const float* p, int row, int fq) { const f32x4 v = *(const f32x4*)(p + (size_t)row * 16 + 4 * fq); float s = (v[0] + v[1]) + (v[2] + v[3]); s += __shfl_xor(s, 16); s += __shfl_xor(s, 32); return s; }
__device__ __forceinline__ float fast_sigmoid(float v) { return __builtin_amdgcn_rcpf(1.0f + __expf(-v)); }


struct EpiInProj {
    const float* ssq; const float* qg; const float* kg; bf16_t* Q; bf16_t* Kb; bf16_t* V; bf16_t* CP; bf16_t* G;
    __device__ __forceinline__ bool keep(const Unit&) const { return false; }
    __device__ __forceinline__ void operator()(f32x4 (&acc)[2][2][4][2], const Unit& u, int wr, int wc, int fr, int fq) const {
        const int pn = u.pn; bf16_t* base; int ld, colt, mode; float post = 1.f; const float* gain = qg;
        if (pn < 2) { base = Q; ld = 512; colt = pn * 256; mode = 1; post = QSCALE; gain = qg; }
        else if (pn < 4) { base = Kb; ld = 512; colt = (pn - 2) * 256; mode = 1; gain = kg; }
        else if (pn < 6) { base = V; ld = 512; colt = (pn - 4) * 256; mode = 0; }
        else if (pn < 10) { base = CP; ld = 1024; colt = (pn - 6) * 256; mode = 0; }
        else { base = G; ld = 3072; colt = (pn - 10) * 256; mode = 2; }
        const int row0 = u.pm * BM + wr * 64 + fr, colw = colt + 64 * wc + 8 * fq;
        f32x4 gv[2][2];
#pragma unroll
        for (int bj = 0; bj < 2; ++bj)
#pragma unroll
            for (int n = 0; n < 2; ++n) gv[bj][n] = *(const f32x4*)(gain + 32 * bj + 8 * fq + 4 * n) * post;
#pragma unroll
        for (int ai = 0; ai < 2; ++ai) {
            float rs[4];
#pragma unroll
            for (int m = 0; m < 4; ++m) rs[m] = row_ssq_q(ssq, row0 + ai * HALF + m * 16, fq);
            asm volatile("" : "+v"(rs[0]), "+v"(rs[1]), "+v"(rs[2]), "+v"(rs[3]));
#pragma unroll
            for (int m = 0; m < 4; ++m) {
                const int row = row0 + ai * HALF + m * 16;
                const float r = rsqrtf(rs[m] * (1.0f / 1024.0f) + EPSN);
                f32x4 v[2][2];
#pragma unroll
                for (int bj = 0; bj < 2; ++bj)
#pragma unroll
                    for (int n = 0; n < 2; ++n) v[bj][n] = acc[ai][bj][m][n] * r;
                if (mode == 1) {
                    float s = 0.f;
#pragma unroll
                    for (int bj = 0; bj < 2; ++bj)
#pragma unroll
                        for (int n = 0; n < 2; ++n) { const f32x4 x = v[bj][n]; s += (x[0] * x[0] + x[1] * x[1]) + (x[2] * x[2] + x[3] * x[3]); }
                    s += __shfl_xor(s, 16); s += __shfl_xor(s, 32);
                    const float rn = rsqrtf(s * (1.0f / 64.0f) + EPSN);
#pragma unroll
                    for (int bj = 0; bj < 2; ++bj)
#pragma unroll
                        for (int n = 0; n < 2; ++n) v[bj][n] = v[bj][n] * rn * gv[bj][n];
                } else if (mode == 2) {
#pragma unroll
                    for (int bj = 0; bj < 2; ++bj)
#pragma unroll
                        for (int n = 0; n < 2; ++n) { f32x4 x = v[bj][n];
                            x[0] = fminf(__expf(-x[0]), 1e30f); x[1] = fminf(__expf(-x[1]), 1e30f); x[2] = fminf(__expf(-x[2]), 1e30f); x[3] = fminf(__expf(-x[3]), 1e30f); v[bj][n] = x; }
                }
                bf16_t* rowp = base + (size_t)row * ld + colw;
#pragma unroll
                for (int bj = 0; bj < 2; ++bj) *(u32x4*)(rowp + 32 * bj) = pack8(v[bj][0], v[bj][1]);
            }
        }
    }
};

struct EpiMerge {
    const bf16_t* G; bf16_t* Mg;
    __device__ __forceinline__ bool keep(const Unit& u) const { return u.sub < 2; }
    __device__ __forceinline__ void operator()(f32x4 (&acc)[2][2][4][2], const Unit& u, int wr, int wc, int fr, int fq) const {
        const int row0 = u.pm * BM + wr * 64 + fr, col0 = u.pn * BM + wc * 32 + 8 * fq, sub = u.sub;
        const bf16_t* gbase = G + (size_t)row0 * 3072 + col0 + (sub == 0 ? 0 : sub == 1 ? 1024 : 2048);
#pragma unroll
        for (int aih = 0; aih < 4; ++aih) { const int ai = aih >> 1, mlo = (aih & 1) * 2;
            u32x4 ga[4][2], gb[4][2];
#pragma unroll
            for (int m = mlo; m < mlo + 2; ++m)
#pragma unroll
                for (int bj = 0; bj < 2; ++bj) { const bf16_t* gp = gbase + (size_t)(ai * HALF + m * 16) * 3072 + bj * HALF;
                    ga[m][bj] = *(const u32x4*)gp; gb[m][bj] = ga[m][bj]; if (sub < 2) gb[m][bj] = *(const u32x4*)(gp + 1024); }
#pragma unroll
            for (int m = mlo; m < mlo + 2; ++m) {
                const int row = row0 + ai * HALF + m * 16;
#pragma unroll
                for (int bj = 0; bj < 2; ++bj) {
                    f32x4 f0 = bf_lo4(ga[m][bj].x, ga[m][bj].y) + 1.0f, f1 = bf_lo4(ga[m][bj].z, ga[m][bj].w) + 1.0f;
#pragma unroll
                    for (int j = 0; j < 4; ++j) { f0[j] = __builtin_amdgcn_rcpf(f0[j]); f1[j] = __builtin_amdgcn_rcpf(f1[j]); }
                    if (sub < 2) {
                        const f32x4 d0 = bf_lo4(gb[m][bj].x, gb[m][bj].y) + 1.0f, d1 = bf_lo4(gb[m][bj].z, gb[m][bj].w) + 1.0f;
                        acc[ai][bj][m][0] *= f0 * d0; acc[ai][bj][m][1] *= f1 * d1;
                    } else {
                        *(u32x4*)(Mg + (size_t)row * 1024 + col0 + bj * HALF) = pack8(acc[ai][bj][m][0] * f0, acc[ai][bj][m][1] * f1);
                    }
                }
            }
        }
    }
};

struct EpiResid {
    float* out; bf16_t* XB; float* ssq_next;
    __device__ __forceinline__ bool keep(const Unit&) const { return false; }
    __device__ __forceinline__ void operator()(f32x4 (&acc)[2][2][4][2], const Unit& u, int wr, int wc, int fr, int fq) const {
        const int row0 = u.pm * BM + wr * 64 + fr, col0 = u.pn * BM + wc * 32 + 8 * fq;
#pragma unroll
        for (int ai = 0; ai < 2; ++ai) {
            u32x4 xo[2][4][2];
#pragma unroll
            for (int m = 0; m < 4; ++m)
#pragma unroll
                for (int bj = 0; bj < 2; ++bj) xo[ai][m][bj] = *(const u32x4*)(XB + (size_t)(row0 + ai * HALF + m * 16) * 1024 + col0 + bj * HALF);
#pragma unroll
            for (int m = 0; m < 4; ++m) {
                const int row = row0 + ai * HALF + m * 16; const size_t off = (size_t)row * 1024 + col0;
                float s = 0.f;
#pragma unroll
                for (int bj = 0; bj < 2; ++bj) {
                    const u32x4 xv = xo[ai][m][bj];
                    const f32x4 x0 = bf_lo4(xv.x, xv.y) + acc[ai][bj][m][0], x1 = bf_lo4(xv.z, xv.w) + acc[ai][bj][m][1];
                    if (out) { *(f32x4*)(out + off + bj * HALF) = x0; *(f32x4*)(out + off + bj * HALF + 4) = x1; }
                    else *(u32x4*)(XB + off + bj * HALF) = pack8(x0, x1);
                    s += (x0[0] * x0[0] + x0[1] * x0[1]) + (x0[2] * x0[2] + x0[3] * x0[3]) + (x1[0] * x1[0] + x1[1] * x1[1]) + (x1[2] * x1[2] + x1[3] * x1[3]);
                }
                if (ssq_next) { s += __shfl_xor(s, 16); s += __shfl_xor(s, 32); if (fq == 0) ssq_next[(size_t)row * 16 + u.pn * 4 + wc] = s; }
            }
        }
    }
};

struct EpiSwiGLU {
    const float* ssq; bf16_t* ACT;
    __device__ __forceinline__ bool keep(const Unit&) const { return false; }
    __device__ __forceinline__ void operator()(f32x4 (&acc)[2][2][4][2], const Unit& u, int wr, int wc, int fr, int fq) const {
        const int row0 = u.pm * BM + wr * 64 + fr, col0 = u.pn * HALF + wc * 32 + 8 * fq;
        float rs[2][4];
#pragma unroll
        for (int ai = 0; ai < 2; ++ai)
#pragma unroll
            for (int m = 0; m < 4; ++m) rs[ai][m] = row_ssq_q(ssq, row0 + ai * HALF + m * 16, fq);
#pragma unroll
        for (int ai = 0; ai < 2; ++ai)
#pragma unroll
            for (int m = 0; m < 4; ++m) {
                const int row = row0 + ai * HALF + m * 16;
                const float r = rsqrtf(rs[ai][m] * (1.0f / 1024.0f) + EPSN);
                f32x4 o[2];
#pragma unroll
                for (int n = 0; n < 2; ++n) { const f32x4 g = acc[ai][0][m][n] * r, up = acc[ai][1][m][n] * r;
#pragma unroll
                    for (int j = 0; j < 4; ++j) o[n][j] = g[j] * fast_sigmoid(g[j]) * up[j]; }
                *(u32x4*)(ACT + (size_t)row * DFF + col0) = pack8(o[0], o[1]);
            }
    }
};

struct ProbSimple { const char* A; const char* B; int lda, ldb, nt;
    __device__ __forceinline__ UMem mem(const Unit& u) const { UMem m; m.A = A + (size_t)u.pm * BM * lda * 2; m.B = B + (size_t)u.pn * BM * ldb * 2; m.nt = nt; return m; } };
struct ProbMerge { const char* O; const char* CZ; const char* WM; int lda, ldb;
    __device__ __forceinline__ UMem mem(const Unit& u) const { UMem m; const size_t ar = (size_t)u.pm * BM * 512 * 2, br = (size_t)u.pn * BM * 896 * 2;
        if (u.sub == 0) { m.A = O + ar; m.B = WM + br; m.nt = 8; }
        else if (u.sub == 1) { m.A = CZ + ar; m.B = WM + br + 512 * 2; m.nt = 4; }
        else { m.A = CZ + ar + (256 + 128 * (u.pn >> 1)) * 2; m.B = WM + br + 768 * 2; m.nt = 2; }
        return m; } };

template <class Prob, class Epi, class Sched, bool ALIGN_EPI, bool SP2>
__device__ __forceinline__ void gemm_phase(PG8_LAS unsigned char* lds, const Prob& P, const Sched& S, const Epi& E) {
    const int tid = opaque_i(threadIdx.x), wid = __builtin_amdgcn_readfirstlane(tid >> 6), lane = tid & 63, wr = wid >> 2, wc = wid & 3, fr = lane & 15, fq = lane >> 4;
    unsigned voffA[2], voffB[2];
#pragma unroll
    for (int i = 0; i < 2; ++i) { int R, C; stage_rc(tid * 16 + i * 8192, R, C); const int Rb = (R & ~31) + perm32(R & 31);
        voffA[i] = (unsigned)(R * P.lda + C) * 2u; voffB[i] = (unsigned)(Rb * P.ldb + C) * 2u; }
    const size_t kstep = (size_t)(BK * 2);
    const size_t hstepA = (size_t)HALF * P.lda * 2, hstepB = (size_t)HALF * P.ldb * 2;
    const unsigned ldsw = (unsigned)wid * 1024u;
    const int aoff = lds_byte(wr * 64 + fr, fq * 8), boff = lds_byte(wc * 32 + fr, fq * 8);
#define PG8_SA(b, h) (((b) * 2 + (h)) * HTB)
#define PG8_SB(b, h) ((4 + (b) * 2 + (h)) * HTB)
#define PG8_STAGE(bufoff, gbase, voff) do { _Pragma("unroll") for (int _i = 0; _i < 2; ++_i) \
        __builtin_amdgcn_global_load_lds((const unsigned*)((const char*)(gbase) + (voff)[_i]), (PG8_LAS unsigned*)(lds + (bufoff) + ldsw + _i * 8192), 16, 0, 0); } while (0)
#define PG8_LDA(dst, b, h) do { _Pragma("unroll") for (int m = 0; m < 4; ++m) _Pragma("unroll") for (int k = 0; k < 2; ++k) dst[m][k] = *(const PG8_LAS bf16x8*)(lds + PG8_SA(b, h) + aoff + m * 2048 + k * 1024); } while (0)
#define PG8_LDB(dst, b, h) do { _Pragma("unroll") for (int n = 0; n < 2; ++n) _Pragma("unroll") for (int k = 0; k < 2; ++k) dst[n][k] = *(const PG8_LAS bf16x8*)(lds + PG8_SB(b, h) + boff + n * 2048 + k * 1024); } while (0)
#define PG8_MMA(ai, bj, At, Bt) do { __builtin_amdgcn_s_setprio(1); _Pragma("unroll") for (int m = 0; m < 4; ++m) _Pragma("unroll") for (int n = 0; n < 2; ++n) _Pragma("unroll") for (int k = 0; k < 2; ++k) \
        acc[ai][bj][m][n] = __builtin_amdgcn_mfma_f32_16x16x32_bf16(Bt[n][k], At[m][k], acc[ai][bj][m][n], 0, 0, 0); __builtin_amdgcn_s_setprio(0); } while (0)
#define PG8_WAIT_V(n) asm volatile("s_waitcnt vmcnt(" #n ")" ::: "memory")
#define PG8_WAIT_L(n) asm volatile("s_waitcnt lgkmcnt(" #n ")" ::: "memory")
#define PG8_BAR __builtin_amdgcn_s_barrier()
#define PG8_SCHED __builtin_amdgcn_sched_barrier(0)
    Unit cur, nxt; int ui = 0;
    if (!S.next(0, cur)) return;
    f32x4 acc[2][2][4][2];
#pragma unroll
    for (int a = 0; a < 2; ++a)
#pragma unroll
        for (int b = 0; b < 2; ++b)
#pragma unroll
            for (int m = 0; m < 4; ++m)
#pragma unroll
                for (int n = 0; n < 2; ++n) acc[a][b][m][n] = (f32x4){0.f, 0.f, 0.f, 0.f};
    bf16x8 At[4][2], B0[2][2], B1[2][2];
    UMem cm = P.mem(cur);
    const char* cA = cm.A; const char* cB = cm.B; int nt = cm.nt;
    if constexpr (SP2) {
        PG8_STAGE(PG8_SB(0, 0), cB, voffB); PG8_STAGE(PG8_SB(0, 1), cB + hstepB, voffB); PG8_STAGE(PG8_SA(0, 0), cA, voffA); PG8_STAGE(PG8_SA(0, 1), cA + hstepA, voffA);
        if (wr == 1) PG8_BAR;
        PG8_WAIT_V(2); PG8_BAR;
        PG8_STAGE(PG8_SB(1, 0), cB + kstep, voffB); PG8_STAGE(PG8_SA(1, 0), cA + kstep, voffA); PG8_STAGE(PG8_SB(1, 1), cB + hstepB + kstep, voffB);
        PG8_WAIT_V(6); PG8_BAR;
    } else {
        PG8_STAGE(PG8_SB(0, 0), cB, voffB); PG8_STAGE(PG8_SA(0, 0), cA, voffA); PG8_STAGE(PG8_SB(0, 1), cB + hstepB, voffB); PG8_STAGE(PG8_SA(0, 1), cA + hstepA, voffA);
        if (wr == 1) PG8_BAR;
        PG8_WAIT_V(4); PG8_BAR;
        PG8_STAGE(PG8_SB(1, 0), cB + kstep, voffB); PG8_STAGE(PG8_SA(1, 0), cA + kstep, voffA); PG8_STAGE(PG8_SB(1, 1), cB + hstepB + kstep, voffB);
        PG8_WAIT_V(6); PG8_BAR;
    }
    for (;;) {
        const bool has_next = S.next(ui + 1, nxt);
        UMem nm = cm; if (has_next) nm = P.mem(nxt);
        const char* nA = has_next ? nm.A : cA; const char* nB = has_next ? nm.B : cB;
        for (int t = 0; t < nt; t += 2) {
            const bool last = (t == nt - 2);
            const char* a1 = cA + (size_t)(t + 1) * kstep;
            const char* a2 = last ? nA : cA + (size_t)(t + 2) * kstep; const char* b2 = last ? nB : cB + (size_t)(t + 2) * kstep;
            const char* a3 = a2 + kstep; const char* b3 = b2 + kstep;
            if constexpr (SP2) {
            PG8_LDB(B0, 0, 0); PG8_LDB(B1, 0, 1); PG8_SCHED; PG8_LDA(At, 0, 0); PG8_STAGE(PG8_SA(1, 1), a1 + hstepA, voffA);
            PG8_WAIT_V(8); PG8_WAIT_L(0); PG8_BAR; PG8_MMA(0, 0, At, B0); PG8_MMA(0, 1, At, B1); PG8_BAR; PG8_SCHED;
            PG8_LDA(At, 0, 1); PG8_STAGE(PG8_SB(0, 0), b2, voffB); PG8_STAGE(PG8_SB(0, 1), b2 + hstepB, voffB); PG8_STAGE(PG8_SA(0, 0), a2, voffA);
            PG8_WAIT_V(8); PG8_WAIT_L(0); PG8_BAR; PG8_MMA(1, 0, At, B0); PG8_MMA(1, 1, At, B1); PG8_BAR; PG8_SCHED;
            PG8_LDB(B0, 1, 0); PG8_LDB(B1, 1, 1); PG8_SCHED; PG8_LDA(At, 1, 0); PG8_STAGE(PG8_SA(0, 1), a2 + hstepA, voffA);
            PG8_WAIT_V(8); PG8_WAIT_L(0); PG8_BAR; PG8_MMA(0, 0, At, B0); PG8_MMA(0, 1, At, B1); PG8_BAR; PG8_SCHED;
            PG8_LDA(At, 1, 1); PG8_STAGE(PG8_SB(1, 0), b3, voffB); PG8_STAGE(PG8_SB(1, 1), b3 + hstepB, voffB); PG8_STAGE(PG8_SA(1, 0), a3, voffA);
            PG8_WAIT_V(8); PG8_WAIT_L(0); PG8_BAR; PG8_MMA(1, 0, At, B0); PG8_MMA(1, 1, At, B1); PG8_BAR; PG8_SCHED;
            } else {
            PG8_LDB(B0, 0, 0); PG8_SCHED; PG8_LDA(At, 0, 0); PG8_STAGE(PG8_SA(1, 1), a1 + hstepA, voffA);
            PG8_WAIT_L(8); PG8_BAR; PG8_WAIT_L(0); PG8_MMA(0, 0, At, B0); PG8_BAR; PG8_SCHED;
            PG8_LDB(B1, 0, 1); PG8_STAGE(PG8_SB(0, 0), b2, voffB);
            PG8_BAR; PG8_WAIT_L(0); PG8_MMA(0, 1, At, B1); PG8_BAR;
            PG8_LDA(At, 0, 1); PG8_STAGE(PG8_SA(0, 0), a2, voffA);
            PG8_BAR; PG8_WAIT_L(0); PG8_MMA(1, 0, At, B0); PG8_BAR; PG8_SCHED;
            PG8_STAGE(PG8_SB(0, 1), b2 + hstepB, voffB);
            PG8_WAIT_V(6); PG8_BAR; PG8_MMA(1, 1, At, B1); PG8_BAR;
            PG8_LDB(B0, 1, 0); PG8_SCHED; PG8_LDA(At, 1, 0); PG8_STAGE(PG8_SA(0, 1), a2 + hstepA, voffA);
            PG8_WAIT_L(8); PG8_BAR; PG8_WAIT_L(0); PG8_MMA(0, 0, At, B0); PG8_BAR; PG8_SCHED;
            PG8_LDB(B1, 1, 1); PG8_STAGE(PG8_SB(1, 0), b3, voffB);
            PG8_BAR; PG8_WAIT_L(0); PG8_MMA(0, 1, At, B1); PG8_BAR;
            PG8_LDA(At, 1, 1); PG8_STAGE(PG8_SA(1, 0), a3, voffA);
            PG8_BAR; PG8_WAIT_L(0); PG8_MMA(1, 0, At, B0); PG8_BAR; PG8_SCHED;
            PG8_STAGE(PG8_SB(1, 1), b3 + hstepB, voffB);
            PG8_WAIT_V(6); PG8_BAR; PG8_MMA(1, 1, At, B1); PG8_BAR;
            }
        }
        if constexpr (ALIGN_EPI) { if (wr == 0) PG8_BAR; }
        E(acc, cur, wr, wc, fr, fq);
        if (!has_next) break;
        if (!E.keep(cur)) {
#pragma unroll
        for (int a = 0; a < 2; ++a)
#pragma unroll
            for (int b = 0; b < 2; ++b)
#pragma unroll
                for (int m = 0; m < 4; ++m)
#pragma unroll
                    for (int n = 0; n < 2; ++n) acc[a][b][m][n] = (f32x4){0.f, 0.f, 0.f, 0.f};
        }
        cur = nxt; cm = nm; cA = nA; cB = nB; nt = nm.nt; ++ui;
        if constexpr (ALIGN_EPI) { if (wr == 1) PG8_BAR; }
    }
    PG8_WAIT_V(0);
    if constexpr (!ALIGN_EPI) { if (wr == 0) PG8_BAR; }
    PG8_BAR;
#undef PG8_SA
#undef PG8_SB
#undef PG8_STAGE
#undef PG8_LDA
#undef PG8_LDB
#undef PG8_MMA
#undef PG8_WAIT_V
#undef PG8_WAIT_L
#undef PG8_BAR
#undef PG8_SCHED
}
}
namespace attn_body {
using bf16=__hip_bfloat16;
using bf16x8=__attribute__((ext_vector_type(8)))short;
using s16x4=__attribute__((ext_vector_type(4)))short;
using f32x16=__attribute__((ext_vector_type(16)))float;
using u32x4=__attribute__((ext_vector_type(4)))unsigned;
using f32x4v=__attribute__((ext_vector_type(4)))float;
constexpr int BATCH=8,NHEAD=8,SEQ=4096,D=64,DM=NHEAD*D;
constexpr int NW=8,QBLK=32,QB=QBLK*NW,KVBLK=64,NQB=SEQ/QB;
constexpr int ATTN_PITCH=DM, ATTN_UNIT_ROWS=QB;
__device__ __forceinline__ int crow(int r,int hi){return (r&3)+8*(r>>2)+4*hi;}
#define SBAR() __builtin_amdgcn_sched_barrier(0)
__device__ __forceinline__ void cmask(f32x16&p0,f32x16&p1,int jb,int qrel,int hi){
  const float NEG=-INFINITY; int kb=64*jb+4*hi;
  #pragma unroll
  for(int r=0;r<16;++r){int kv=kb+(r&3)+8*(r>>2); if(kv>qrel)p0[r]=NEG; if(kv+32>qrel)p1[r]=NEG;}
}

constexpr int NSLOT=3, SLOTB=8192;
constexpr int LDS_K=0, LDS_V=NSLOT*SLOTB, LDS_WS=2*NSLOT*SLOTB, LDS_OST=LDS_WS+NW*64*4, LDS_C2=LDS_OST+NW*4096, LDS_WSUM=LDS_C2+SEQ*4, LDS_KX=LDS_WSUM+64, LDS_BYTES=LDS_KX+SEQ*8;
constexpr float C2=0.125f*1.4426950408889634f;
__device__ __forceinline__ void glds16(const void*gsrc,unsigned lds_dst){unsigned keep;
  asm volatile("s_mov_b32 %0, m0\n\ts_mov_b32 m0, %2\n\ts_nop 0\n\tglobal_load_lds_dwordx4 %1, off\n\ts_mov_b32 m0, %0":"=&s"(keep):"v"(gsrc),"s"(lds_dst):"memory");}
__device__ __forceinline__ float max3f(float a,float b,float c){float r;asm("v_max3_f32 %0, %1, %2, %3":"=v"(r):"v"(a),"v"(b),"v"(c));return r;}
__device__ __forceinline__ float max2f(float a,float b){float r;asm("v_max_f32_e32 %0, %1, %2":"=v"(r):"v"(a),"v"(b));return r;}
__device__ __forceinline__ float fadd_s(float a,float b){float r;asm("v_add_f32_e32 %0, %1, %2":"=v"(r):"v"(a),"v"(b));return r;}
__device__ __forceinline__ float fsub_s(float a,float b){float r;asm("v_sub_f32_e32 %0, %1, %2":"=v"(r):"v"(a),"v"(b));return r;}
typedef float f32x2_t __attribute__((ext_vector_type(2))); typedef __bf16 bf16x2_t __attribute__((ext_vector_type(2)));
__device__ __forceinline__ unsigned cvtpk_s(float lo,float hi){f32x2_t v={lo,hi};bf16x2_t b=__builtin_convertvector(v,bf16x2_t);return __builtin_bit_cast(unsigned,b);}
#define WAIT_BAR(N) asm volatile("s_waitcnt vmcnt(" #N ") lgkmcnt(0)\n\ts_barrier":::"memory")

__device__ __forceinline__ void qkt(f32x16&p0,f32x16&p1,const char*Kslot,const bf16x8*qr,int r32,int hi){
  const char*kb=Kslot+hi*1024+r32*16;
  #pragma unroll
  for(int d0=0;d0<4;++d0){
    const bf16x8 b0=*reinterpret_cast<const bf16x8*>(kb+d0*2048);
    const bf16x8 b1=*reinterpret_cast<const bf16x8*>(kb+d0*2048+512);
    {p0=__builtin_amdgcn_mfma_f32_32x32x16_bf16(b0,qr[d0],p0,0,0,0);p1=__builtin_amdgcn_mfma_f32_32x32x16_bf16(b1,qr[d0],p1,0,0,0);}}
}
typedef __attribute__((address_space(3))) const char* lds_cptr;
typedef short v4i16_t __attribute__((ext_vector_type(4)));
__device__ __forceinline__ void kload8(bf16x8*kf,lds_cptr kp){
  kf[0]=*(const __attribute__((address_space(3))) bf16x8*)(kp);      kf[1]=*(const __attribute__((address_space(3))) bf16x8*)(kp+512);
  kf[2]=*(const __attribute__((address_space(3))) bf16x8*)(kp+2048); kf[3]=*(const __attribute__((address_space(3))) bf16x8*)(kp+2560);
  kf[4]=*(const __attribute__((address_space(3))) bf16x8*)(kp+4096); kf[5]=*(const __attribute__((address_space(3))) bf16x8*)(kp+4608);
  kf[6]=*(const __attribute__((address_space(3))) bf16x8*)(kp+6144); kf[7]=*(const __attribute__((address_space(3))) bf16x8*)(kp+6656);
}
__device__ __forceinline__ void kload2(bf16x8*kf,lds_cptr kp,int j){ kf[2*j]=*(const __attribute__((address_space(3))) bf16x8*)(kp+j*2048); kf[2*j+1]=*(const __attribute__((address_space(3))) bf16x8*)(kp+j*2048+512); }
__device__ __forceinline__ s16x4 vtr(lds_cptr p){ return __builtin_bit_cast(s16x4,__builtin_amdgcn_ds_read_tr16_b64_v4i16((__attribute__((address_space(3))) v4i16_t*)p)); }
__device__ __forceinline__ float rowmax(const f32x16&p0,const f32x16&p1){
  float a=max3f(p0[0],p0[1],p1[0]),b=max3f(p0[2],p0[3],p1[1]);a=max3f(a,p1[2],p1[3]);
  #pragma unroll
  for(int r=4;r<16;r+=4){a=max3f(a,p0[r],p0[r+1]);b=max3f(b,p0[r+2],p0[r+3]);a=max3f(a,p1[r],p1[r+1]);b=max3f(b,p1[r+2],p1[r+3]);}
  const float m=max2f(a,b);
  auto rr=__builtin_amdgcn_permlane32_swap(__float_as_uint(m),__float_as_uint(m),false,false);
  return max2f(__uint_as_float(rr[0]),__uint_as_float(rr[1]));
}
__device__ __forceinline__ void pv(f32x16*o,int vb,bf16x8 pa0,bf16x8 pa1,bf16x8 pa2,bf16x8 pa3){
  #pragma unroll
  for(int d0=0;d0<2;++d0){s16x4 lo[4],hi[4];
    #pragma unroll
    for(int ks=0;ks<4;++ks){
      asm volatile("ds_read_b64_tr_b16 %0,%1 offset:%c2":"=&v"(lo[ks]):"v"(vb),"i"(d0*4096+ks*1024):"memory");
      asm volatile("ds_read_b64_tr_b16 %0,%1 offset:%c2":"=&v"(hi[ks]):"v"(vb),"i"(d0*4096+ks*1024+512):"memory");}
    asm volatile("s_waitcnt lgkmcnt(0)":::"memory");SBAR();
    #define PK(k) (bf16x8){lo[k][0],lo[k][1],lo[k][2],lo[k][3],hi[k][0],hi[k][1],hi[k][2],hi[k][3]}
    o[d0]=__builtin_amdgcn_mfma_f32_32x32x16_bf16(pa0,PK(0),o[d0],0,0,0);
    o[d0]=__builtin_amdgcn_mfma_f32_32x32x16_bf16(pa1,PK(1),o[d0],0,0,0);
    o[d0]=__builtin_amdgcn_mfma_f32_32x32x16_bf16(pa2,PK(2),o[d0],0,0,0);
    o[d0]=__builtin_amdgcn_mfma_f32_32x32x16_bf16(pa3,PK(3),o[d0],0,0,0);
    #undef PK
  }
}

#ifndef ATTN_STORE16
#define ATTN_STORE16(p,v) (*(u32x4*)(p)=(v))
#endif
template<int THRL> __device__ __forceinline__ void attn_unit(int b,int h,int qb,const bf16*Q,const bf16*__restrict__ K,const bf16*__restrict__ V,bf16*O,char*shm,float dthr2,float mref2){
  typedef __attribute__((address_space(3))) const float* lds_cf; typedef __attribute__((address_space(3))) const f32x4v* lds_cf4;
  const int tid=opaque_i(threadIdx.x),lane=tid&63,r32=lane&31,hi=lane>>5; const int wid=__builtin_amdgcn_readfirstlane(tid>>6);
  const long rowbase=(long)b*SEQ; const int q0=qb*QB;
  const bf16*Qw=Q+(rowbase+q0+wid*QBLK)*DM+h*D;
  int T0;
  { const lds_cf c2all=(lds_cf)((lds_cptr)shm+LDS_C2); const float thr=c2all[q0]-dthr2; const bool skp=c2all[64*lane+63]<thr; const unsigned long long bal=__ballot(skp);
    const int nskip=(~bal==0ull)?64:(int)__builtin_ctzll(~bal); const int ntf=(q0+QB)/KVBLK; int t0=nskip&~1; if(t0>ntf-4)t0=ntf-4; T0=__builtin_amdgcn_readfirstlane(t0); }
  const bf16*Kh=K+(rowbase+(long)T0*KVBLK)*DM+h*D,*Vh=V+(rowbase+(long)T0*KVBLK)*DM+h*D;
  const unsigned lds0=(unsigned)(uintptr_t)shm;
  float*wsf=(float*)(shm+LDS_WS)+wid*64;
  const bf16*ksrc=Kh+(long)lane*DM+wid*8;
  const bf16*vsrc=Vh+(long)(16*(wid&3)+(lane>>2))*DM+(wid>>2)*32+(lane&3)*8;
  const unsigned kdst=lds0+LDS_K+wid*1024, vdst=lds0+LDS_V+wid*1024;
  #define DMA_K(t,slot) glds16(ksrc+(long)(t)*KVBLK*DM,(unsigned)__builtin_amdgcn_readfirstlane(kdst+(slot)))
  #define DMA_V(t,slot) glds16(vsrc+(long)(t)*KVBLK*DM,(unsigned)__builtin_amdgcn_readfirstlane(vdst+(slot)))
  const int vb0=(int)(lds0+LDS_V)+((lane>>4)&1)*32+(lane&3)*8+(4*hi+((lane&15)>>2))*64;
  const char*Kbase=shm+LDS_K; bf16x8 kf[8];
  const lds_cptr shm3=(lds_cptr)shm; const lds_cptr kp0=shm3+LDS_K+hi*1024+r32*16; const lds_cptr vp0=shm3+LDS_V+((lane>>4)&1)*32+(lane&3)*8+(4*hi+((lane&15)>>2))*64;
  const int NT=(q0+QB)/KVBLK-T0;
  DMA_K(0,0);DMA_V(0,0);DMA_K(1,SLOTB);
  bf16x8 qr[4];
  #pragma unroll
  for(int d0=0;d0<4;++d0)qr[d0]=*reinterpret_cast<const bf16x8*>(&Qw[(long)r32*DM+d0*16+hi*8]);
  float l_reg=0.f;f32x16 o[2];o[0]=f32x16{};o[1]=f32x16{};
  const float k0c=-(((lds_cf)((lds_cptr)shm+LDS_C2))[q0+wid*QBLK+r32]+mref2);
  bf16x8 qx;
  { const unsigned h_=__float_as_uint(k0c); const unsigned kh=(h_+0x7fffu+((h_>>16)&1u))>>16; const float r1_=k0c-__uint_as_float(kh<<16);
    const unsigned m_=__float_as_uint(r1_); const unsigned km=(m_+0x7fffu+((m_>>16)&1u))>>16; const float r2_=r1_-__uint_as_float(km<<16);
    const unsigned l_=__float_as_uint(r2_); const unsigned kl=(l_+0x7fffu+((l_>>16)&1u))>>16;
    u32x4 w_; w_.x=hi?0u:0x3F803F80u; w_.y=hi?0u:(0x3F80u|(kh<<16)); w_.z=hi?0u:(km|(kl<<16)); w_.w=0u; qx=__builtin_bit_cast(bf16x8,w_); }
  typedef __attribute__((address_space(3))) const unsigned long long* lds_cu64;
  const lds_cu64 kxp=(lds_cu64)((lds_cptr)shm+LDS_KX)+T0*KVBLK+r32;
  #define KXF(v_) __builtin_bit_cast(bf16x8,(u32x4){(unsigned)(v_),(unsigned)((v_)>>32),0x3F803F80u,0u})
  #define CINIT(C0,C1,t) do{ const unsigned long long a_=kxp[(t)*KVBLK], b_=kxp[(t)*KVBLK+32]; const f32x16 z_=f32x16{}; \
    C0=__builtin_amdgcn_mfma_f32_32x32x16_bf16(KXF(a_),qx,z_,0,0,0); C1=__builtin_amdgcn_mfma_f32_32x32x16_bf16(KXF(b_),qx,z_,0,0,0); }while(0)
  const int qrel=wid*QBLK+r32;
  #define CMASK(P0,P1,t) do{int jb_=(t)-(NT-4); if(jb_>=0)cmask(P0,P1,jb_,qrel,hi);}while(0)
  #define START(P0,P1) do{ _Pragma("unroll") for(int r=0;r<16;++r)P0[r]=__builtin_amdgcn_exp2f(P0[r]); }while(0)
  #define RESC() do{}while(0)
  f32x16 pA0,pA1,pB0,pB1;
  int sl_prev=0,sl_cur=0,sl_next=SLOTB;
  #define ROT() do{sl_prev=sl_cur;sl_cur=sl_next;sl_next=(sl_next==(NSLOT-1)*SLOTB)?0:sl_next+SLOTB;}while(0)
  DMA_K(2,2*SLOTB);
  WAIT_BAR(3);
  CINIT(pA0,pA1,0); qkt(pA0,pA1,Kbase,qr,r32,hi);asm volatile("s_nop 15\n\ts_nop 7":"+v"(pA0),"+v"(pA1));CMASK(pA0,pA1,0);
  START(pA0,pA1);
  _Pragma("unroll") for(int r=0;r<16;++r)pA1[r]=__builtin_amdgcn_exp2f(pA1[r]);
  WAIT_BAR(0);
  DMA_K(3,0);DMA_V(1,SLOTB);
  ROT();
  kload8(kf,kp0+sl_cur);
  WAIT_BAR(2);
  s16x4 vlo[8],vhi[8]; u32x4 pw0,pw1,pw2,pw3;
  #define PKW(P,B) cvtpk_s(P[B],P[B+1])
  #define PAF(k) __builtin_bit_cast(bf16x8,pw##k)
  #define VFR(i) (bf16x8){vlo[i][0],vlo[i][1],vlo[i][2],vlo[i][3],vhi[i][0],vhi[i][1],vhi[i][2],vhi[i][3]}
  #define PIN(x) asm volatile("":"+v"(x))
  #define MX3(a,b,c) __builtin_fmaxf(__builtin_fmaxf((a),(b)),(c))
  #define GAPA(MF,A0,A1,A2,A3,W0,W1,PW) do{ MF; sacc+=A0; sacc+=A1; sacc+=A2; sacc+=A3; PIN(sacc); W0; W1; PIN(PW); SBAR(); }while(0)
  #define EX(v) __builtin_amdgcn_exp2f(v)
  #define GAPB(MF,X,B) do{ MF; X[B]=EX(X[B]); X[B+1]=EX(X[B+1]); X[B+2]=EX(X[B+2]); X[B+3]=EX(X[B+3]); PIN(X); SBAR(); }while(0)
  #define VRD(i) do{ vlo[i]=vtr(vp_+(((i)>>2)*4096+((i)&3)*1024)); vhi[i]=vtr(vp_+(((i)>>2)*4096+((i)&3)*1024+512)); }while(0)
  #define KRD(G,j) do{ if(G){ kload2(kf,kp0+sl_next,j); SBAR(); } }while(0)
  #define STEP(C0,C1,P0,P1,t,GK,GV,GL) do{ SBAR(); CINIT(C0,C1,t); SBAR(); \
    const lds_cptr vp_=vp0+sl_prev; \
    VRD(0); SBAR(); float sacc=(P0[0]+P0[1]); \
    GAPA(C0=__builtin_amdgcn_mfma_f32_32x32x16_bf16(kf[0],qr[0],C0,0,0,0), P0[2],P0[3],P0[4],P0[5],     pw0[0]=PKW(P0,0), pw0[1]=PKW(P0,2), pw0); \
    VRD(4); SBAR(); GAPA(C1=__builtin_amdgcn_mfma_f32_32x32x16_bf16(kf[1],qr[0],C1,0,0,0), P0[6],P0[7],P0[8],P0[9],     pw0[2]=PKW(P0,4), pw0[3]=PKW(P0,6), pw0); \
    VRD(1); SBAR(); GAPA(C0=__builtin_amdgcn_mfma_f32_32x32x16_bf16(kf[2],qr[1],C0,0,0,0),   P0[10],P0[11],P0[12],P0[13], pw1[0]=PKW(P0,8), pw1[1]=PKW(P0,10), pw1); \
    VRD(5); SBAR(); GAPA(C1=__builtin_amdgcn_mfma_f32_32x32x16_bf16(kf[3],qr[1],C1,0,0,0),   P0[14],P0[15],P1[0],P1[1],   pw1[2]=PKW(P0,12),pw1[3]=PKW(P0,14), pw1); \
    VRD(2); SBAR(); GAPA(C0=__builtin_amdgcn_mfma_f32_32x32x16_bf16(kf[4],qr[2],C0,0,0,0),   P1[2],P1[3],P1[4],P1[5],     pw2[0]=PKW(P1,0), pw2[1]=PKW(P1,2), pw2); \
    VRD(6); SBAR(); GAPA(C1=__builtin_amdgcn_mfma_f32_32x32x16_bf16(kf[5],qr[2],C1,0,0,0),   P1[6],P1[7],P1[8],P1[9],     pw2[2]=PKW(P1,4), pw2[3]=PKW(P1,6), pw2); \
    VRD(3); SBAR(); GAPA(C0=__builtin_amdgcn_mfma_f32_32x32x16_bf16(kf[6],qr[3],C0,0,0,0),   P1[10],P1[11],P1[12],P1[13], pw3[0]=PKW(P1,8), pw3[1]=PKW(P1,10), pw3); \
    VRD(7); SBAR(); GAPA(C1=__builtin_amdgcn_mfma_f32_32x32x16_bf16(kf[7],qr[3],C1,0,0,0),   P1[14],P1[15],0.f,0.f,       pw3[2]=PKW(P1,12),pw3[3]=PKW(P1,14), pw3); \
    l_reg+=sacc; \
    if(GK){DMA_K((t)+3,sl_cur);} if(GV){DMA_V((t)+1,sl_next);} \
    CMASK(C0,C1,t); \
    SBAR(); \
    GAPB(o[0]=__builtin_amdgcn_mfma_f32_32x32x16_bf16(PAF(0),VFR(0),o[0],0,0,0), C0,0); \
    GAPB(o[1]=__builtin_amdgcn_mfma_f32_32x32x16_bf16(PAF(0),VFR(4),o[1],0,0,0), C0,4); \
    KRD(GL,0); GAPB(o[0]=__builtin_amdgcn_mfma_f32_32x32x16_bf16(PAF(1),VFR(1),o[0],0,0,0), C0,8); \
    KRD(GL,1); GAPB(o[1]=__builtin_amdgcn_mfma_f32_32x32x16_bf16(PAF(1),VFR(5),o[1],0,0,0), C0,12); \
    KRD(GL,2); GAPB(o[0]=__builtin_amdgcn_mfma_f32_32x32x16_bf16(PAF(2),VFR(2),o[0],0,0,0), C1,0); \
    KRD(GL,3); GAPB(o[1]=__builtin_amdgcn_mfma_f32_32x32x16_bf16(PAF(2),VFR(6),o[1],0,0,0), C1,4); \
    GAPB(o[0]=__builtin_amdgcn_mfma_f32_32x32x16_bf16(PAF(3),VFR(3),o[0],0,0,0), C1,8); \
    GAPB(o[1]=__builtin_amdgcn_mfma_f32_32x32x16_bf16(PAF(3),VFR(7),o[1],0,0,0), C1,12); \
    }while(0)
  int t=1;
  #undef CMASK
  #define CMASK(P0,P1,t) do{}while(0)
  for(;t+5<NT;t+=2){
    STEP(pB0,pB1,pA0,pA1,t,true,true,true);     WAIT_BAR(2); RESC(); ROT();
    STEP(pA0,pA1,pB0,pB1,t+1,true,true,true);   WAIT_BAR(2); RESC(); ROT();
  }
  #undef CMASK
  #define CMASK(P0,P1,t) do{int jb_=(t)-(NT-4); if(jb_>=0)cmask(P0,P1,jb_,qrel,hi);}while(0)
  #define ENDW(tt) do{ if((tt)+3<NT){WAIT_BAR(2);} else if((tt)+2<NT){WAIT_BAR(1);} else {WAIT_BAR(0);} }while(0)
  for(;t+1<NT;t+=2){
    STEP(pB0,pB1,pA0,pA1,t,(t+3<NT),(t+1<NT),(t+1<NT));       ENDW(t);   RESC(); ROT();
    STEP(pA0,pA1,pB0,pB1,t+1,(t+4<NT),(t+2<NT),(t+2<NT));     ENDW(t+1); RESC(); ROT();
  }
  STEP(pB0,pB1,pA0,pA1,NT-1,false,false,false); RESC();
  { float sacc=pB0[0]+pB0[1]; _Pragma("unroll") for(int r=2;r<16;++r)sacc+=pB0[r]; _Pragma("unroll") for(int r=0;r<16;++r)sacc+=pB1[r]; l_reg+=sacc;
    pw0=(u32x4){PKW(pB0,0),PKW(pB0,2),PKW(pB0,4),PKW(pB0,6)};pw1=(u32x4){PKW(pB0,8),PKW(pB0,10),PKW(pB0,12),PKW(pB0,14)};pw2=(u32x4){PKW(pB1,0),PKW(pB1,2),PKW(pB1,4),PKW(pB1,6)};pw3=(u32x4){PKW(pB1,8),PKW(pB1,10),PKW(pB1,12),PKW(pB1,14)};
    SBAR(); pv(o,vb0+sl_cur,PAF(0),PAF(1),PAF(2),PAF(3)); }
  #undef PKW
  #undef PAF
  #undef VFR
  #undef PIN
  #undef MX3
  #undef GAPA
  #undef GAPB
  #undef EX
  #undef VRD
  #undef KRD
  #undef STEP
  #undef ENDW
  {auto rr=__builtin_amdgcn_permlane32_swap(__float_as_uint(l_reg),__float_as_uint(l_reg),false,false);l_reg=__uint_as_float(rr[0])+__uint_as_float(rr[1]);}
  if(hi==0)wsf[32+r32]=l_reg;asm volatile("s_waitcnt lgkmcnt(0)":::"memory");
  float rli[16];
  #pragma unroll
  for(int r=0;r<16;++r)rli[r]=__builtin_amdgcn_rcpf(wsf[32+crow(r,hi)]);
  bf16*Ow=O+(rowbase+q0+wid*QBLK)*DM+h*D;
  { bf16*stg=(bf16*)(shm+LDS_OST)+wid*2048;
    #pragma unroll
    for(int r=0;r<16;++r){const int orow=crow(r,hi);
      #pragma unroll
      for(int d0=0;d0<2;++d0)stg[orow*64+d0*32+r32]=__float2bfloat16(o[d0][r]*rli[r]);}
    asm volatile("s_waitcnt lgkmcnt(0)":::"memory");
    #pragma unroll
    for(int i=0;i<4;++i){const int row=i*8+(lane>>3),ch=lane&7; const u32x4 v=*(const u32x4*)(stg+row*64+ch*8); ATTN_STORE16(Ow+(long)row*DM+ch*8,v);} }
  asm volatile("s_waitcnt lgkmcnt(0)\n\ts_barrier":::"memory");
  #undef CINIT
  #undef KXF
  #undef DMA_K
  #undef DMA_V
  #undef CMASK
  #undef START
  #undef RESC
  #undef ROT
}
constexpr int ATTN_LDS_BYTES=LDS_BYTES;
struct AttnTensors { const bf16* Q; const bf16* K; const bf16* V; bf16* O; };
struct AttnUnit { int bh; int qb; };
struct StaticOrder {
  int vcu;
  __device__ __forceinline__ explicit StaticOrder(int grid,int block):vcu((block%8)*(grid/8)+block/8){}
  __device__ __forceinline__ bool next(int i,AttnUnit&u)const{ if(i>=4)return false; const int s=vcu&3; u.bh=vcu>>2; u.qb=(i==0)?15-s:(i==1)?8+s:(i==2)?7-s:s; return true; }
  __device__ __forceinline__ void a_ready(const AttnUnit&)const{}
  __device__ __forceinline__ void done(const AttnUnit&)const{}
};
template<class Sched,int THRL=8> __device__ __forceinline__ void attn_phase(char*lds,const AttnTensors&T,const Sched&S){
  AttnUnit u;
  for(int i=0;S.next(i,u);++i){ S.a_ready(u); attn_unit<THRL>(u.bh/NHEAD,u.bh%NHEAD,u.qb,T.Q,T.K,T.V,T.O,lds,1e30f,16.0f); S.done(u); }
}
#undef SBAR
#undef WAIT_BAR
}
constexpr size_t MiB = 1u << 20;
constexpr size_t WS_SSQ_MIX = 0;
constexpr size_t WS_LOGF = 2 * MiB;
constexpr size_t WS_BAR = 3 * MiB + 512 * 1024;
constexpr size_t WS_WF = 3 * MiB;
constexpr size_t WS_W = 4 * MiB, W_PAR = 32 * MiB;
constexpr size_t W_WIN = 0, W_WM = 11 * MiB, W_WO = 13 * MiB, W_WFI = 15 * MiB, W_WFO = 26 * MiB;
constexpr size_t WS_XB = 68 * MiB;
constexpr size_t WS_Q = 132 * MiB, WS_K = 164 * MiB, WS_V = 196 * MiB;
constexpr size_t WS_CP = 228 * MiB;
constexpr size_t WS_G = 292 * MiB;
constexpr size_t WS_SSQ_FFN = 484 * MiB;
constexpr size_t WS_END = 486 * MiB;
constexpr int LDS_BYTES = 147456;
constexpr int NWAVES = 8;

#define GAS __attribute__((address_space(1)))
#define LAS __attribute__((address_space(3)))
typedef unsigned short bf16;
typedef unsigned v4u __attribute__((ext_vector_type(4)));
typedef float f32x4 __attribute__((ext_vector_type(4)));
#define LDS_WAIT() asm volatile("s_waitcnt lgkmcnt(0)" ::: "memory")
__device__ __forceinline__ unsigned f2bf(float f) { unsigned u = __builtin_bit_cast(unsigned, f); return (u + 0x7fffu + ((u >> 16) & 1u)) >> 16; }
__device__ __forceinline__ unsigned pk2(float lo, float hi) { return f2bf(lo) | (f2bf(hi) << 16); }
__device__ __forceinline__ float wave_sum(float v) {
#pragma unroll
    for (int o = 1; o < 64; o <<= 1) v += __shfl_xor(v, o);
    return v;
}

__device__ __forceinline__ void tr_item(const float* W, int ldn, int n0, int k0, const float* gain, bf16* WT, int ldk, int drow0, int koff, LAS float* scr, int lane) {
    { const int c4 = lane & 7, kr = lane >> 3;
#pragma unroll
      for (int i = 0; i < 8; ++i) { const int kk = 8 * i + kr; f32x4 w = *(const f32x4*)(W + (size_t)(k0 + kk) * ldn + n0 + 4 * c4); if (gain) w *= gain[k0 + kk];
          LAS float* d = scr + kk * 33 + 4 * c4; d[0] = w.x; d[1] = w.y; d[2] = w.z; d[3] = w.w; } }
    LDS_WAIT(); asm volatile("" ::: "memory");
    const int c = lane & 7;
#pragma unroll
    for (int j = 0; j < 4; ++j) { const int n = (lane >> 3) + 8 * j; const LAS float* s = scr + (8 * c) * 33 + n;
        v4u o; o.x = pk2(s[0 * 33], s[1 * 33]); o.y = pk2(s[2 * 33], s[3 * 33]); o.z = pk2(s[4 * 33], s[5 * 33]); o.w = pk2(s[6 * 33], s[7 * 33]);
        *(v4u*)(WT + (size_t)(drow0 + n) * ldk + koff + k0 + 8 * c) = o; }
    LDS_WAIT(); asm volatile("" ::: "memory");
}

#define XB_TMO      128
#define XB_XCNT(j)  (256  + 64 * (j))
#define XB_XSUB(j)  (1280 + 64 * (j))
#define XB_XGEN(j)  (2304 + 64 * (j))
#define XB_TOP      3328
#define XB_TOPGEN   3392
#define XCD_BAR_WORDS 3456
#define XB_SPIN_CAP (1u << 18)

__device__ __forceinline__ unsigned xb_ld(unsigned* p)              { return __hip_atomic_load(p, __ATOMIC_RELAXED, __HIP_MEMORY_SCOPE_AGENT); }
__device__ __forceinline__ unsigned xb_add(unsigned* p, unsigned v) { return __hip_atomic_fetch_add(p, v, __ATOMIC_RELAXED, __HIP_MEMORY_SCOPE_AGENT); }
__device__ __forceinline__ unsigned xb_xcc_id() { return (unsigned)__builtin_amdgcn_s_getreg((3 << 11) | 20) & 0xFu; }
#define XB_SPIN(cond, bar) do { unsigned _sp = 0; while (cond) { __builtin_amdgcn_s_sleep(1); \
    if ((++_sp & 255u) == 0u) { if (xb_ld(&(bar)[XB_TMO])) break; if (_sp > XB_SPIN_CAP) { atomicAdd(&(bar)[XB_TMO], 1u); break; } } } } while (0)

struct XcdBarrier {
    unsigned* bar; unsigned x;
    volatile LAS unsigned* st;
};

__device__ __forceinline__ XcdBarrier xcd_barrier_post(unsigned* bar, volatile LAS unsigned* st) {
    XcdBarrier b; b.bar = bar; b.x = xb_xcc_id(); b.st = st;
    if (threadIdx.x == 0) (void)xb_add(&bar[XB_XCNT(b.x)], 1u);
    return b;
}
__device__ __forceinline__ void xcd_barrier_complete(unsigned* bar, unsigned x, unsigned& nloc, unsigned& nx) {
    const unsigned G = gridDim.x * gridDim.y * gridDim.z;
    unsigned sum, cnt, mine, sp = 0u;
    for (;;) {
        sum = 0u; cnt = 0u; mine = 0u;
#pragma unroll
        for (unsigned j = 0; j < 16; ++j) { const unsigned c = xb_ld(&bar[XB_XCNT(j)]); sum += c; cnt += (c > 0u) ? 1u : 0u; mine = (j == x) ? c : mine; }
        if (sum == G) break;
        __builtin_amdgcn_s_sleep(1);
        if ((++sp & 255u) == 0u) { if (xb_ld(&bar[XB_TMO])) break; if (sp > XB_SPIN_CAP) { atomicAdd(&bar[XB_TMO], 1u); break; } }
    }
    nloc = mine > 0u ? mine : 1u; nx = cnt > 0u ? cnt : 1u;
}

__device__ __forceinline__ void xcd_barrier(const XcdBarrier& b) {
    asm volatile("s_waitcnt vmcnt(0)" ::: "memory");
    __syncthreads();
    if (threadIdx.x == 0) {
        unsigned* bar = b.bar;
        __builtin_amdgcn_s_waitcnt(0);
        unsigned nloc = b.st[0], nx = b.st[1];
        if (nloc == 0u) { xcd_barrier_complete(bar, b.x, nloc, nx); b.st[0] = nloc; b.st[1] = nx; }
        const unsigned old = xb_add(&bar[XB_XSUB(b.x)], 1u);
        const unsigned gen = old / nloc;
        if (old + 1u == (gen + 1u) * nloc) {
            __builtin_amdgcn_fence(__ATOMIC_RELEASE, "agent");
            asm volatile("s_waitcnt vmcnt(0)" ::: "memory");
            const unsigned og = xb_add(&bar[XB_TOP], 1u);
            const unsigned tg = og / nx;
            if (og + 1u == (tg + 1u) * nx) xb_add(&bar[XB_TOPGEN], 1u);
            else XB_SPIN(xb_ld(&bar[XB_TOPGEN]) == tg, bar);
            __builtin_amdgcn_fence(__ATOMIC_ACQUIRE, "agent");
            xb_add(&bar[XB_XGEN(b.x)], 1u);
            asm volatile("s_waitcnt vmcnt(0)" ::: "memory");
        } else {
            XB_SPIN(xb_ld(&bar[XB_XGEN(b.x)]) == gen, bar);
            __builtin_amdgcn_fence(__ATOMIC_ACQUIRE, "agent");
            asm volatile("s_waitcnt vmcnt(0)" ::: "memory");
        }
    }
    __syncthreads();
}

struct Args { const float* in[15]; float* out; unsigned char* ws; };

__device__ __forceinline__ void convert_layer(const Args& a, int l, int par, LAS unsigned char* lds, int gw, int NGW, int wave, int lane) {
    lane = opaque_i(lane);
    LAS float* scr = (LAS float*)(lds + wave * 16384);
    unsigned char* wb = a.ws + WS_W + (size_t)par * W_PAR;
    bf16* WIN = (bf16*)(wb + W_WIN); bf16* WM = (bf16*)(wb + W_WM); bf16* WO = (bf16*)(wb + W_WO); bf16* WFI = (bf16*)(wb + W_WFI); bf16* WFO = (bf16*)(wb + W_WFO);
    bf16* WFB = (bf16*)(a.ws + WS_WF) + (size_t)par * 16384;
    const float* g_mix = a.in[1] + (size_t)l * 1024; const float* w_in = a.in[2] + (size_t)l * 1024 * DIN_SRC;
    const float* w_ao = a.in[6] + (size_t)l * 512 * 1024; const float* w_co = a.in[8] + (size_t)l * 256 * 1024;
    const float* pool_w = a.in[9] + (size_t)l * 4 * 64 * 256; const float* pool_s = a.in[10] + (size_t)l * 1024;
    const float* w_o = a.in[11] + (size_t)l * 1024 * 1024; const float* g_ffn = a.in[12] + (size_t)l * 1024;
    const float* w_fi = a.in[13] + (size_t)l * 1024 * 5632; const float* w_fo = a.in[14] + (size_t)l * 2816 * 1024;
    constexpr int I_WIN = 16 * 176, I_WFI = 16 * 176, I_WO = 16 * 32, I_WFO = 44 * 32, I_WA = 8 * 32, I_WC = 4 * 32, I_WP = 1024, I_WF = 8;
    constexpr int NITEMS = I_WIN + I_WFI + I_WO + I_WFO + I_WA + I_WC + I_WP + I_WF;
    for (int it = gw; it < NITEMS; it += NGW) {
        int r = it;
        if (r < I_WIN) { const int kb = r / 176, nb = r % 176, pn = nb >> 3, rem = nb & 7, bj = rem >> 2, w = rem & 3; const int nl = 256 * pn + 64 * w + 32 * bj; const int src = nl < 1536 ? nl : nl + 8;
            tr_item(w_in, DIN_SRC, src, 64 * kb, g_mix, WIN, 1024, 32 * nb, 0, scr, lane); continue; } r -= I_WIN;
        if (r < I_WFI) { const int kb = r / 176, nb = r % 176, pn = nb >> 3, rem = nb & 7, bj = rem >> 2, w = rem & 3; const int src = bj * DFF + 128 * pn + 32 * w;
            tr_item(w_fi, 5632, src, 64 * kb, g_ffn, WFI, 1024, 32 * nb, 0, scr, lane); continue; } r -= I_WFI;
        if (r < I_WO) { const int kb = r >> 5, nb = r & 31; tr_item(w_o, 1024, 32 * nb, 64 * kb, nullptr, WO, 1024, 32 * nb, 0, scr, lane); continue; } r -= I_WO;
        if (r < I_WFO) { const int kb = r >> 5, nb = r & 31; tr_item(w_fo, 1024, 32 * nb, 64 * kb, nullptr, WFO, DFF, 32 * nb, 0, scr, lane); continue; } r -= I_WFO;
        if (r < I_WA) { const int kb = r >> 5, nb = r & 31; tr_item(w_ao, 1024, 32 * nb, 64 * kb, nullptr, WM, 896, 32 * nb, 0, scr, lane); continue; } r -= I_WA;
        if (r < I_WC) { const int kb = r >> 5, nb = r & 31; tr_item(w_co, 1024, 32 * nb, 64 * kb, nullptr, WM, 896, 32 * nb, 512, scr, lane); continue; } r -= I_WC;
        if (r < I_WP) { const int n = r, g = n >> 8, d = n & 255; const float w = pool_w[((size_t)g * 64 + lane) * 256 + d] * pool_s[n]; const bf16 wv = (bf16)f2bf(w);
            WM[(size_t)n * 896 + 768 + lane] = (g & 1) ? (bf16)0 : wv; WM[(size_t)n * 896 + 768 + 64 + lane] = (g & 1) ? wv : (bf16)0; continue; } r -= I_WP;
        { const int h = r;
#pragma unroll 4
            for (int i = 0; i < 16; ++i) { const int k = lane + 64 * i; const float w = w_in[(size_t)k * DIN_SRC + 1536 + h] * g_mix[k]; const unsigned hi = f2bf(w);
                WFB[h * 1024 + k] = (bf16)hi; WFB[(8 + h) * 1024 + k] = (bf16)f2bf(w - __uint_as_float(hi << 16)); } }
    }
}

__global__ void __launch_bounds__(NWAVES * 64, 2) fwd_kernel(Args args) {
    extern __shared__ __attribute__((aligned(16))) unsigned char lds[];
    cg::grid_group grid = cg::this_grid();
#define GSYNC0() do { asm volatile("s_waitcnt vmcnt(0)" ::: "memory"); grid.sync(); __builtin_amdgcn_fence(__ATOMIC_ACQUIRE, "agent"); asm volatile("s_waitcnt vmcnt(0)" ::: "memory"); } while (0)
    LAS unsigned char* ldsl = (LAS unsigned char*)lds;
    const int tid = threadIdx.x, lane = tid & 63, wave = __builtin_amdgcn_readfirstlane(tid >> 6);
    const int G = gridDim.x; const int bx = blockIdx.x; const int vcu = (G % 8 == 0) ? (bx % 8) * (G / 8) + bx / 8 : bx;
    const int gw = vcu * NWAVES + wave, NGW = G * NWAVES;
#ifdef PROBE
    LAS unsigned long long* TACC = (LAS unsigned long long*)(ldsl + LDS_BYTES - 128);
    if (bx == 0 && tid == 0) { for (int i = 0; i < 14; ++i) TACC[i] = 0ull; TACC[13] = 1ull; TACC[12] = __builtin_amdgcn_s_memrealtime(); }
#define TSTAMP(k) do { if (bx == 0 && tid == 0) { const unsigned long long t_ = __builtin_amdgcn_s_memrealtime(); if (TACC[13]) TACC[k] += t_ - TACC[12]; TACC[12] = t_; } } while (0)
#else
#define TSTAMP(k) do {} while (0)
#endif
    unsigned char* ws = args.ws;
    float* SSQ_MIX = (float*)(ws + WS_SSQ_MIX); float* SSQ_FFN = (float*)(ws + WS_SSQ_FFN); float* LOGF = (float*)(ws + WS_LOGF);
    bf16* XB = (bf16*)(ws + WS_XB); bf16* CZ = (bf16*)args.out;     bf16* QO = (bf16*)(ws + WS_Q); bf16* KB = (bf16*)(ws + WS_K); bf16* VB = (bf16*)(ws + WS_V); bf16* MG = KB;
    bf16* CP = (bf16*)(ws + WS_CP); bf16* GT = (bf16*)(ws + WS_G); bf16* ACT = GT;
    const float* x_in = args.in[0]; float* out = args.out;

    unsigned* barw = (unsigned*)(ws + WS_BAR);
    volatile LAS unsigned* bst = (volatile LAS unsigned*)(ldsl + LDS_BYTES - 256);
    if (tid < 2) bst[tid] = 0u;
    __syncthreads();
    XcdBarrier xbar = xcd_barrier_post(barw, bst);
#define GSYNC() xcd_barrier(xbar)
    if (args.ws == nullptr) GSYNC0();
    convert_layer(args, 0, 0, ldsl, gw, NGW, wave, lane);
    for (int m = gw; m < MTOK; m += 4 * NGW) {
        const int lane = opaque_i(tid) & 63;
        f32x4 v[4][4];
#pragma unroll
        for (int r = 0; r < 4; ++r) { const f32x4* xr = (const f32x4*)(x_in + (size_t)(m + r * NGW) * 1024) + lane;
#pragma unroll
            for (int j = 0; j < 4; ++j) v[r][j] = xr[64 * j]; }
#pragma unroll
        for (int r = 0; r < 4; ++r) { const int mr = m + r * NGW; float s = 0.f;
#pragma unroll
            for (int j = 0; j < 4; ++j) s += (v[r][j].x * v[r][j].x + v[r][j].y * v[r][j].y) + (v[r][j].z * v[r][j].z + v[r][j].w * v[r][j].w);
            s = wave_sum(s);
            unsigned long long* o8 = (unsigned long long*)(XB + (size_t)mr * 1024) + lane;
#pragma unroll
            for (int j = 0; j < 4; ++j) o8[64 * j] = (unsigned long long)pk2(v[r][j].x, v[r][j].y) | ((unsigned long long)pk2(v[r][j].z, v[r][j].w) << 32);
            if (lane < 16) SSQ_MIX[(size_t)mr * 16 + lane] = lane == 0 ? s : 0.f; }
    }
    GSYNC();
    TSTAMP(0);

    for (int l = 0; l < NLAYER; ++l) {
#ifdef PROBE
        if (bx == 0 && tid == 0) TACC[13] = 1ull;
#endif
        const int par = l & 1;
        unsigned char* wb = ws + WS_W + (size_t)par * W_PAR;
        const float* ssq_mix = SSQ_MIX; float* ssq_ffn = SSQ_FFN;
        float* ssq_nextmix = (l + 1 < NLAYER) ? SSQ_MIX : nullptr;

#if (PHM >> 1) & 1
        {
            const bf16* WFB = (const bf16*)(ws + WS_WF) + (size_t)par * 16384; const float* fb = args.in[3] + l * 8;
            for (int ch = gw; ch < MTOK / 16; ch += NGW) {
                const int lane = opaque_i(tid) & 63, fr = lane & 15, fq = lane >> 4, m0 = ch * 16;
                const bf16* xa = XB + (size_t)(m0 + fr) * 1024 + 8 * fq; const bf16* wbp = WFB + (size_t)fr * 1024 + 8 * fq;
                f32x4 acc = {0.f, 0.f, 0.f, 0.f};
#pragma unroll 16
                for (int kk = 0; kk < 32; ++kk) { const pg8::bf16x8 av = *(const pg8::bf16x8*)(xa + 32 * kk), bv = *(const pg8::bf16x8*)(wbp + 32 * kk);
                    acc = __builtin_amdgcn_mfma_f32_16x16x32_bf16(av, bv, acc, 0, 0, 0); }
                f32x4 tot; tot.x = acc.x + __shfl_xor(acc.x, 8); tot.y = acc.y + __shfl_xor(acc.y, 8); tot.z = acc.z + __shfl_xor(acc.z, 8); tot.w = acc.w + __shfl_xor(acc.w, 8);
                if (fr < 8) { const float fbh = fb[fr]; f32x4 lf;
#pragma unroll
                    for (int r = 0; r < 4; ++r) { const int row = m0 + 4 * fq + r; const float rr = rsqrtf(pg8::row_ssq(ssq_mix, row) * (1.0f / 1024.0f) + EPSN); const float f = tot[r] * rr + fbh;
                        lf[r] = fminf(f, 0.f) - log1pf(expf(-fabsf(f))); }
                    *(f32x4*)(LOGF + ((size_t)(m0 >> 12) * 8 + fr) * SEQ_ + (m0 & (SEQ_ - 1)) + 4 * fq) = lf; }
            }
            TSTAMP(1);
            pg8::ProbSimple P{(const char*)XB, (const char*)(wb + W_WIN), 1024, 1024, 16}; pg8::StaticOrder<1> S; S.init(MTOK, NIN, G, bx);
            pg8::EpiInProj E{ssq_mix, args.in[4] + l * 64, args.in[5] + l * 64, QO, KB, VB, CP, GT};
            pg8::gemm_phase<pg8::ProbSimple, pg8::EpiInProj, pg8::StaticOrder<1>, true, true>(ldsl, P, S, E);
        }
#endif
        GSYNC();
        TSTAMP(2);
#ifdef PROBE
        GSYNC(); TSTAMP(11);
#endif

#if (PHM >> 2) & 1
        {
            if (l + 1 < NLAYER) convert_layer(args, l + 1, (l + 1) & 1, ldsl, gw, NGW, wave, lane);
            TSTAMP(3);
            {
                const float* cw = args.in[7] + (size_t)l * 3 * 256;
                const int lane = opaque_i(tid) & 63; const bool isconv = lane < 32; const int c0 = 8 * (lane & 31), g = (lane & 31) >> 3, wwin = 2 << g;
                const int R0 = vcu * 128 + wave * 16, tl0 = R0 & (SEQ_ - 1); const bool halo = tl0 != 0;
                const int colA = isconv ? c0 : 768 + c0, colB = isconv ? 512 + c0 : 768 + c0, colC = isconv ? 256 + c0 : 768 + c0;
                const f32x4 w0a = *(const f32x4*)(cw + c0), w0b = *(const f32x4*)(cw + c0 + 4), w1a = *(const f32x4*)(cw + 256 + c0), w1b = *(const f32x4*)(cw + 256 + c0 + 4), w2a = *(const f32x4*)(cw + 512 + c0), w2b = *(const f32x4*)(cw + 512 + c0 + 4);
                const v4u zero4 = {0u, 0u, 0u, 0u}; const f32x4 zf = {0.f, 0.f, 0.f, 0.f};
                v4u ring[16];
#pragma unroll
                for (int i = 0; i < 16; ++i) ring[i] = zero4;
                f32x4 S0 = zf, S1 = zf, z1a = zf, z1b = zf, z2a = zf, z2b = zf;
#pragma unroll
                for (int i = -15; i < 16; ++i) {
                    const bool valid = (i >= 0) || halo;
                    const bf16* rp = CP + (size_t)(R0 + i) * 1024;
                    v4u av = zero4; if (valid) av = *(const v4u*)(rp + colA);
                    const f32x4 u0 = pg8::bf_lo4(av.x, av.y), u1 = pg8::bf_lo4(av.z, av.w);
                    S0 += u0; S1 += u1;
                    { const v4u o2 = (i - 2 >= -15) ? ring[(i - 2 + 16) & 15] : zero4, o4 = (i - 4 >= -15) ? ring[(i - 4 + 16) & 15] : zero4, o8 = (i - 8 >= -15) ? ring[(i - 8 + 16) & 15] : zero4, o16 = (i - 16 >= -15) ? ring[(i - 16 + 16) & 15] : zero4;
                      const v4u o = g == 0 ? o2 : g == 1 ? o4 : g == 2 ? o8 : o16;
                      S0 -= pg8::bf_lo4(o.x, o.y); S1 -= pg8::bf_lo4(o.z, o.w); }
                    ring[(i + 16) & 15] = av;
                    f32x4 za = zf, zb = zf;
                    if (i >= -2) { v4u bv = zero4; if (valid) bv = *(const v4u*)(rp + colB); za = u0 * pg8::bf_lo4(bv.x, bv.y); zb = u1 * pg8::bf_lo4(bv.z, bv.w); }
                    if (i >= 0) {
                        const v4u cv = *(const v4u*)(rp + colC);
                        const f32x4 oc0 = pg8::bf_lo4(cv.x, cv.y) * (w0a * z2a + w1a * z1a + w2a * za), oc1 = pg8::bf_lo4(cv.z, cv.w) * (w0b * z2b + w1b * z1b + w2b * zb);
                        const int tl = tl0 + i, n = (tl + 1) < wwin ? (tl + 1) : wwin; const float inv = 1.0f / (float)n;
                        const f32x4 op0 = S0 * inv - u0, op1 = S1 * inv - u1;
                        *(v4u*)(CZ + (size_t)(R0 + i) * 512 + (isconv ? c0 : 256 + c0)) = pg8::pack8(isconv ? oc0 : op0, isconv ? oc1 : op1);
                    }
                    if (i >= -2) { z2a = z1a; z2b = z1b; z1a = za; z1b = zb; }
                }
            }
            TSTAMP(4);
            {
                __syncthreads();
                const int tid = opaque_i(threadIdx.x), lane = tid & 63;
                float dthr2, mref2;
                { float mq = fabsf((args.in[4] + l * 64)[lane]), mk = fabsf((args.in[5] + l * 64)[lane]);
#pragma unroll
                  for (int o = 1; o < 64; o <<= 1) { mq = fmaxf(mq, __shfl_xor(mq, o)); mk = fmaxf(mk, __shfl_xor(mk, o)); }
                  mref2 = 8.0f * 1.02f * mq * mk * LOG2E; dthr2 = 2.0f * mref2 + 26.0f * LOG2E; }
                LAS float* c2 = (LAS float*)(ldsl + attn_body::LDS_C2); LAS float* wsum = (LAS float*)(ldsl + attn_body::LDS_WSUM); volatile LAS unsigned* uq = (volatile LAS unsigned*)(ldsl + attn_body::LDS_WSUM + 32);
                unsigned* qctr = barw + 4096 + 64 * l;
                for (;;) {
                    if (tid == 0) *uq = __hip_atomic_fetch_add(qctr, 1u, __ATOMIC_RELAXED, __HIP_MEMORY_SCOPE_AGENT);
                    __syncthreads();
                    const unsigned u = *uq;
                    if (u >= (unsigned)(NB * NHEADS * (SEQ_ / 256))) break;
                    const int qb = (SEQ_ / 256 - 1) - (int)(u >> 6), bh = (int)(u & 63);
                    const f32x4* p = (const f32x4*)(LOGF + (size_t)bh * SEQ_ + tid * 8); const f32x4 a = p[0], b = p[1];
                    float v0 = a.x, v1 = v0 + a.y, v2 = v1 + a.z, v3 = v2 + a.w, v4 = v3 + b.x, v5 = v4 + b.y, v6 = v5 + b.z, v7 = v6 + b.w;
                    float sc = v7;
#pragma unroll
                    for (int o = 1; o < 64; o <<= 1) { const float y = __shfl_up(sc, o); if (lane >= o) sc += y; }
                    if (lane == 63) wsum[wave] = sc;
                    __syncthreads();
                    float off = 0.f;
#pragma unroll
                    for (int w = 0; w < 8; ++w) { const float t = wsum[w]; if (w < wave) off += t; }
                    const float e = off + sc - v7;
                    f32x4 r0 = {-(e + v0) * LOG2E, -(e + v1) * LOG2E, -(e + v2) * LOG2E, -(e + v3) * LOG2E}, r1 = {-(e + v4) * LOG2E, -(e + v5) * LOG2E, -(e + v6) * LOG2E, -(e + v7) * LOG2E};
                    *(LAS f32x4*)(c2 + tid * 8) = r0; *(LAS f32x4*)(c2 + tid * 8 + 4) = r1;
                    { LAS unsigned long long* kx = (LAS unsigned long long*)(ldsl + attn_body::LDS_KX) + tid * 8;
#pragma unroll
                      for (int j = 0; j < 8; ++j) { const float cv = j < 4 ? r0[j & 3] : r1[j & 3]; const unsigned hh = f2bf(cv); const float q1 = cv - __uint_as_float(hh << 16);
                          const unsigned mm = f2bf(q1); const float q2 = q1 - __uint_as_float(mm << 16); const unsigned ll = f2bf(q2);
                          kx[j] = (unsigned long long)(hh | (mm << 16)) | ((unsigned long long)(ll | (0x3F80u << 16)) << 32); } }
                    __syncthreads();
                    attn_body::attn_unit<8>(bh >> 3, bh & 7, qb, (const attn_body::bf16*)QO, (const attn_body::bf16*)KB, (const attn_body::bf16*)VB, (attn_body::bf16*)QO, (char*)lds, dthr2, mref2);
                }
            }
            TSTAMP(5);
        }
#endif
        GSYNC();
        TSTAMP(6);

#if (PHM >> 3) & 1
        {
            pg8::ProbMerge P{(const char*)QO, (const char*)CZ, (const char*)(wb + W_WM), 512, 896}; pg8::StaticOrder<3> S; S.init(MTOK, 1024, G, bx);
            pg8::EpiMerge E{GT, MG};
            pg8::gemm_phase<pg8::ProbMerge, pg8::EpiMerge, pg8::StaticOrder<3>, true, true>(ldsl, P, S, E);
        }
#endif
        GSYNC();
        TSTAMP(7);

#if (PHM >> 4) & 1
        {
            pg8::ProbSimple P{(const char*)MG, (const char*)(wb + W_WO), 1024, 1024, 16}; pg8::StaticOrder<1> S; S.init(MTOK, 1024, G, bx);
            pg8::EpiResid E{nullptr, XB, ssq_ffn};
            pg8::gemm_phase<pg8::ProbSimple, pg8::EpiResid, pg8::StaticOrder<1>, true, true>(ldsl, P, S, E);
        }
#endif
        GSYNC();
        TSTAMP(8);

#if (PHM >> 5) & 1
        {
            pg8::ProbSimple P{(const char*)XB, (const char*)(wb + W_WFI), 1024, 1024, 16}; pg8::StaticOrder<1> S; S.init(MTOK, 2 * DFF, G, bx);
            pg8::EpiSwiGLU E{ssq_ffn, ACT};
            pg8::gemm_phase<pg8::ProbSimple, pg8::EpiSwiGLU, pg8::StaticOrder<1>, true, true>(ldsl, P, S, E);
        }
#endif
        GSYNC();
        TSTAMP(9);

#if (PHM >> 6) & 1
        {
            pg8::ProbSimple P{(const char*)ACT, (const char*)(wb + W_WFO), DFF, DFF, DFF / 64}; pg8::StaticOrder<1> S; S.init(MTOK, 1024, G, bx);
            pg8::EpiResid E{(l + 1 < NLAYER) ? nullptr : out, XB, ssq_nextmix};
            pg8::gemm_phase<pg8::ProbSimple, pg8::EpiResid, pg8::StaticOrder<1>, true, true>(ldsl, P, S, E);
        }
#endif
        if (l + 1 < NLAYER) GSYNC();
        TSTAMP(10);
    }
#ifdef PROBE
    GSYNC();
    if (bx == 0 && tid == 0) out[0] += (float)TACC[PROBE] * 0.0005f;
#endif
}

extern "C" void kernel_launch(void* const* d_in, const int* in_sizes, int n_in, void* d_out, int out_size, void* d_ws, size_t ws_size, hipStream_t stream) {
    static int grid = 0;
    if (grid == 0) {
        if (n_in != 15 || out_size != MTOK * DMODEL || ws_size < WS_END) { fprintf(stderr, "kernel_launch: unexpected shapes (n_in %d out %d ws %zu)\n", n_in, out_size, ws_size); grid = -1; return; }
        int dev = 0, cus = 0, per_cu = 0;
        hipGetDevice(&dev); hipDeviceGetAttribute(&cus, hipDeviceAttributeMultiprocessorCount, dev);
        if (hipFuncSetAttribute((const void*)fwd_kernel, hipFuncAttributeMaxDynamicSharedMemorySize, LDS_BYTES) != hipSuccess) { fprintf(stderr, "kernel_launch: hipFuncSetAttribute failed\n"); grid = -1; return; }
        if (hipOccupancyMaxActiveBlocksPerMultiprocessor(&per_cu, (const void*)fwd_kernel, NWAVES * 64, LDS_BYTES) != hipSuccess || per_cu < 1) { fprintf(stderr, "kernel_launch: occupancy query says %d\n", per_cu); per_cu = 1; }
        (void)hipGetLastError();
        grid = cus;
        if (grid != 256) fprintf(stderr, "kernel_launch: %d CUs (built for 256)\n", grid);
    }
    if (grid < 0) return;
    (void)hipMemsetAsync((char*)d_ws + WS_BAR, 0, (4096 + 4 * 64) * 4, stream);
    Args a{};
    for (int i = 0; i < 15; ++i) a.in[i] = (const float*)d_in[i];
    a.out = (float*)d_out; a.ws = (unsigned char*)d_ws;
    void* kargs[] = {&a};
    hipError_t e = hipLaunchCooperativeKernel((const void*)fwd_kernel, dim3(grid), dim3(NWAVES * 64), kargs, LDS_BYTES, stream);
    if (e != hipSuccess) fprintf(stderr, "cooperative launch failed: %s (grid %d)\n", hipGetErrorString(e), grid);
}
```

```cpp
#include <hip/hip_runtime.h>
#include <hip/hip_cooperative_groups.h>
#include <hip/hip_bf16.h>
#include <cstdio>
#include <cstdint>
#include <cmath>
namespace cg = cooperative_groups;

#ifndef PHM
#define PHM 0xff
#endif
constexpr int NB = 8, SEQ_ = 4096, DMODEL = 1024, NLAYER = 4;
constexpr int MTOK = NB * SEQ_;
constexpr int DATT = 512, NHEADS = 8, DCONV = 256, DPOOL = 256, DFF = 2816;
constexpr int DIN_SRC = 5640;
constexpr int NIN = 5632;
constexpr float EPSN = 1e-6f;
constexpr float LOG2E = 1.4426950408889634f;
constexpr float QSCALE = 0.125f * LOG2E;

__device__ __forceinline__ int opaque_i(int v) { asm volatile("" : "+v"(v)); return v; }
namespace pg8 {
#define PG8_LAS __attribute__((address_space(3)))
typedef unsigned short bf16_t;
typedef short bf16x8 __attribute__((ext_vector_type(8)));
typedef float f32x4 __attribute__((ext_vector_type(4)));
typedef unsigned u32x4 __attribute__((ext_vector_type(4)));
constexpr int BM = 256, BK = 64, HALF = 128, HTB = HALF * BK * 2, STAGE_BYTES = 8 * HTB, NXCD = 8, WGM = 8;

__host__ __device__ __forceinline__ int lds_byte(int r, int c) { const int st = (r >> 4) * 2 + (c >> 5), rr = r & 15, cc = c & 31, ob = rr * 64 + cc * 2; return st * 1024 + (ob ^ (((ob >> 9) & 1) << 5)); }
__host__ __device__ __forceinline__ void stage_rc(int b, int& R, int& C) { const int st = b / 1024, sb = b % 1024, swz = sb ^ (((sb >> 9) & 1) << 5); R = (st >> 1) * 16 + swz / 64; C = (st & 1) * 32 + (swz % 64) / 2; }
__host__ __device__ __forceinline__ int perm32(int rho) { const int n = rho >> 4, i = rho & 15; return 8 * (i >> 2) + 4 * n + (i & 3); }

struct Unit { int pm, pn, sub; };
struct UMem { const char* A; const char* B; int nt; };

template <int NSUB> struct StaticOrder {
    int nM, nN, nwg, G, c;
    __device__ void init(int M, int N, int G_, int c_) { nM = M / BM; nN = N / BM; nwg = nM * nN; G = G_; c = c_; }
    __device__ bool next(int i, Unit& u) const {
        const int it = i / NSUB; u.sub = i - it * NSUB;
        const long L = (long)it * G + c; if (L >= nwg) return false;
        int wgid = (int)L; { const int q = nwg / NXCD, r = nwg % NXCD, xcd = wgid % NXCD, off = wgid / NXCD; wgid = (xcd < r ? xcd * (q + 1) : r * (q + 1) + (xcd - r) * q) + off; }
        const int nig = WGM * nN, gid = wgid / nig, fm = gid * WGM, gsz = (nM - fm) < WGM ? (nM - fm) : WGM;
        u.pm = fm + ((wgid % nig) % gsz); u.pn = (wgid % nig) / gsz; return true;
    }
};

__device__ __forceinline__ unsigned cvt_pk_bf16(float lo, float hi) { unsigned r; asm volatile("v_cvt_pk_bf16_f32 %0, %1, %2" : "=v"(r) : "v"(lo), "v"(hi)); return r; }
__device__ __forceinline__ f32x4 bf_lo4(unsigned a, unsigned b) { return (f32x4){__uint_as_float(a << 16), __uint_as_float(a & 0xffff0000u), __uint_as_float(b << 16), __uint_as_float(b & 0xffff0000u)}; }
__device__ __forceinline__ u32x4 pack8(f32x4 v0, f32x4 v1) { u32x4 w; w.x = cvt_pk_bf16(v0[0], v0[1]); w.y = cvt_pk_bf16(v0[2], v0[3]); w.z = cvt_pk_bf16(v1[0], v1[1]); w.w = cvt_pk_bf16(v1[2], v1[3]); return w; }
__device__ __forceinline__ float row_ssq(const float* p, int row) { const f32x4* q = (const f32x4*)(p + (size_t)row * 16); const f32x4 s = (q[0] + q[1]) + (q[2] + q[3]); return (s[0] + s[1]) + (s[2] + s[3]); }
__device__ __forceinline__ float row_ssq_q(const float* p, int row, int fq) { const f32x4 v = *(const f32x4*)(p + (size_t)row * 16 + 4 * fq); float s = (v[0] + v[1]) + (v[2] + v[3]); s += __shfl_xor(s, 16); s += __shfl_xor(s, 32); return s; }
__device__ __forceinline__ float fast_sigmoid(float v) { return __builtin_amdgcn_rcpf(1.0f + __expf(-v)); }


struct EpiInProj {
    const float* ssq; const float* qg; const float* kg; bf16_t* Q; bf16_t* Kb; bf16_t* V; bf16_t* CP; bf16_t* G;
    __device__ __forceinline__ bool keep(const Unit&) const { return false; }
    __device__ __forceinline__ void operator()(f32x4 (&acc)[2][2][4][2], const Unit& u, int wr, int wc, int fr, int fq) const {
        const int pn = u.pn; bf16_t* base; int ld, colt, mode; float post = 1.f; const float* gain = qg;
        if (pn < 2) { base = Q; ld = 512; colt = pn * 256; mode = 1; post = QSCALE; gain = qg; }
        else if (pn < 4) { base = Kb; ld = 512; colt = (pn - 2) * 256; mode = 1; gain = kg; }
        else if (pn < 6) { base = V; ld = 512; colt = (pn - 4) * 256; mode = 0; }
        else if (pn < 10) { base = CP; ld = 1024; colt = (pn - 6) * 256; mode = 0; }
        else { base = G; ld = 3072; colt = (pn - 10) * 256; mode = 2; }
        const int row0 = u.pm * BM + wr * 64 + fr, colw = colt + 64 * wc + 8 * fq;
        f32x4 gv[2][2];
#pragma unroll
        for (int bj = 0; bj < 2; ++bj)
#pragma unroll
            for (int n = 0; n < 2; ++n) gv[bj][n] = *(const f32x4*)(gain + 32 * bj + 8 * fq + 4 * n) * post;
        float rsa[2][4];
#pragma unroll
        for (int ai = 0; ai < 2; ++ai)
#pragma unroll
            for (int m = 0; m < 4; ++m) rsa[ai][m] = row_ssq_q(ssq, row0 + ai * HALF + m * 16, fq);
        asm volatile("" : "+v"(rsa[0][0]), "+v"(rsa[0][1]), "+v"(rsa[0][2]), "+v"(rsa[0][3]), "+v"(rsa[1][0]), "+v"(rsa[1][1]), "+v"(rsa[1][2]), "+v"(rsa[1][3]));
#pragma unroll
        for (int ai = 0; ai < 2; ++ai) {
#pragma unroll
            for (int m = 0; m < 4; ++m) {
                const int row = row0 + ai * HALF + m * 16;
                const float r = rsqrtf(rsa[ai][m] * (1.0f / 1024.0f) + EPSN);
                f32x4 v[2][2];
#pragma unroll
                for (int bj = 0; bj < 2; ++bj)
#pragma unroll
                    for (int n = 0; n < 2; ++n) v[bj][n] = acc[ai][bj][m][n] * r;
                if (mode == 1) {
                    float s = 0.f;
#pragma unroll
                    for (int bj = 0; bj < 2; ++bj)
#pragma unroll
                        for (int n = 0; n < 2; ++n) { const f32x4 x = v[bj][n]; s += (x[0] * x[0] + x[1] * x[1]) + (x[2] * x[2] + x[3] * x[3]); }
                    s += __shfl_xor(s, 16); s += __shfl_xor(s, 32);
                    const float rn = rsqrtf(s * (1.0f / 64.0f) + EPSN);
#pragma unroll
                    for (int bj = 0; bj < 2; ++bj)
#pragma unroll
                        for (int n = 0; n < 2; ++n) v[bj][n] = v[bj][n] * rn * gv[bj][n];
                } else if (mode == 2) {
#pragma unroll
                    for (int bj = 0; bj < 2; ++bj)
#pragma unroll
                        for (int n = 0; n < 2; ++n) { f32x4 x = v[bj][n];
                            x[0] = fminf(__expf(-x[0]), 1e30f); x[1] = fminf(__expf(-x[1]), 1e30f); x[2] = fminf(__expf(-x[2]), 1e30f); x[3] = fminf(__expf(-x[3]), 1e30f); v[bj][n] = x; }
                }
                bf16_t* rowp = base + (size_t)row * ld + colw;
#pragma unroll
                for (int bj = 0; bj < 2; ++bj) *(u32x4*)(rowp + 32 * bj) = pack8(v[bj][0], v[bj][1]);
            }
        }
    }
};

struct EpiMerge {
    const bf16_t* G; bf16_t* Mg;
    __device__ __forceinline__ bool keep(const Unit& u) const { return u.sub < 2; }
    __device__ __forceinline__ void operator()(f32x4 (&acc)[2][2][4][2], const Unit& u, int wr, int wc, int fr, int fq) const {
        const int row0 = u.pm * BM + wr * 64 + fr, col0 = u.pn * BM + wc * 32 + 8 * fq, sub = u.sub;
        const bf16_t* gbase = G + (size_t)row0 * 3072 + col0 + (sub == 0 ? 0 : sub == 1 ? 1024 : 2048);
#pragma unroll
        for (int aih = 0; aih < 4; ++aih) { const int ai = aih >> 1, mlo = (aih & 1) * 2;
            u32x4 ga[4][2], gb[4][2];
#pragma unroll
            for (int m = mlo; m < mlo + 2; ++m)
#pragma unroll
                for (int bj = 0; bj < 2; ++bj) { const bf16_t* gp = gbase + (size_t)(ai * HALF + m * 16) * 3072 + bj * HALF;
                    ga[m][bj] = *(const u32x4*)gp; gb[m][bj] = ga[m][bj]; if (sub < 2) gb[m][bj] = *(const u32x4*)(gp + 1024); }
#pragma unroll
            for (int m = mlo; m < mlo + 2; ++m) {
                const int row = row0 + ai * HALF + m * 16;
#pragma unroll
                for (int bj = 0; bj < 2; ++bj) {
                    f32x4 f0 = bf_lo4(ga[m][bj].x, ga[m][bj].y) + 1.0f, f1 = bf_lo4(ga[m][bj].z, ga[m][bj].w) + 1.0f;
#pragma unroll
                    for (int j = 0; j < 4; ++j) { f0[j] = __builtin_amdgcn_rcpf(f0[j]); f1[j] = __builtin_amdgcn_rcpf(f1[j]); }
                    if (sub < 2) {
                        const f32x4 d0 = bf_lo4(gb[m][bj].x, gb[m][bj].y) + 1.0f, d1 = bf_lo4(gb[m][bj].z, gb[m][bj].w) + 1.0f;
                        acc[ai][bj][m][0] *= f0 * d0; acc[ai][bj][m][1] *= f1 * d1;
                    } else {
                        *(u32x4*)(Mg + (size_t)row * 1024 + col0 + bj * HALF) = pack8(acc[ai][bj][m][0] * f0, acc[ai][bj][m][1] * f1);
                    }
                }
            }
        }
    }
};

struct EpiResid {
    float* out; bf16_t* XB; float* ssq_next;
    __device__ __forceinline__ bool keep(const Unit&) const { return false; }
    __device__ __forceinline__ void operator()(f32x4 (&acc)[2][2][4][2], const Unit& u, int wr, int wc, int fr, int fq) const {
        const int row0 = u.pm * BM + wr * 64 + fr, col0 = u.pn * BM + wc * 32 + 8 * fq;
#pragma unroll
        for (int ai = 0; ai < 2; ++ai) {
            u32x4 xo[2][4][2];
#pragma unroll
            for (int m = 0; m < 4; ++m)
#pragma unroll
                for (int bj = 0; bj < 2; ++bj) xo[ai][m][bj] = *(const u32x4*)(XB + (size_t)(row0 + ai * HALF + m * 16) * 1024 + col0 + bj * HALF);
#pragma unroll
            for (int m = 0; m < 4; ++m) {
                const int row = row0 + ai * HALF + m * 16; const size_t off = (size_t)row * 1024 + col0;
                float s = 0.f;
#pragma unroll
                for (int bj = 0; bj < 2; ++bj) {
                    const u32x4 xv = xo[ai][m][bj];
                    const f32x4 x0 = bf_lo4(xv.x, xv.y) + acc[ai][bj][m][0], x1 = bf_lo4(xv.z, xv.w) + acc[ai][bj][m][1];
                    if (out) { *(f32x4*)(out + off + bj * HALF) = x0; *(f32x4*)(out + off + bj * HALF + 4) = x1; }
                    else *(u32x4*)(XB + off + bj * HALF) = pack8(x0, x1);
                    s += (x0[0] * x0[0] + x0[1] * x0[1]) + (x0[2] * x0[2] + x0[3] * x0[3]) + (x1[0] * x1[0] + x1[1] * x1[1]) + (x1[2] * x1[2] + x1[3] * x1[3]);
                }
                if (ssq_next) { s += __shfl_xor(s, 16); s += __shfl_xor(s, 32); if (fq == 0) ssq_next[(size_t)row * 16 + u.pn * 4 + wc] = s; }
            }
        }
    }
};

struct EpiSwiGLU {
    const float* ssq; bf16_t* ACT;
    __device__ __forceinline__ bool keep(const Unit&) const { return false; }
    __device__ __forceinline__ void operator()(f32x4 (&acc)[2][2][4][2], const Unit& u, int wr, int wc, int fr, int fq) const {
        const int row0 = u.pm * BM + wr * 64 + fr, col0 = u.pn * HALF + wc * 32 + 8 * fq;
        float rs[2][4];
#pragma unroll
        for (int ai = 0; ai < 2; ++ai)
#pragma unroll
            for (int m = 0; m < 4; ++m) rs[ai][m] = row_ssq_q(ssq, row0 + ai * HALF + m * 16, fq);
#pragma unroll
        for (int ai = 0; ai < 2; ++ai)
#pragma unroll
            for (int m = 0; m < 4; ++m) {
                const int row = row0 + ai * HALF + m * 16;
                const float r = rsqrtf(rs[ai][m] * (1.0f / 1024.0f) + EPSN);
                f32x4 o[2];
#pragma unroll
                for (int n = 0; n < 2; ++n) { const f32x4 g = acc[ai][0][m][n] * r, up = acc[ai][1][m][n] * r;
#pragma unroll
                    for (int j = 0; j < 4; ++j) o[n][j] = g[j] * fast_sigmoid(g[j]) * up[j]; }
                *(u32x4*)(ACT + (size_t)row * DFF + col0) = pack8(o[0], o[1]);
            }
    }
};

struct ProbSimple { const char* A; const char* B; int lda, ldb, nt;
    __device__ __forceinline__ UMem mem(const Unit& u) const { UMem m; m.A = A + (size_t)u.pm * BM * lda * 2; m.B = B + (size_t)u.pn * BM * ldb * 2; m.nt = nt; return m; } };
struct ProbMerge { const char* O; const char* CZ; const char* WM; int lda, ldb;
    __device__ __forceinline__ UMem mem(const Unit& u) const { UMem m; const size_t ar = (size_t)u.pm * BM * 512 * 2, br = (size_t)u.pn * BM * 896 * 2;
        if (u.sub == 0) { m.A = O + ar; m.B = WM + br; m.nt = 8; }
        else if (u.sub == 1) { m.A = CZ + ar; m.B = WM + br + 512 * 2; m.nt = 4; }
        else { m.A = CZ + ar + (256 + 128 * (u.pn >> 1)) * 2; m.B = WM + br + 768 * 2; m.nt = 2; }
        return m; } };

template <class Prob, class Epi, class Sched, bool ALIGN_EPI, bool SP2>
__device__ __forceinline__ void gemm_phase(PG8_LAS unsigned char* lds, const Prob& P, const Sched& S, const Epi& E) {
    const int tid = opaque_i(threadIdx.x), wid = __builtin_amdgcn_readfirstlane(tid >> 6), lane = tid & 63, wr = wid >> 2, wc = wid & 3, fr = lane & 15, fq = lane >> 4;
    unsigned voffA[2], voffB[2];
#pragma unroll
    for (int i = 0; i < 2; ++i) { int R, C; stage_rc(tid * 16 + i * 8192, R, C); const int Rb = (R & ~31) + perm32(R & 31);
        voffA[i] = (unsigned)(R * P.lda + C) * 2u; voffB[i] = (unsigned)(Rb * P.ldb + C) * 2u; }
    const size_t kstep = (size_t)(BK * 2);
    const size_t hstepA = (size_t)HALF * P.lda * 2, hstepB = (size_t)HALF * P.ldb * 2;
    const unsigned ldsw = (unsigned)wid * 1024u;
    const int aoff = lds_byte(wr * 64 + fr, fq * 8), boff = lds_byte(wc * 32 + fr, fq * 8);
#define PG8_SA(b, h) (((b) * 2 + (h)) * HTB)
#define PG8_SB(b, h) ((4 + (b) * 2 + (h)) * HTB)
#define PG8_STAGE(bufoff, gbase, voff) do { _Pragma("unroll") for (int _i = 0; _i < 2; ++_i) \
        __builtin_amdgcn_global_load_lds((const unsigned*)((const char*)(gbase) + (voff)[_i]), (PG8_LAS unsigned*)(lds + (bufoff) + ldsw + _i * 8192), 16, 0, 0); } while (0)
#define PG8_LDA(dst, b, h) do { _Pragma("unroll") for (int m = 0; m < 4; ++m) _Pragma("unroll") for (int k = 0; k < 2; ++k) dst[m][k] = *(const PG8_LAS bf16x8*)(lds + PG8_SA(b, h) + aoff + m * 2048 + k * 1024); } while (0)
#define PG8_LDB(dst, b, h) do { _Pragma("unroll") for (int n = 0; n < 2; ++n) _Pragma("unroll") for (int k = 0; k < 2; ++k) dst[n][k] = *(const PG8_LAS bf16x8*)(lds + PG8_SB(b, h) + boff + n * 2048 + k * 1024); } while (0)
#define PG8_MMA(ai, bj, At, Bt) do { __builtin_amdgcn_s_setprio(1); _Pragma("unroll") for (int m = 0; m < 4; ++m) _Pragma("unroll") for (int n = 0; n < 2; ++n) _Pragma("unroll") for (int k = 0; k < 2; ++k) \
        acc[ai][bj][m][n] = __builtin_amdgcn_mfma_f32_16x16x32_bf16(Bt[n][k], At[m][k], acc[ai][bj][m][n], 0, 0, 0); __builtin_amdgcn_s_setprio(0); } while (0)
#define PG8_WAIT_V(n) asm volatile("s_waitcnt vmcnt(" #n ")" ::: "memory")
#define PG8_WAIT_L(n) asm volatile("s_waitcnt lgkmcnt(" #n ")" ::: "memory")
#define PG8_BAR __builtin_amdgcn_s_barrier()
#define PG8_SCHED __builtin_amdgcn_sched_barrier(0)
    Unit cur, nxt; int ui = 0;
    if (!S.next(0, cur)) return;
    f32x4 acc[2][2][4][2];
#pragma unroll
    for (int a = 0; a < 2; ++a)
#pragma unroll
        for (int b = 0; b < 2; ++b)
#pragma unroll
            for (int m = 0; m < 4; ++m)
#pragma unroll
                for (int n = 0; n < 2; ++n) acc[a][b][m][n] = (f32x4){0.f, 0.f, 0.f, 0.f};
    bf16x8 At[4][2], B0[2][2], B1[2][2];
    UMem cm = P.mem(cur);
    const char* cA = cm.A; const char* cB = cm.B; int nt = cm.nt;
    if constexpr (SP2) {
        PG8_STAGE(PG8_SB(0, 0), cB, voffB); PG8_STAGE(PG8_SB(0, 1), cB + hstepB, voffB); PG8_STAGE(PG8_SA(0, 0), cA, voffA); PG8_STAGE(PG8_SA(0, 1), cA + hstepA, voffA);
        if (wr == 1) PG8_BAR;
        PG8_WAIT_V(2); PG8_BAR;
        PG8_STAGE(PG8_SB(1, 0), cB + kstep, voffB); PG8_STAGE(PG8_SA(1, 0), cA + kstep, voffA); PG8_STAGE(PG8_SB(1, 1), cB + hstepB + kstep, voffB);
        PG8_WAIT_V(6); PG8_BAR;
    } else {
        PG8_STAGE(PG8_SB(0, 0), cB, voffB); PG8_STAGE(PG8_SA(0, 0), cA, voffA); PG8_STAGE(PG8_SB(0, 1), cB + hstepB, voffB); PG8_STAGE(PG8_SA(0, 1), cA + hstepA, voffA);
        if (wr == 1) PG8_BAR;
        PG8_WAIT_V(4); PG8_BAR;
        PG8_STAGE(PG8_SB(1, 0), cB + kstep, voffB); PG8_STAGE(PG8_SA(1, 0), cA + kstep, voffA); PG8_STAGE(PG8_SB(1, 1), cB + hstepB + kstep, voffB);
        PG8_WAIT_V(6); PG8_BAR;
    }
    for (;;) {
        const bool has_next = S.next(ui + 1, nxt);
        UMem nm = cm; if (has_next) nm = P.mem(nxt);
        const char* nA = has_next ? nm.A : cA; const char* nB = has_next ? nm.B : cB;
        for (int t = 0; t < nt; t += 2) {
            const bool last = (t == nt - 2);
            const char* a1 = cA + (size_t)(t + 1) * kstep;
            const char* a2 = last ? nA : cA + (size_t)(t + 2) * kstep; const char* b2 = last ? nB : cB + (size_t)(t + 2) * kstep;
            const char* a3 = a2 + kstep; const char* b3 = b2 + kstep;
            if constexpr (SP2) {
            PG8_LDB(B0, 0, 0); PG8_LDB(B1, 0, 1); PG8_SCHED; PG8_LDA(At, 0, 0); PG8_STAGE(PG8_SA(1, 1), a1 + hstepA, voffA);
            PG8_WAIT_V(8); PG8_WAIT_L(0); PG8_BAR; PG8_MMA(0, 0, At, B0); PG8_MMA(0, 1, At, B1); PG8_BAR; PG8_SCHED;
            PG8_LDA(At, 0, 1); PG8_STAGE(PG8_SB(0, 0), b2, voffB); PG8_STAGE(PG8_SB(0, 1), b2 + hstepB, voffB); PG8_STAGE(PG8_SA(0, 0), a2, voffA);
            PG8_WAIT_V(8); PG8_WAIT_L(0); PG8_BAR; PG8_MMA(1, 0, At, B0); PG8_MMA(1, 1, At, B1); PG8_BAR; PG8_SCHED;
            PG8_LDB(B0, 1, 0); PG8_LDB(B1, 1, 1); PG8_SCHED; PG8_LDA(At, 1, 0); PG8_STAGE(PG8_SA(0, 1), a2 + hstepA, voffA);
            PG8_WAIT_V(8); PG8_WAIT_L(0); PG8_BAR; PG8_MMA(0, 0, At, B0); PG8_MMA(0, 1, At, B1); PG8_BAR; PG8_SCHED;
            PG8_LDA(At, 1, 1); PG8_STAGE(PG8_SB(1, 0), b3, voffB); PG8_STAGE(PG8_SB(1, 1), b3 + hstepB, voffB); PG8_STAGE(PG8_SA(1, 0), a3, voffA);
            PG8_WAIT_V(8); PG8_WAIT_L(0); PG8_BAR; PG8_MMA(1, 0, At, B0); PG8_MMA(1, 1, At, B1); PG8_BAR; PG8_SCHED;
            } else {
            PG8_LDB(B0, 0, 0); PG8_SCHED; PG8_LDA(At, 0, 0); PG8_STAGE(PG8_SA(1, 1), a1 + hstepA, voffA);
            PG8_WAIT_L(8); PG8_BAR; PG8_WAIT_L(0); PG8_MMA(0, 0, At, B0); PG8_BAR; PG8_SCHED;
            PG8_LDB(B1, 0, 1); PG8_STAGE(PG8_SB(0, 0), b2, voffB);
            PG8_BAR; PG8_WAIT_L(0); PG8_MMA(0, 1, At, B1); PG8_BAR;
            PG8_LDA(At, 0, 1); PG8_STAGE(PG8_SA(0, 0), a2, voffA);
            PG8_BAR; PG8_WAIT_L(0); PG8_MMA(1, 0, At, B0); PG8_BAR; PG8_SCHED;
            PG8_STAGE(PG8_SB(0, 1), b2 + hstepB, voffB);
            PG8_WAIT_V(6); PG8_BAR; PG8_MMA(1, 1, At, B1); PG8_BAR;
            PG8_LDB(B0, 1, 0); PG8_SCHED; PG8_LDA(At, 1, 0); PG8_STAGE(PG8_SA(0, 1), a2 + hstepA, voffA);
            PG8_WAIT_L(8); PG8_BAR; PG8_WAIT_L(0); PG8_MMA(0, 0, At, B0); PG8_BAR; PG8_SCHED;
            PG8_LDB(B1, 1, 1); PG8_STAGE(PG8_SB(1, 0), b3, voffB);
            PG8_BAR; PG8_WAIT_L(0); PG8_MMA(0, 1, At, B1); PG8_BAR;
            PG8_LDA(At, 1, 1); PG8_STAGE(PG8_SA(1, 0), a3, voffA);
            PG8_BAR; PG8_WAIT_L(0); PG8_MMA(1, 0, At, B0); PG8_BAR; PG8_SCHED;
            PG8_STAGE(PG8_SB(1, 1), b3 + hstepB, voffB);
            PG8_WAIT_V(6); PG8_BAR; PG8_MMA(1, 1, At, B1); PG8_BAR;
            }
        }
        if constexpr (ALIGN_EPI) { if (wr == 0) PG8_BAR; }
        E(acc, cur, wr, wc, fr, fq);
        if (!has_next) break;
        if (!E.keep(cur)) {
#pragma unroll
        for (int a = 0; a < 2; ++a)
#pragma unroll
            for (int b = 0; b < 2; ++b)
#pragma unroll
                for (int m = 0; m < 4; ++m)
#pragma unroll
                    for (int n = 0; n < 2; ++n) acc[a][b][m][n] = (f32x4){0.f, 0.f, 0.f, 0.f};
        }
        cur = nxt; cm = nm; cA = nA; cB = nB; nt = nm.nt; ++ui;
        if constexpr (ALIGN_EPI) { if (wr == 1) PG8_BAR; }
    }
    PG8_WAIT_V(0);
    if constexpr (!ALIGN_EPI) { if (wr == 0) PG8_BAR; }
    PG8_BAR;
#undef PG8_SA
#undef PG8_SB
#undef PG8_STAGE
#undef PG8_LDA
#undef PG8_LDB
#undef PG8_MMA
#undef PG8_WAIT_V
#undef PG8_WAIT_L
#undef PG8_BAR
#undef PG8_SCHED
}
}
namespace attn_body {
using bf16=__hip_bfloat16;
using bf16x8=__attribute__((ext_vector_type(8)))short;
using s16x4=__attribute__((ext_vector_type(4)))short;
using f32x16=__attribute__((ext_vector_type(16)))float;
using u32x4=__attribute__((ext_vector_type(4)))unsigned;
using f32x4v=__attribute__((ext_vector_type(4)))float;
constexpr int BATCH=8,NHEAD=8,SEQ=4096,D=64,DM=NHEAD*D;
constexpr int NW=8,QBLK=32,QB=QBLK*NW,KVBLK=64,NQB=SEQ/QB;
constexpr int ATTN_PITCH=DM, ATTN_UNIT_ROWS=QB;
__device__ __forceinline__ int crow(int r,int hi){return (r&3)+8*(r>>2)+4*hi;}
#define SBAR() __builtin_amdgcn_sched_barrier(0)
__device__ __forceinline__ void cmask(f32x16&p0,f32x16&p1,int jb,int qrel,int hi){
  const float NEG=-INFINITY; int kb=64*jb+4*hi;
  #pragma unroll
  for(int r=0;r<16;++r){int kv=kb+(r&3)+8*(r>>2); if(kv>qrel)p0[r]=NEG; if(kv+32>qrel)p1[r]=NEG;}
}

constexpr int NSLOT=3, SLOTB=8192;
constexpr int LDS_K=0, LDS_V=NSLOT*SLOTB, LDS_WS=2*NSLOT*SLOTB, LDS_OST=LDS_WS+NW*64*4, LDS_C2=LDS_OST+NW*4096, LDS_WSUM=LDS_C2+SEQ*4, LDS_KX=LDS_WSUM+64, LDS_BYTES=LDS_KX+SEQ*8;
constexpr float C2=0.125f*1.4426950408889634f;
__device__ __forceinline__ void glds16(const void*gsrc,unsigned lds_dst){unsigned keep;
  asm volatile("s_mov_b32 %0, m0\n\ts_mov_b32 m0, %2\n\ts_nop 0\n\tglobal_load_lds_dwordx4 %1, off\n\ts_mov_b32 m0, %0":"=&s"(keep):"v"(gsrc),"s"(lds_dst):"memory");}
__device__ __forceinline__ float max3f(float a,float b,float c){float r;asm("v_max3_f32 %0, %1, %2, %3":"=v"(r):"v"(a),"v"(b),"v"(c));return r;}
__device__ __forceinline__ float max2f(float a,float b){float r;asm("v_max_f32_e32 %0, %1, %2":"=v"(r):"v"(a),"v"(b));return r;}
__device__ __forceinline__ float fadd_s(float a,float b){float r;asm("v_add_f32_e32 %0, %1, %2":"=v"(r):"v"(a),"v"(b));return r;}
__device__ __forceinline__ float fsub_s(float a,float b){float r;asm("v_sub_f32_e32 %0, %1, %2":"=v"(r):"v"(a),"v"(b));return r;}
typedef float f32x2_t __attribute__((ext_vector_type(2))); typedef __bf16 bf16x2_t __attribute__((ext_vector_type(2)));
__device__ __forceinline__ unsigned cvtpk_s(float lo,float hi){f32x2_t v={lo,hi};bf16x2_t b=__builtin_convertvector(v,bf16x2_t);return __builtin_bit_cast(unsigned,b);}
#define WAIT_BAR(N) asm volatile("s_waitcnt vmcnt(" #N ") lgkmcnt(0)\n\ts_barrier":::"memory")

__device__ __forceinline__ void qkt(f32x16&p0,f32x16&p1,const char*Kslot,const bf16x8*qr,int r32,int hi){
  const char*kb=Kslot+hi*1024+r32*16;
  #pragma unroll
  for(int d0=0;d0<4;++d0){
    const bf16x8 b0=*reinterpret_cast<const bf16x8*>(kb+d0*2048);
    const bf16x8 b1=*reinterpret_cast<const bf16x8*>(kb+d0*2048+512);
    {p0=__builtin_amdgcn_mfma_f32_32x32x16_bf16(b0,qr[d0],p0,0,0,0);p1=__builtin_amdgcn_mfma_f32_32x32x16_bf16(b1,qr[d0],p1,0,0,0);}}
}
typedef __attribute__((address_space(3))) const char* lds_cptr;
typedef short v4i16_t __attribute__((ext_vector_type(4)));
__device__ __forceinline__ void kload8(bf16x8*kf,lds_cptr kp){
  kf[0]=*(const __attribute__((address_space(3))) bf16x8*)(kp);      kf[1]=*(const __attribute__((address_space(3))) bf16x8*)(kp+512);
  kf[2]=*(const __attribute__((address_space(3))) bf16x8*)(kp+2048); kf[3]=*(const __attribute__((address_space(3))) bf16x8*)(kp+2560);
  kf[4]=*(const __attribute__((address_space(3))) bf16x8*)(kp+4096); kf[5]=*(const __attribute__((address_space(3))) bf16x8*)(kp+4608);
  kf[6]=*(const __attribute__((address_space(3))) bf16x8*)(kp+6144); kf[7]=*(const __attribute__((address_space(3))) bf16x8*)(kp+6656);
}
__device__ __forceinline__ void kload2(bf16x8*kf,lds_cptr kp,int j){ kf[2*j]=*(const __attribute__((address_space(3))) bf16x8*)(kp+j*2048); kf[2*j+1]=*(const __attribute__((address_space(3))) bf16x8*)(kp+j*2048+512); }
__device__ __forceinline__ s16x4 vtr(lds_cptr p){ return __builtin_bit_cast(s16x4,__builtin_amdgcn_ds_read_tr16_b64_v4i16((__attribute__((address_space(3))) v4i16_t*)p)); }
__device__ __forceinline__ float rowmax(const f32x16&p0,const f32x16&p1){
  float a=max3f(p0[0],p0[1],p1[0]),b=max3f(p0[2],p0[3],p1[1]);a=max3f(a,p1[2],p1[3]);
  #pragma unroll
  for(int r=4;r<16;r+=4){a=max3f(a,p0[r],p0[r+1]);b=max3f(b,p0[r+2],p0[r+3]);a=max3f(a,p1[r],p1[r+1]);b=max3f(b,p1[r+2],p1[r+3]);}
  const float m=max2f(a,b);
  auto rr=__builtin_amdgcn_permlane32_swap(__float_as_uint(m),__float_as_uint(m),false,false);
  return max2f(__uint_as_float(rr[0]),__uint_as_float(rr[1]));
}
__device__ __forceinline__ void pv(f32x16*o,int vb,bf16x8 pa0,bf16x8 pa1,bf16x8 pa2,bf16x8 pa3){
  #pragma unroll
  for(int d0=0;d0<2;++d0){s16x4 lo[4],hi[4];
    #pragma unroll
    for(int ks=0;ks<4;++ks){
      asm volatile("ds_read_b64_tr_b16 %0,%1 offset:%c2":"=&v"(lo[ks]):"v"(vb),"i"(d0*4096+ks*1024):"memory");
      asm volatile("ds_read_b64_tr_b16 %0,%1 offset:%c2":"=&v"(hi[ks]):"v"(vb),"i"(d0*4096+ks*1024+512):"memory");}
    asm volatile("s_waitcnt lgkmcnt(0)":::"memory");SBAR();
    #define PK(k) (bf16x8){lo[k][0],lo[k][1],lo[k][2],lo[k][3],hi[k][0],hi[k][1],hi[k][2],hi[k][3]}
    o[d0]=__builtin_amdgcn_mfma_f32_32x32x16_bf16(pa0,PK(0),o[d0],0,0,0);
    o[d0]=__builtin_amdgcn_mfma_f32_32x32x16_bf16(pa1,PK(1),o[d0],0,0,0);
    o[d0]=__builtin_amdgcn_mfma_f32_32x32x16_bf16(pa2,PK(2),o[d0],0,0,0);
    o[d0]=__builtin_amdgcn_mfma_f32_32x32x16_bf16(pa3,PK(3),o[d0],0,0,0);
    #undef PK
  }
}

#ifndef ATTN_STORE16
#define ATTN_STORE16(p,v) (*(u32x4*)(p)=(v))
#endif
template<int THRL> __device__ __forceinline__ void attn_unit(int b,int h,int qb,const bf16*Q,const bf16*__restrict__ K,const bf16*__restrict__ V,bf16*O,char*shm,float dthr2,float mref2){
  typedef __attribute__((address_space(3))) const float* lds_cf; typedef __attribute__((address_space(3))) const f32x4v* lds_cf4;
  const int tid=opaque_i(threadIdx.x),lane=tid&63,r32=lane&31,hi=lane>>5; const int wid=__builtin_amdgcn_readfirstlane(tid>>6);
  const long rowbase=(long)b*SEQ; const int q0=qb*QB;
  const bf16*Qw=Q+(rowbase+q0+wid*QBLK)*DM+h*D;
  int T0;
  { const lds_cf c2all=(lds_cf)((lds_cptr)shm+LDS_C2); const float thr=c2all[q0]-dthr2; const bool skp=c2all[64*lane+63]<thr; const unsigned long long bal=__ballot(skp);
    const int nskip=(~bal==0ull)?64:(int)__builtin_ctzll(~bal); const int ntf=(q0+QB)/KVBLK; int t0=nskip&~1; if(t0>ntf-4)t0=ntf-4; T0=__builtin_amdgcn_readfirstlane(t0); }
  const bf16*Kh=K+(rowbase+(long)T0*KVBLK)*DM+h*D,*Vh=V+(rowbase+(long)T0*KVBLK)*DM+h*D;
  const unsigned lds0=(unsigned)(uintptr_t)shm;
  float*wsf=(float*)(shm+LDS_WS)+wid*64;
  const bf16*ksrc=Kh+(long)lane*DM+wid*8;
  const bf16*vsrc=Vh+(long)(16*(wid&3)+(lane>>2))*DM+(wid>>2)*32+(lane&3)*8;
  const unsigned kdst=lds0+LDS_K+wid*1024, vdst=lds0+LDS_V+wid*1024;
  #define DMA_K(t,slot) glds16(ksrc+(long)(t)*KVBLK*DM,(unsigned)__builtin_amdgcn_readfirstlane(kdst+(slot)))
  #define DMA_V(t,slot) glds16(vsrc+(long)(t)*KVBLK*DM,(unsigned)__builtin_amdgcn_readfirstlane(vdst+(slot)))
  const int vb0=(int)(lds0+LDS_V)+((lane>>4)&1)*32+(lane&3)*8+(4*hi+((lane&15)>>2))*64;
  const char*Kbase=shm+LDS_K; bf16x8 kf[8];
  const lds_cptr shm3=(lds_cptr)shm; const lds_cptr kp0=shm3+LDS_K+hi*1024+r32*16; const lds_cptr vp0=shm3+LDS_V+((lane>>4)&1)*32+(lane&3)*8+(4*hi+((lane&15)>>2))*64;
  const int NT=(q0+QB)/KVBLK-T0;
  DMA_K(0,0);DMA_V(0,0);DMA_K(1,SLOTB);
  bf16x8 qr[4];
  #pragma unroll
  for(int d0=0;d0<4;++d0)qr[d0]=*reinterpret_cast<const bf16x8*>(&Qw[(long)r32*DM+d0*16+hi*8]);
  float l_reg=0.f;f32x16 o[2];o[0]=f32x16{};o[1]=f32x16{};
  const float k0c=-(((lds_cf)((lds_cptr)shm+LDS_C2))[q0+wid*QBLK+r32]+mref2);
  bf16x8 qx;
  { const unsigned h_=__float_as_uint(k0c); const unsigned kh=(h_+0x7fffu+((h_>>16)&1u))>>16; const float r1_=k0c-__uint_as_float(kh<<16);
    const unsigned m_=__float_as_uint(r1_); const unsigned km=(m_+0x7fffu+((m_>>16)&1u))>>16; const float r2_=r1_-__uint_as_float(km<<16);
    const unsigned l_=__float_as_uint(r2_); const unsigned kl=(l_+0x7fffu+((l_>>16)&1u))>>16;
    u32x4 w_; w_.x=hi?0u:0x3F803F80u; w_.y=hi?0u:(0x3F80u|(kh<<16)); w_.z=hi?0u:(km|(kl<<16)); w_.w=0u; qx=__builtin_bit_cast(bf16x8,w_); }
  typedef __attribute__((address_space(3))) const unsigned long long* lds_cu64;
  const lds_cu64 kxp=(lds_cu64)((lds_cptr)shm+LDS_KX)+T0*KVBLK+r32;
  #define KXF(v_) __builtin_bit_cast(bf16x8,(u32x4){(unsigned)(v_),(unsigned)((v_)>>32),0x3F803F80u,0u})
  #define CINIT(C0,C1,t) do{ const unsigned long long a_=kxp[(t)*KVBLK], b_=kxp[(t)*KVBLK+32]; const f32x16 z_=f32x16{}; \
    C0=__builtin_amdgcn_mfma_f32_32x32x16_bf16(KXF(a_),qx,z_,0,0,0); C1=__builtin_amdgcn_mfma_f32_32x32x16_bf16(KXF(b_),qx,z_,0,0,0); }while(0)
  const int qrel=wid*QBLK+r32;
  #define CMASK(P0,P1,t) do{int jb_=(t)-(NT-4); if(jb_>=0)cmask(P0,P1,jb_,qrel,hi);}while(0)
  #define START(P0,P1) do{ _Pragma("unroll") for(int r=0;r<16;++r)P0[r]=__builtin_amdgcn_exp2f(P0[r]); }while(0)
  #define RESC() do{}while(0)
  f32x16 pA0,pA1,pB0,pB1;
  int sl_prev=0,sl_cur=0,sl_next=SLOTB;
  #define ROT() do{sl_prev=sl_cur;sl_cur=sl_next;sl_next=(sl_next==(NSLOT-1)*SLOTB)?0:sl_next+SLOTB;}while(0)
  DMA_K(2,2*SLOTB);
  WAIT_BAR(3);
  CINIT(pA0,pA1,0); qkt(pA0,pA1,Kbase,qr,r32,hi);asm volatile("s_nop 15\n\ts_nop 7":"+v"(pA0),"+v"(pA1));CMASK(pA0,pA1,0);
  START(pA0,pA1);
  _Pragma("unroll") for(int r=0;r<16;++r)pA1[r]=__builtin_amdgcn_exp2f(pA1[r]);
  WAIT_BAR(0);
  DMA_K(3,0);DMA_V(1,SLOTB);
  ROT();
  kload8(kf,kp0+sl_cur);
  WAIT_BAR(2);
  s16x4 vlo[8],vhi[8]; u32x4 pw0,pw1,pw2,pw3;
  #define PKW(P,B) cvtpk_s(P[B],P[B+1])
  #define PAF(k) __builtin_bit_cast(bf16x8,pw##k)
  #define VFR(i) (bf16x8){vlo[i][0],vlo[i][1],vlo[i][2],vlo[i][3],vhi[i][0],vhi[i][1],vhi[i][2],vhi[i][3]}
  #define PIN(x) asm volatile("":"+v"(x))
  #define MX3(a,b,c) __builtin_fmaxf(__builtin_fmaxf((a),(b)),(c))
  #define GAPA(MF,A0,A1,A2,A3,W0,W1,PW) do{ MF; sacc+=A0; sacc+=A1; sacc+=A2; sacc+=A3; PIN(sacc); W0; W1; PIN(PW); SBAR(); }while(0)
  #define EX(v) __builtin_amdgcn_exp2f(v)
  #define GAPB(MF,X,B) do{ MF; X[B]=EX(X[B]); X[B+1]=EX(X[B+1]); X[B+2]=EX(X[B+2]); X[B+3]=EX(X[B+3]); PIN(X); SBAR(); }while(0)
  #define VRD(i) do{ vlo[i]=vtr(vp_+(((i)>>2)*4096+((i)&3)*1024)); vhi[i]=vtr(vp_+(((i)>>2)*4096+((i)&3)*1024+512)); }while(0)
  #define KRD(G,j) do{ if(G){ kload2(kf,kp0+sl_next,j); SBAR(); } }while(0)
  #define STEP(C0,C1,P0,P1,t,GK,GV,GL) do{ SBAR(); CINIT(C0,C1,t); SBAR(); \
    const lds_cptr vp_=vp0+sl_prev; \
    VRD(0); SBAR(); float sacc=(P0[0]+P0[1]); \
    GAPA(C0=__builtin_amdgcn_mfma_f32_32x32x16_bf16(kf[0],qr[0],C0,0,0,0), P0[2],P0[3],P0[4],P0[5],     pw0[0]=PKW(P0,0), pw0[1]=PKW(P0,2), pw0); \
    VRD(4); SBAR(); GAPA(C1=__builtin_amdgcn_mfma_f32_32x32x16_bf16(kf[1],qr[0],C1,0,0,0), P0[6],P0[7],P0[8],P0[9],     pw0[2]=PKW(P0,4), pw0[3]=PKW(P0,6), pw0); \
    VRD(1); SBAR(); GAPA(C0=__builtin_amdgcn_mfma_f32_32x32x16_bf16(kf[2],qr[1],C0,0,0,0),   P0[10],P0[11],P0[12],P0[13], pw1[0]=PKW(P0,8), pw1[1]=PKW(P0,10), pw1); \
    VRD(5); SBAR(); GAPA(C1=__builtin_amdgcn_mfma_f32_32x32x16_bf16(kf[3],qr[1],C1,0,0,0),   P0[14],P0[15],P1[0],P1[1],   pw1[2]=PKW(P0,12),pw1[3]=PKW(P0,14), pw1); \
    VRD(2); SBAR(); GAPA(C0=__builtin_amdgcn_mfma_f32_32x32x16_bf16(kf[4],qr[2],C0,0,0,0),   P1[2],P1[3],P1[4],P1[5],     pw2[0]=PKW(P1,0), pw2[1]=PKW(P1,2), pw2); \
    VRD(6); SBAR(); GAPA(C1=__builtin_amdgcn_mfma_f32_32x32x16_bf16(kf[5],qr[2],C1,0,0,0),   P1[6],P1[7],P1[8],P1[9],     pw2[2]=PKW(P1,4), pw2[3]=PKW(P1,6), pw2); \
    VRD(3); SBAR(); GAPA(C0=__builtin_amdgcn_mfma_f32_32x32x16_bf16(kf[6],qr[3],C0,0,0,0),   P1[10],P1[11],P1[12],P1[13], pw3[0]=PKW(P1,8), pw3[1]=PKW(P1,10), pw3); \
    VRD(7); SBAR(); GAPA(C1=__builtin_amdgcn_mfma_f32_32x32x16_bf16(kf[7],qr[3],C1,0,0,0),   P1[14],P1[15],0.f,0.f,       pw3[2]=PKW(P1,12),pw3[3]=PKW(P1,14), pw3); \
    l_reg+=sacc; \
    if(GK){DMA_K((t)+3,sl_cur);} if(GV){DMA_V((t)+1,sl_next);} \
    CMASK(C0,C1,t); \
    SBAR(); \
    GAPB(o[0]=__builtin_amdgcn_mfma_f32_32x32x16_bf16(PAF(0),VFR(0),o[0],0,0,0), C0,0); \
    GAPB(o[1]=__builtin_amdgcn_mfma_f32_32x32x16_bf16(PAF(0),VFR(4),o[1],0,0,0), C0,4); \
    KRD(GL,0); GAPB(o[0]=__builtin_amdgcn_mfma_f32_32x32x16_bf16(PAF(1),VFR(1),o[0],0,0,0), C0,8); \
    KRD(GL,1); GAPB(o[1]=__builtin_amdgcn_mfma_f32_32x32x16_bf16(PAF(1),VFR(5),o[1],0,0,0), C0,12); \
    KRD(GL,2); GAPB(o[0]=__builtin_amdgcn_mfma_f32_32x32x16_bf16(PAF(2),VFR(2),o[0],0,0,0), C1,0); \
    KRD(GL,3); GAPB(o[1]=__builtin_amdgcn_mfma_f32_32x32x16_bf16(PAF(2),VFR(6),o[1],0,0,0), C1,4); \
    GAPB(o[0]=__builtin_amdgcn_mfma_f32_32x32x16_bf16(PAF(3),VFR(3),o[0],0,0,0), C1,8); \
    GAPB(o[1]=__builtin_amdgcn_mfma_f32_32x32x16_bf16(PAF(3),VFR(7),o[1],0,0,0), C1,12); \
    }while(0)
  int t=1;
  #undef CMASK
  #define CMASK(P0,P1,t) do{}while(0)
  for(;t+5<NT;t+=2){
    STEP(pB0,pB1,pA0,pA1,t,true,true,true);     WAIT_BAR(2); RESC(); ROT();
    STEP(pA0,pA1,pB0,pB1,t+1,true,true,true);   WAIT_BAR(2); RESC(); ROT();
  }
  #undef CMASK
  #define CMASK(P0,P1,t) do{int jb_=(t)-(NT-4); if(jb_>=0)cmask(P0,P1,jb_,qrel,hi);}while(0)
  #define ENDW(tt) do{ if((tt)+3<NT){WAIT_BAR(2);} else if((tt)+2<NT){WAIT_BAR(1);} else {WAIT_BAR(0);} }while(0)
  for(;t+1<NT;t+=2){
    STEP(pB0,pB1,pA0,pA1,t,(t+3<NT),(t+1<NT),(t+1<NT));       ENDW(t);   RESC(); ROT();
    STEP(pA0,pA1,pB0,pB1,t+1,(t+4<NT),(t+2<NT),(t+2<NT));     ENDW(t+1); RESC(); ROT();
  }
  STEP(pB0,pB1,pA0,pA1,NT-1,false,false,false); RESC();
  { float sacc=pB0[0]+pB0[1]; _Pragma("unroll") for(int r=2;r<16;++r)sacc+=pB0[r]; _Pragma("unroll") for(int r=0;r<16;++r)sacc+=pB1[r]; l_reg+=sacc;
    pw0=(u32x4){PKW(pB0,0),PKW(pB0,2),PKW(pB0,4),PKW(pB0,6)};pw1=(u32x4){PKW(pB0,8),PKW(pB0,10),PKW(pB0,12),PKW(pB0,14)};pw2=(u32x4){PKW(pB1,0),PKW(pB1,2),PKW(pB1,4),PKW(pB1,6)};pw3=(u32x4){PKW(pB1,8),PKW(pB1,10),PKW(pB1,12),PKW(pB1,14)};
    SBAR(); pv(o,vb0+sl_cur,PAF(0),PAF(1),PAF(2),PAF(3)); }
  #undef PKW
  #undef PAF
  #undef VFR
  #undef PIN
  #undef MX3
  #undef GAPA
  #undef GAPB
  #undef EX
  #undef VRD
  #undef KRD
  #undef STEP
  #undef ENDW
  {auto rr=__builtin_amdgcn_permlane32_swap(__float_as_uint(l_reg),__float_as_uint(l_reg),false,false);l_reg=__uint_as_float(rr[0])+__uint_as_float(rr[1]);}
  if(hi==0)wsf[32+r32]=l_reg;asm volatile("s_waitcnt lgkmcnt(0)":::"memory");
  float rli[16];
  #pragma unroll
  for(int r=0;r<16;++r)rli[r]=__builtin_amdgcn_rcpf(wsf[32+crow(r,hi)]);
  bf16*Ow=O+(rowbase+q0+wid*QBLK)*DM+h*D;
  { bf16*stg=(bf16*)(shm+LDS_OST)+wid*2048;
    #pragma unroll
    for(int r=0;r<16;++r){const int orow=crow(r,hi);
      #pragma unroll
      for(int d0=0;d0<2;++d0)stg[orow*64+d0*32+r32]=__float2bfloat16(o[d0][r]*rli[r]);}
    asm volatile("s_waitcnt lgkmcnt(0)":::"memory");
    #pragma unroll
    for(int i=0;i<4;++i){const int row=i*8+(lane>>3),ch=lane&7; const u32x4 v=*(const u32x4*)(stg+row*64+ch*8); ATTN_STORE16(Ow+(long)row*DM+ch*8,v);} }
  asm volatile("s_waitcnt lgkmcnt(0)\n\ts_barrier":::"memory");
  #undef CINIT
  #undef KXF
  #undef DMA_K
  #undef DMA_V
  #undef CMASK
  #undef START
  #undef RESC
  #undef ROT
}
constexpr int ATTN_LDS_BYTES=LDS_BYTES;
struct AttnTensors { const bf16* Q; const bf16* K; const bf16* V; bf16* O; };
struct AttnUnit { int bh; int qb; };
struct StaticOrder {
  int vcu;
  __device__ __forceinline__ explicit StaticOrder(int grid,int block):vcu((block%8)*(grid/8)+block/8){}
  __device__ __forceinline__ bool next(int i,AttnUnit&u)const{ if(i>=4)return false; const int s=vcu&3; u.bh=vcu>>2; u.qb=(i==0)?15-s:(i==1)?8+s:(i==2)?7-s:s; return true; }
  __device__ __forceinline__ void a_ready(const AttnUnit&)const{}
  __device__ __forceinline__ void done(const AttnUnit&)const{}
};
template<class Sched,int THRL=8> __device__ __forceinline__ void attn_phase(char*lds,const AttnTensors&T,const Sched&S){
  AttnUnit u;
  for(int i=0;S.next(i,u);++i){ S.a_ready(u); attn_unit<THRL>(u.bh/NHEAD,u.bh%NHEAD,u.qb,T.Q,T.K,T.V,T.O,lds,1e30f,16.0f); S.done(u); }
}
#undef SBAR
#undef WAIT_BAR
}
constexpr size_t MiB = 1u << 20;
constexpr size_t WS_SSQ_MIX = 0;
constexpr size_t WS_LOGF = 2 * MiB;
constexpr size_t WS_BAR = 3 * MiB + 512 * 1024;
constexpr size_t WS_WF = 3 * MiB;
constexpr size_t WS_W = 4 * MiB, W_PAR = 32 * MiB;
constexpr size_t W_WIN = 0, W_WM = 11 * MiB, W_WO = 13 * MiB, W_WFI = 15 * MiB, W_WFO = 26 * MiB;
constexpr size_t WS_XB = 68 * MiB;
constexpr size_t WS_Q = 132 * MiB, WS_K = 164 * MiB, WS_V = 196 * MiB;
constexpr size_t WS_CP = 228 * MiB;
constexpr size_t WS_G = 292 * MiB;
constexpr size_t WS_SSQ_FFN = 484 * MiB;
constexpr size_t WS_END = 486 * MiB;
constexpr int LDS_BYTES = 147456;
constexpr int NWAVES = 8;

#define GAS __attribute__((address_space(1)))
#define LAS __attribute__((address_space(3)))
typedef unsigned short bf16;
typedef unsigned v4u __attribute__((ext_vector_type(4)));
typedef float f32x4 __attribute__((ext_vector_type(4)));
#define LDS_WAIT() asm volatile("s_waitcnt lgkmcnt(0)" ::: "memory")
__device__ __forceinline__ unsigned f2bf(float f) { unsigned u = __builtin_bit_cast(unsigned, f); return (u + 0x7fffu + ((u >> 16) & 1u)) >> 16; }
__device__ __forceinline__ unsigned pk2(float lo, float hi) { return f2bf(lo) | (f2bf(hi) << 16); }
__device__ __forceinline__ float wave_sum(float v) {
#pragma unroll
    for (int o = 1; o < 64; o <<= 1) v += __shfl_xor(v, o);
    return v;
}

__device__ __forceinline__ void tr_item(const float* W, int ldn, int n0, int k0, const float* gain, bf16* WT, int ldk, int drow0, int koff, LAS float* scr, int lane) {
    { const int c4 = lane & 7, kr = lane >> 3;
#pragma unroll
      for (int i = 0; i < 8; ++i) { const int kk = 8 * i + kr; f32x4 w = *(const f32x4*)(W + (size_t)(k0 + kk) * ldn + n0 + 4 * c4); if (gain) w *= gain[k0 + kk];
          LAS float* d = scr + kk * 33 + 4 * c4; d[0] = w.x; d[1] = w.y; d[2] = w.z; d[3] = w.w; } }
    LDS_WAIT(); asm volatile("" ::: "memory");
    const int c = lane & 7;
#pragma unroll
    for (int j = 0; j < 4; ++j) { const int n = (lane >> 3) + 8 * j; const LAS float* s = scr + (8 * c) * 33 + n;
        v4u o; o.x = pk2(s[0 * 33], s[1 * 33]); o.y = pk2(s[2 * 33], s[3 * 33]); o.z = pk2(s[4 * 33], s[5 * 33]); o.w = pk2(s[6 * 33], s[7 * 33]);
        *(v4u*)(WT + (size_t)(drow0 + n) * ldk + koff + k0 + 8 * c) = o; }
    LDS_WAIT(); asm volatile("" ::: "memory");
}

#define XB_TMO      128
#define XB_XCNT(j)  (256  + 64 * (j))
#define XB_XSUB(j)  (1280 + 64 * (j))
#define XB_XGEN(j)  (2304 + 64 * (j))
#define XB_TOP      3328
#define XB_TOPGEN   3392
#define XCD_BAR_WORDS 3456
#define XB_SPIN_CAP (1u << 18)

__device__ __forceinline__ unsigned xb_ld(unsigned* p)              { return __hip_atomic_load(p, __ATOMIC_RELAXED, __HIP_MEMORY_SCOPE_AGENT); }
__device__ __forceinline__ unsigned xb_add(unsigned* p, unsigned v) { return __hip_atomic_fetch_add(p, v, __ATOMIC_RELAXED, __HIP_MEMORY_SCOPE_AGENT); }
__device__ __forceinline__ unsigned xb_xcc_id() { return (unsigned)__builtin_amdgcn_s_getreg((3 << 11) | 20) & 0xFu; }
#define XB_SPIN(cond, bar) do { unsigned _sp = 0; while (cond) { __builtin_amdgcn_s_sleep(1); \
    if ((++_sp & 255u) == 0u) { if (xb_ld(&(bar)[XB_TMO])) break; if (_sp > XB_SPIN_CAP) { atomicAdd(&(bar)[XB_TMO], 1u); break; } } } } while (0)

struct XcdBarrier {
    unsigned* bar; unsigned x;
    volatile LAS unsigned* st;
};

__device__ __forceinline__ XcdBarrier xcd_barrier_post(unsigned* bar, volatile LAS unsigned* st) {
    XcdBarrier b; b.bar = bar; b.x = xb_xcc_id(); b.st = st;
    if (threadIdx.x == 0) (void)xb_add(&bar[XB_XCNT(b.x)], 1u);
    return b;
}
__device__ __forceinline__ void xcd_barrier_complete(unsigned* bar, unsigned x, unsigned& nloc, unsigned& nx) {
    const unsigned G = gridDim.x * gridDim.y * gridDim.z;
    unsigned sum, cnt, mine, sp = 0u;
    for (;;) {
        sum = 0u; cnt = 0u; mine = 0u;
#pragma unroll
        for (unsigned j = 0; j < 16; ++j) { const unsigned c = xb_ld(&bar[XB_XCNT(j)]); sum += c; cnt += (c > 0u) ? 1u : 0u; mine = (j == x) ? c : mine; }
        if (sum == G) break;
        __builtin_amdgcn_s_sleep(1);
        if ((++sp & 255u) == 0u) { if (xb_ld(&bar[XB_TMO])) break; if (sp > XB_SPIN_CAP) { atomicAdd(&bar[XB_TMO], 1u); break; } }
    }
    nloc = mine > 0u ? mine : 1u; nx = cnt > 0u ? cnt : 1u;
}

__device__ __forceinline__ void xcd_barrier(const XcdBarrier& b) {
    asm volatile("s_waitcnt vmcnt(0)" ::: "memory");
    __syncthreads();
    if (threadIdx.x == 0) {
        unsigned* bar = b.bar;
        __builtin_amdgcn_s_waitcnt(0);
        unsigned nloc = b.st[0], nx = b.st[1];
        if (nloc == 0u) { xcd_barrier_complete(bar, b.x, nloc, nx); b.st[0] = nloc; b.st[1] = nx; }
        const unsigned old = xb_add(&bar[XB_XSUB(b.x)], 1u);
        const unsigned gen = old / nloc;
        if (old + 1u == (gen + 1u) * nloc) {
            __builtin_amdgcn_fence(__ATOMIC_RELEASE, "agent");
            asm volatile("s_waitcnt vmcnt(0)" ::: "memory");
            const unsigned og = xb_add(&bar[XB_TOP], 1u);
            const unsigned tg = og / nx;
            if (og + 1u == (tg + 1u) * nx) xb_add(&bar[XB_TOPGEN], 1u);
            else XB_SPIN(xb_ld(&bar[XB_TOPGEN]) == tg, bar);
            __builtin_amdgcn_fence(__ATOMIC_ACQUIRE, "agent");
            xb_add(&bar[XB_XGEN(b.x)], 1u);
            asm volatile("s_waitcnt vmcnt(0)" ::: "memory");
        } else {
            XB_SPIN(xb_ld(&bar[XB_XGEN(b.x)]) == gen, bar);
            __builtin_amdgcn_fence(__ATOMIC_ACQUIRE, "agent");
            asm volatile("s_waitcnt vmcnt(0)" ::: "memory");
        }
    }
    __syncthreads();
}

struct Args { const float* in[15]; float* out; unsigned char* ws; };

__device__ __forceinline__ void convert_layer(const Args& a, int l, int par, LAS unsigned char* lds, int gw, int NGW, int wave, int lane) {
    lane = opaque_i(lane);
    LAS float* scr = (LAS float*)(lds + wave * 16384);
    unsigned char* wb = a.ws + WS_W + (size_t)par * W_PAR;
    bf16* WIN = (bf16*)(wb + W_WIN); bf16* WM = (bf16*)(wb + W_WM); bf16* WO = (bf16*)(wb + W_WO); bf16* WFI = (bf16*)(wb + W_WFI); bf16* WFO = (bf16*)(wb + W_WFO);
    bf16* WFB = (bf16*)(a.ws + WS_WF) + (size_t)par * 16384;
    const float* g_mix = a.in[1] + (size_t)l * 1024; const float* w_in = a.in[2] + (size_t)l * 1024 * DIN_SRC;
    const float* w_ao = a.in[6] + (size_t)l * 512 * 1024; const float* w_co = a.in[8] + (size_t)l * 256 * 1024;
    const float* pool_w = a.in[9] + (size_t)l * 4 * 64 * 256; const float* pool_s = a.in[10] + (size_t)l * 1024;
    const float* w_o = a.in[11] + (size_t)l * 1024 * 1024; const float* g_ffn = a.in[12] + (size_t)l * 1024;
    const float* w_fi = a.in[13] + (size_t)l * 1024 * 5632; const float* w_fo = a.in[14] + (size_t)l * 2816 * 1024;
    constexpr int I_WIN = 16 * 176, I_WFI = 16 * 176, I_WO = 16 * 32, I_WFO = 44 * 32, I_WA = 8 * 32, I_WC = 4 * 32, I_WP = 1024, I_WF = 8;
    constexpr int NITEMS = I_WIN + I_WFI + I_WO + I_WFO + I_WA + I_WC + I_WP + I_WF;
    for (int it = gw; it < NITEMS; it += NGW) {
        int r = it;
        if (r < I_WIN) { const int kb = r / 176, nb = r % 176, pn = nb >> 3, rem = nb & 7, bj = rem >> 2, w = rem & 3; const int nl = 256 * pn + 64 * w + 32 * bj; const int src = nl < 1536 ? nl : nl + 8;
            tr_item(w_in, DIN_SRC, src, 64 * kb, g_mix, WIN, 1024, 32 * nb, 0, scr, lane); continue; } r -= I_WIN;
        if (r < I_WFI) { const int kb = r / 176, nb = r % 176, pn = nb >> 3, rem = nb & 7, bj = rem >> 2, w = rem & 3; const int src = bj * DFF + 128 * pn + 32 * w;
            tr_item(w_fi, 5632, src, 64 * kb, g_ffn, WFI, 1024, 32 * nb, 0, scr, lane); continue; } r -= I_WFI;
        if (r < I_WO) { const int kb = r >> 5, nb = r & 31; tr_item(w_o, 1024, 32 * nb, 64 * kb, nullptr, WO, 1024, 32 * nb, 0, scr, lane); continue; } r -= I_WO;
        if (r < I_WFO) { const int kb = r >> 5, nb = r & 31; tr_item(w_fo, 1024, 32 * nb, 64 * kb, nullptr, WFO, DFF, 32 * nb, 0, scr, lane); continue; } r -= I_WFO;
        if (r < I_WA) { const int kb = r >> 5, nb = r & 31; tr_item(w_ao, 1024, 32 * nb, 64 * kb, nullptr, WM, 896, 32 * nb, 0, scr, lane); continue; } r -= I_WA;
        if (r < I_WC) { const int kb = r >> 5, nb = r & 31; tr_item(w_co, 1024, 32 * nb, 64 * kb, nullptr, WM, 896, 32 * nb, 512, scr, lane); continue; } r -= I_WC;
        if (r < I_WP) { const int n = r, g = n >> 8, d = n & 255; const float w = pool_w[((size_t)g * 64 + lane) * 256 + d] * pool_s[n]; const bf16 wv = (bf16)f2bf(w);
            WM[(size_t)n * 896 + 768 + lane] = (g & 1) ? (bf16)0 : wv; WM[(size_t)n * 896 + 768 + 64 + lane] = (g & 1) ? wv : (bf16)0; continue; } r -= I_WP;
        { const int h = r;
#pragma unroll 4
            for (int i = 0; i < 16; ++i) { const int k = lane + 64 * i; const float w = w_in[(size_t)k * DIN_SRC + 1536 + h] * g_mix[k]; const unsigned hi = f2bf(w);
                WFB[h * 1024 + k] = (bf16)hi; WFB[(8 + h) * 1024 + k] = (bf16)f2bf(w - __uint_as_float(hi << 16)); } }
    }
}

__global__ void __launch_bounds__(NWAVES * 64, 2) fwd_kernel(Args args) {
    extern __shared__ __attribute__((aligned(16))) unsigned char lds[];
    cg::grid_group grid = cg::this_grid();
#define GSYNC0() do { asm volatile("s_waitcnt vmcnt(0)" ::: "memory"); grid.sync(); __builtin_amdgcn_fence(__ATOMIC_ACQUIRE, "agent"); asm volatile("s_waitcnt vmcnt(0)" ::: "memory"); } while (0)
    LAS unsigned char* ldsl = (LAS unsigned char*)lds;
    const int tid = threadIdx.x, lane = tid & 63, wave = __builtin_amdgcn_readfirstlane(tid >> 6);
    const int G = gridDim.x; const int bx = blockIdx.x; const int vcu = (G % 8 == 0) ? (bx % 8) * (G / 8) + bx / 8 : bx;
    const int gw = vcu * NWAVES + wave, NGW = G * NWAVES;
#ifdef PROBE
    LAS unsigned long long* TACC = (LAS unsigned long long*)(ldsl + LDS_BYTES - 128);
    if (bx == 0 && tid == 0) { for (int i = 0; i < 14; ++i) TACC[i] = 0ull; TACC[13] = 1ull; TACC[12] = __builtin_amdgcn_s_memrealtime(); }
#define TSTAMP(k) do { if (bx == 0 && tid == 0) { const unsigned long long t_ = __builtin_amdgcn_s_memrealtime(); if (TACC[13]) TACC[k] += t_ - TACC[12]; TACC[12] = t_; } } while (0)
#else
#define TSTAMP(k) do {} while (0)
#endif
    unsigned char* ws = args.ws;
    float* SSQ_MIX = (float*)(ws + WS_SSQ_MIX); float* SSQ_FFN = (float*)(ws + WS_SSQ_FFN); float* LOGF = (float*)(ws + WS_LOGF);
    bf16* XB = (bf16*)(ws + WS_XB); bf16* CZ = (bf16*)args.out;     bf16* QO = (bf16*)(ws + WS_Q); bf16* KB = (bf16*)(ws + WS_K); bf16* VB = (bf16*)(ws + WS_V); bf16* MG = KB;
    bf16* CP = (bf16*)(ws + WS_CP); bf16* GT = (bf16*)(ws + WS_G); bf16* ACT = GT;
    const float* x_in = args.in[0]; float* out = args.out;

    unsigned* barw = (unsigned*)(ws + WS_BAR);
    volatile LAS unsigned* bst = (volatile LAS unsigned*)(ldsl + LDS_BYTES - 256);
    if (tid < 2) bst[tid] = 0u;
    __syncthreads();
    XcdBarrier xbar = xcd_barrier_post(barw, bst);
#define GSYNC() xcd_barrier(xbar)
    if (args.ws == nullptr) GSYNC0();
    convert_layer(args, 0, 0, ldsl, gw, NGW, wave, lane);
    for (int m = gw; m < MTOK; m += 4 * NGW) {
        const int lane = opaque_i(tid) & 63;
        f32x4 v[4][4];
#pragma unroll
        for (int r = 0; r < 4; ++r) { const f32x4* xr = (const f32x4*)(x_in + (size_t)(m + r * NGW) * 1024) + lane;
#pragma unroll
            for (int j = 0; j < 4; ++j) v[r][j] = xr[64 * j]; }
#pragma unroll
        for (int r = 0; r < 4; ++r) { const int mr = m + r * NGW; float s = 0.f;
#pragma unroll
            for (int j = 0; j < 4; ++j) s += (v[r][j].x * v[r][j].x + v[r][j].y * v[r][j].y) + (v[r][j].z * v[r][j].z + v[r][j].w * v[r][j].w);
            s = wave_sum(s);
            unsigned long long* o8 = (unsigned long long*)(XB + (size_t)mr * 1024) + lane;
#pragma unroll
            for (int j = 0; j < 4; ++j) o8[64 * j] = (unsigned long long)pk2(v[r][j].x, v[r][j].y) | ((unsigned long long)pk2(v[r][j].z, v[r][j].w) << 32);
            if (lane < 16) SSQ_MIX[(size_t)mr * 16 + lane] = lane == 0 ? s : 0.f; }
    }
    GSYNC();
    TSTAMP(0);

    for (int l = 0; l < NLAYER; ++l) {
#ifdef PROBE
        if (bx == 0 && tid == 0) TACC[13] = 1ull;
#endif
        const int par = l & 1;
        unsigned char* wb = ws + WS_W + (size_t)par * W_PAR;
        const float* ssq_mix = SSQ_MIX; float* ssq_ffn = SSQ_FFN;
        float* ssq_nextmix = (l + 1 < NLAYER) ? SSQ_MIX : nullptr;

#if (PHM >> 1) & 1
        {
            const bf16* WFB = (const bf16*)(ws + WS_WF) + (size_t)par * 16384; const float* fb = args.in[3] + l * 8;
            for (int ch = gw; ch < MTOK / 16; ch += NGW) {
                const int lane = opaque_i(tid) & 63, fr = lane & 15, fq = lane >> 4, m0 = ch * 16;
                const bf16* xa = XB + (size_t)(m0 + fr) * 1024 + 8 * fq; const bf16* wbp = WFB + (size_t)fr * 1024 + 8 * fq;
                f32x4 acc = {0.f, 0.f, 0.f, 0.f};
#pragma unroll 16
                for (int kk = 0; kk < 32; ++kk) { const pg8::bf16x8 av = *(const pg8::bf16x8*)(xa + 32 * kk), bv = *(const pg8::bf16x8*)(wbp + 32 * kk);
                    acc = __builtin_amdgcn_mfma_f32_16x16x32_bf16(av, bv, acc, 0, 0, 0); }
                f32x4 tot; tot.x = acc.x + __shfl_xor(acc.x, 8); tot.y = acc.y + __shfl_xor(acc.y, 8); tot.z = acc.z + __shfl_xor(acc.z, 8); tot.w = acc.w + __shfl_xor(acc.w, 8);
                if (fr < 8) { const float fbh = fb[fr]; f32x4 lf;
#pragma unroll
                    for (int r = 0; r < 4; ++r) { const int row = m0 + 4 * fq + r; const float rr = rsqrtf(pg8::row_ssq(ssq_mix, row) * (1.0f / 1024.0f) + EPSN); const float f = tot[r] * rr + fbh;
                        lf[r] = fminf(f, 0.f) - log1pf(expf(-fabsf(f))); }
                    *(f32x4*)(LOGF + ((size_t)(m0 >> 12) * 8 + fr) * SEQ_ + (m0 & (SEQ_ - 1)) + 4 * fq) = lf; }
            }
            TSTAMP(1);
            pg8::ProbSimple P{(const char*)XB, (const char*)(wb + W_WIN), 1024, 1024, 16}; pg8::StaticOrder<1> S; S.init(MTOK, NIN, G, bx);
            pg8::EpiInProj E{ssq_mix, args.in[4] + l * 64, args.in[5] + l * 64, QO, KB, VB, CP, GT};
            pg8::gemm_phase<pg8::ProbSimple, pg8::EpiInProj, pg8::StaticOrder<1>, true, true>(ldsl, P, S, E);
        }
#endif
        GSYNC();
        TSTAMP(2);
#ifdef PROBE
        GSYNC(); TSTAMP(11);
#endif

#if (PHM >> 2) & 1
        {
            if (l + 1 < NLAYER) convert_layer(args, l + 1, (l + 1) & 1, ldsl, gw, NGW, wave, lane);
            TSTAMP(3);
            {
                const float* cw = args.in[7] + (size_t)l * 3 * 256;
                const int lane = opaque_i(tid) & 63; const bool isconv = lane < 32; const int c0 = 8 * (lane & 31), g = (lane & 31) >> 3, wwin = 2 << g;
                const int R0 = vcu * 128 + wave * 16, tl0 = R0 & (SEQ_ - 1); const bool halo = tl0 != 0;
                const int colA = isconv ? c0 : 768 + c0, colB = isconv ? 512 + c0 : 768 + c0, colC = isconv ? 256 + c0 : 768 + c0;
                const f32x4 w0a = *(const f32x4*)(cw + c0), w0b = *(const f32x4*)(cw + c0 + 4), w1a = *(const f32x4*)(cw + 256 + c0), w1b = *(const f32x4*)(cw + 256 + c0 + 4), w2a = *(const f32x4*)(cw + 512 + c0), w2b = *(const f32x4*)(cw + 512 + c0 + 4);
                const v4u zero4 = {0u, 0u, 0u, 0u}; const f32x4 zf = {0.f, 0.f, 0.f, 0.f};
                v4u ring[16];
#pragma unroll
                for (int i = 0; i < 16; ++i) ring[i] = zero4;
                f32x4 S0 = zf, S1 = zf, z1a = zf, z1b = zf, z2a = zf, z2b = zf;
#pragma unroll
                for (int i = -15; i < 16; ++i) {
                    const bool valid = (i >= 0) || halo;
                    const bf16* rp = CP + (size_t)(R0 + i) * 1024;
                    v4u av = zero4; if (valid) av = *(const v4u*)(rp + colA);
                    const f32x4 u0 = pg8::bf_lo4(av.x, av.y), u1 = pg8::bf_lo4(av.z, av.w);
                    S0 += u0; S1 += u1;
                    { const v4u o2 = (i - 2 >= -15) ? ring[(i - 2 + 16) & 15] : zero4, o4 = (i - 4 >= -15) ? ring[(i - 4 + 16) & 15] : zero4, o8 = (i - 8 >= -15) ? ring[(i - 8 + 16) & 15] : zero4, o16 = (i - 16 >= -15) ? ring[(i - 16 + 16) & 15] : zero4;
                      const v4u o = g == 0 ? o2 : g == 1 ? o4 : g == 2 ? o8 : o16;
                      S0 -= pg8::bf_lo4(o.x, o.y); S1 -= pg8::bf_lo4(o.z, o.w); }
                    ring[(i + 16) & 15] = av;
                    f32x4 za = zf, zb = zf;
                    if (i >= -2) { v4u bv = zero4; if (valid) bv = *(const v4u*)(rp + colB); za = u0 * pg8::bf_lo4(bv.x, bv.y); zb = u1 * pg8::bf_lo4(bv.z, bv.w); }
                    if (i >= 0) {
                        const v4u cv = *(const v4u*)(rp + colC);
                        const f32x4 oc0 = pg8::bf_lo4(cv.x, cv.y) * (w0a * z2a + w1a * z1a + w2a * za), oc1 = pg8::bf_lo4(cv.z, cv.w) * (w0b * z2b + w1b * z1b + w2b * zb);
                        const int tl = tl0 + i, n = (tl + 1) < wwin ? (tl + 1) : wwin; const float inv = 1.0f / (float)n;
                        const f32x4 op0 = S0 * inv - u0, op1 = S1 * inv - u1;
                        *(v4u*)(CZ + (size_t)(R0 + i) * 512 + (isconv ? c0 : 256 + c0)) = pg8::pack8(isconv ? oc0 : op0, isconv ? oc1 : op1);
                    }
                    if (i >= -2) { z2a = z1a; z2b = z1b; z1a = za; z1b = zb; }
                }
            }
            TSTAMP(4);
            {
                __syncthreads();
                const int tid = opaque_i(threadIdx.x), lane = tid & 63;
                float dthr2, mref2;
                { float mq = fabsf((args.in[4] + l * 64)[lane]), mk = fabsf((args.in[5] + l * 64)[lane]);
#pragma unroll
                  for (int o = 1; o < 64; o <<= 1) { mq = fmaxf(mq, __shfl_xor(mq, o)); mk = fmaxf(mk, __shfl_xor(mk, o)); }
                  mref2 = 8.0f * 1.02f * mq * mk * LOG2E; dthr2 = 2.0f * mref2 + 26.0f * LOG2E; }
                LAS float* c2 = (LAS float*)(ldsl + attn_body::LDS_C2); LAS float* wsum = (LAS float*)(ldsl + attn_body::LDS_WSUM); volatile LAS unsigned* uq = (volatile LAS unsigned*)(ldsl + attn_body::LDS_WSUM + 32);
                unsigned* qctr = barw + 4096 + 64 * l;
                for (;;) {
                    if (tid == 0) *uq = __hip_atomic_fetch_add(qctr, 1u, __ATOMIC_RELAXED, __HIP_MEMORY_SCOPE_AGENT);
                    __syncthreads();
                    const unsigned u = *uq;
                    if (u >= (unsigned)(NB * NHEADS * (SEQ_ / 256))) break;
                    const int qb = (SEQ_ / 256 - 1) - (int)(u >> 6), bh = (int)(u & 63);
                    const f32x4* p = (const f32x4*)(LOGF + (size_t)bh * SEQ_ + tid * 8); const f32x4 a = p[0], b = p[1];
                    float v0 = a.x, v1 = v0 + a.y, v2 = v1 + a.z, v3 = v2 + a.w, v4 = v3 + b.x, v5 = v4 + b.y, v6 = v5 + b.z, v7 = v6 + b.w;
                    float sc = v7;
#pragma unroll
                    for (int o = 1; o < 64; o <<= 1) { const float y = __shfl_up(sc, o); if (lane >= o) sc += y; }
                    if (lane == 63) wsum[wave] = sc;
                    __syncthreads();
                    float off = 0.f;
#pragma unroll
                    for (int w = 0; w < 8; ++w) { const float t = wsum[w]; if (w < wave) off += t; }
                    const float e = off + sc - v7;
                    f32x4 r0 = {-(e + v0) * LOG2E, -(e + v1) * LOG2E, -(e + v2) * LOG2E, -(e + v3) * LOG2E}, r1 = {-(e + v4) * LOG2E, -(e + v5) * LOG2E, -(e + v6) * LOG2E, -(e + v7) * LOG2E};
                    *(LAS f32x4*)(c2 + tid * 8) = r0; *(LAS f32x4*)(c2 + tid * 8 + 4) = r1;
                    { LAS unsigned long long* kx = (LAS unsigned long long*)(ldsl + attn_body::LDS_KX) + tid * 8;
#pragma unroll
                      for (int j = 0; j < 8; ++j) { const float cv = j < 4 ? r0[j & 3] : r1[j & 3]; const unsigned hh = f2bf(cv); const float q1 = cv - __uint_as_float(hh << 16);
                          const unsigned mm = f2bf(q1); const float q2 = q1 - __uint_as_float(mm << 16); const unsigned ll = f2bf(q2);
                          kx[j] = (unsigned long long)(hh | (mm << 16)) | ((unsigned long long)(ll | (0x3F80u << 16)) << 32); } }
                    __syncthreads();
                    attn_body::attn_unit<8>(bh >> 3, bh & 7, qb, (const attn_body::bf16*)QO, (const attn_body::bf16*)KB, (const attn_body::bf16*)VB, (attn_body::bf16*)QO, (char*)lds, dthr2, mref2);
                }
            }
            TSTAMP(5);
        }
#endif
        GSYNC();
        TSTAMP(6);

#if (PHM >> 3) & 1
        {
            pg8::ProbMerge P{(const char*)QO, (const char*)CZ, (const char*)(wb + W_WM), 512, 896}; pg8::StaticOrder<3> S; S.init(MTOK, 1024, G, bx);
            pg8::EpiMerge E{GT, MG};
            pg8::gemm_phase<pg8::ProbMerge, pg8::EpiMerge, pg8::StaticOrder<3>, true, true>(ldsl, P, S, E);
        }
#endif
        GSYNC();
        TSTAMP(7);

#if (PHM >> 4) & 1
        {
            pg8::ProbSimple P{(const char*)MG, (const char*)(wb + W_WO), 1024, 1024, 16}; pg8::StaticOrder<1> S; S.init(MTOK, 1024, G, bx);
            pg8::EpiResid E{nullptr, XB, ssq_ffn};
            pg8::gemm_phase<pg8::ProbSimple, pg8::EpiResid, pg8::StaticOrder<1>, true, true>(ldsl, P, S, E);
        }
#endif
        GSYNC();
        TSTAMP(8);

#if (PHM >> 5) & 1
        {
            pg8::ProbSimple P{(const char*)XB, (const char*)(wb + W_WFI), 1024, 1024, 16}; pg8::StaticOrder<1> S; S.init(MTOK, 2 * DFF, G, bx);
            pg8::EpiSwiGLU E{ssq_ffn, ACT};
            pg8::gemm_phase<pg8::ProbSimple, pg8::EpiSwiGLU, pg8::StaticOrder<1>, true, true>(ldsl, P, S, E);
        }
#endif
        GSYNC();
        TSTAMP(9);

#if (PHM >> 6) & 1
        {
            pg8::ProbSimple P{(const char*)ACT, (const char*)(wb + W_WFO), DFF, DFF, DFF / 64}; pg8::StaticOrder<1> S; S.init(MTOK, 1024, G, bx);
            pg8::EpiResid E{(l + 1 < NLAYER) ? nullptr : out, XB, ssq_nextmix};
            pg8::gemm_phase<pg8::ProbSimple, pg8::EpiResid, pg8::StaticOrder<1>, true, true>(ldsl, P, S, E);
        }
#endif
        if (l + 1 < NLAYER) GSYNC();
        TSTAMP(10);
    }
#ifdef PROBE
    GSYNC();
    if (bx == 0 && tid == 0) out[0] += (float)TACC[PROBE] * 0.0005f;
#endif
}

extern "C" void kernel_launch(void* const* d_in, const int* in_sizes, int n_in, void* d_out, int out_size, void* d_ws, size_t ws_size, hipStream_t stream) {
    static int grid = 0;
    if (grid == 0) {
        if (n_in != 15 || out_size != MTOK * DMODEL || ws_size < WS_END) { fprintf(stderr, "kernel_launch: unexpected shapes (n_in %d out %d ws %zu)\n", n_in, out_size, ws_size); grid = -1; return; }
        int dev = 0, cus = 0, per_cu = 0;
        hipGetDevice(&dev); hipDeviceGetAttribute(&cus, hipDeviceAttributeMultiprocessorCount, dev);
        if (hipFuncSetAttribute((const void*)fwd_kernel, hipFuncAttributeMaxDynamicSharedMemorySize, LDS_BYTES) != hipSuccess) { fprintf(stderr, "kernel_launch: hipFuncSetAttribute failed\n"); grid = -1; return; }
        if (hipOccupancyMaxActiveBlocksPerMultiprocessor(&per_cu, (const void*)fwd_kernel, NWAVES * 64, LDS_BYTES) != hipSuccess || per_cu < 1) { fprintf(stderr, "kernel_launch: occupancy query says %d\n", per_cu); per_cu = 1; }
        (void)hipGetLastError();
        grid = cus;
        if (grid != 256) fprintf(stderr, "kernel_launch: %d CUs (built for 256)\n", grid);
    }
    if (grid < 0) return;
    (void)hipMemsetAsync((char*)d_ws + WS_BAR, 0, (4096 + 4 * 64) * 4, stream);
    Args a{};
    for (int i = 0; i < 15; ++i) a.in[i] = (const float*)d_in[i];
    a.out = (float*)d_out; a.ws = (unsigned char*)d_ws;
    void* kargs[] = {&a};
    hipError_t e = hipLaunchCooperativeKernel((const void*)fwd_kernel, dim3(grid), dim3(NWAVES * 64), kargs, LDS_BYTES, stream);
    if (e != hipSuccess) fprintf(stderr, "cooperative launch failed: %s (grid %d)\n", hipGetErrorString(e), grid);
}
```

```cpp
#include <hip/hip_runtime.h>
#include <hip/hip_cooperative_groups.h>
#include <hip/hip_bf16.h>
#include <cstdio>
#include <cstdint>
#include <cmath>
namespace cg = cooperative_groups;

#ifndef PHM
#define PHM 0xff
#endif
constexpr int NB = 8, SEQ_ = 4096, DMODEL = 1024, NLAYER = 4;
constexpr int MTOK = NB * SEQ_;
constexpr int DATT = 512, NHEADS = 8, DCONV = 256, DPOOL = 256, DFF = 2816;
constexpr int DIN_SRC = 5640;
constexpr int NIN = 5632;
constexpr float EPSN = 1e-6f;
constexpr float LOG2E = 1.4426950408889634f;
constexpr float QSCALE = 0.125f * LOG2E;

__device__ __forceinline__ int opaque_i(int v) { asm volatile("" : "+v"(v)); return v; }
namespace pg8 {
#define PG8_LAS __attribute__((address_space(3)))
typedef unsigned short bf16_t;
typedef short bf16x8 __attribute__((ext_vector_type(8)));
typedef float f32x4 __attribute__((ext_vector_type(4)));
typedef unsigned u32x4 __attribute__((ext_vector_type(4)));
constexpr int BM = 256, BK = 64, HALF = 128, HTB = HALF * BK * 2, STAGE_BYTES = 8 * HTB, NXCD = 8, WGM = 8;

__host__ __device__ __forceinline__ int lds_byte(int r, int c) { const int st = (r >> 4) * 2 + (c >> 5), rr = r & 15, cc = c & 31, ob = rr * 64 + cc * 2; return st * 1024 + (ob ^ (((ob >> 9) & 1) << 5)); }
__host__ __device__ __forceinline__ void stage_rc(int b, int& R, int& C) { const int st = b / 1024, sb = b % 1024, swz = sb ^ (((sb >> 9) & 1) << 5); R = (st >> 1) * 16 + swz / 64; C = (st & 1) * 32 + (swz % 64) / 2; }
__host__ __device__ __forceinline__ int perm32(int rho) { const int n = rho >> 4, i = rho & 15; return 8 * (i >> 2) + 4 * n + (i & 3); }

struct Unit { int pm, pn, sub, idx; };
struct UMem { const char* A; const char* B; int nt; };

template <int NSUB> struct StaticOrder {
    int nM, nN, nwg, G, c;
    __device__ void init(int M, int N, int G_, int c_) { nM = M / BM; nN = N / BM; nwg = nM * nN; G = G_; c = c_; }
    __device__ bool next(int i, Unit& u) const {
        const int it = i / NSUB; u.sub = i - it * NSUB; u.idx = it;
        const long L = (long)it * G + c; if (L >= nwg) return false;
        int wgid = (int)L; { const int q = nwg / NXCD, r = nwg % NXCD, xcd = wgid % NXCD, off = wgid / NXCD; wgid = (xcd < r ? xcd * (q + 1) : r * (q + 1) + (xcd - r) * q) + off; }
        const int nig = WGM * nN, gid = wgid / nig, fm = gid * WGM, gsz = (nM - fm) < WGM ? (nM - fm) : WGM;
        u.pm = fm + ((wgid % nig) % gsz); u.pn = (wgid % nig) / gsz; return true;
    }
};

__device__ __forceinline__ unsigned cvt_pk_bf16(float lo, float hi) { unsigned r; asm volatile("v_cvt_pk_bf16_f32 %0, %1, %2" : "=v"(r) : "v"(lo), "v"(hi)); return r; }
__device__ __forceinline__ f32x4 bf_lo4(unsigned a, unsigned b) { return (f32x4){__uint_as_float(a << 16), __uint_as_float(a & 0xffff0000u), __uint_as_float(b << 16), __uint_as_float(b & 0xffff0000u)}; }
__device__ __forceinline__ u32x4 pack8(f32x4 v0, f32x4 v1) { u32x4 w; w.x = cvt_pk_bf16(v0[0], v0[1]); w.y = cvt_pk_bf16(v0[2], v0[3]); w.z = cvt_pk_bf16(v1[0], v1[1]); w.w = cvt_pk_bf16(v1[2], v1[3]); return w; }
__device__ __forceinline__ float row_ssq(const float* p, int row) { const f32x4* q = (const f32x4*)(p + (size_t)row * 16); const f32x4 s = (q[0] + q[1]) + (q[2] + q[3]); return (s[0] + s[1]) + (s[2] + s[3]); }
__device__ __forceinline__ float row_ssq_q(const float* p, int row, int fq) { const f32x4 v = *(const f32x4*)(p + (size_t)row * 16 + 4 * fq); float s = (v[0] + v[1]) + (v[2] + v[3]); s += __shfl_xor(s, 16); s += __shfl_xor(s, 32); return s; }
__device__ __forceinline__ float fast_sigmoid(float v) { return __builtin_amdgcn_rcpf(1.0f + __expf(-v)); }


struct EpiInProj {
    const PG8_LAS float* RS; const float* qg; const float* kg; bf16_t* Q; bf16_t* Kb; bf16_t* V; bf16_t* CP; bf16_t* G;
    __device__ __forceinline__ bool keep(const Unit&) const { return false; }
    __device__ __forceinline__ void operator()(f32x4 (&acc)[2][2][4][2], const Unit& u, int wr, int wc, int fr, int fq) const {
        const int pn = u.pn; bf16_t* base; int ld, colt, mode; float post = 1.f; const float* gain = qg;
        if (pn < 2) { base = Q; ld = 512; colt = pn * 256; mode = 1; post = QSCALE; gain = qg; }
        else if (pn < 4) { base = Kb; ld = 512; colt = (pn - 2) * 256; mode = 1; gain = kg; }
        else if (pn < 6) { base = V; ld = 512; colt = (pn - 4) * 256; mode = 0; }
        else if (pn < 10) { base = CP; ld = 1024; colt = (pn - 6) * 256; mode = 0; }
        else { base = G; ld = 3072; colt = (pn - 10) * 256; mode = 2; }
        const int row0 = u.pm * BM + wr * 64 + fr, colw = colt + 64 * wc + 8 * fq;
        f32x4 gv[2][2];
#pragma unroll
        for (int bj = 0; bj < 2; ++bj)
#pragma unroll
            for (int n = 0; n < 2; ++n) gv[bj][n] = *(const f32x4*)(gain + 32 * bj + 8 * fq + 4 * n) * post;
        const PG8_LAS float* rsp = RS + u.idx * BM + wr * 64 + fr;
#pragma unroll
        for (int ai = 0; ai < 2; ++ai) {
#pragma unroll
            for (int m = 0; m < 4; ++m) {
                const int row = row0 + ai * HALF + m * 16;
                const float r = rsp[ai * HALF + m * 16];
                f32x4 v[2][2];
#pragma unroll
                for (int bj = 0; bj < 2; ++bj)
#pragma unroll
                    for (int n = 0; n < 2; ++n) v[bj][n] = acc[ai][bj][m][n] * r;
                if (mode == 1) {
                    float s = 0.f;
#pragma unroll
                    for (int bj = 0; bj < 2; ++bj)
#pragma unroll
                        for (int n = 0; n < 2; ++n) { const f32x4 x = v[bj][n]; s += (x[0] * x[0] + x[1] * x[1]) + (x[2] * x[2] + x[3] * x[3]); }
                    s += __shfl_xor(s, 16); s += __shfl_xor(s, 32);
                    const float rn = rsqrtf(s * (1.0f / 64.0f) + EPSN);
#pragma unroll
                    for (int bj = 0; bj < 2; ++bj)
#pragma unroll
                        for (int n = 0; n < 2; ++n) v[bj][n] = v[bj][n] * rn * gv[bj][n];
                } else if (mode == 2) {
#pragma unroll
                    for (int bj = 0; bj < 2; ++bj)
#pragma unroll
                        for (int n = 0; n < 2; ++n) { f32x4 x = v[bj][n];
                            x[0] = fminf(__expf(-x[0]), 1e30f); x[1] = fminf(__expf(-x[1]), 1e30f); x[2] = fminf(__expf(-x[2]), 1e30f); x[3] = fminf(__expf(-x[3]), 1e30f); v[bj][n] = x; }
                }
                bf16_t* rowp = base + (size_t)row * ld + colw;
#pragma unroll
                for (int bj = 0; bj < 2; ++bj) *(u32x4*)(rowp + 32 * bj) = pack8(v[bj][0], v[bj][1]);
            }
        }
    }
};

struct EpiMerge {
    const bf16_t* G; bf16_t* Mg;
    __device__ __forceinline__ bool keep(const Unit& u) const { return u.sub < 2; }
    __device__ __forceinline__ void operator()(f32x4 (&acc)[2][2][4][2], const Unit& u, int wr, int wc, int fr, int fq) const {
        const int row0 = u.pm * BM + wr * 64 + fr, col0 = u.pn * BM + wc * 32 + 8 * fq, sub = u.sub;
        const bf16_t* gbase = G + (size_t)row0 * 3072 + col0 + (sub == 0 ? 0 : sub == 1 ? 1024 : 2048);
#pragma unroll
        for (int aih = 0; aih < 4; ++aih) { const int ai = aih >> 1, mlo = (aih & 1) * 2;
            u32x4 ga[4][2], gb[4][2];
#pragma unroll
            for (int m = mlo; m < mlo + 2; ++m)
#pragma unroll
                for (int bj = 0; bj < 2; ++bj) { const bf16_t* gp = gbase + (size_t)(ai * HALF + m * 16) * 3072 + bj * HALF;
                    ga[m][bj] = *(const u32x4*)gp; gb[m][bj] = ga[m][bj]; if (sub < 2) gb[m][bj] = *(const u32x4*)(gp + 1024); }
#pragma unroll
            for (int m = mlo; m < mlo + 2; ++m) {
                const int row = row0 + ai * HALF + m * 16;
#pragma unroll
                for (int bj = 0; bj < 2; ++bj) {
                    f32x4 f0 = bf_lo4(ga[m][bj].x, ga[m][bj].y) + 1.0f, f1 = bf_lo4(ga[m][bj].z, ga[m][bj].w) + 1.0f;
#pragma unroll
                    for (int j = 0; j < 4; ++j) { f0[j] = __builtin_amdgcn_rcpf(f0[j]); f1[j] = __builtin_amdgcn_rcpf(f1[j]); }
                    if (sub < 2) {
                        const f32x4 d0 = bf_lo4(gb[m][bj].x, gb[m][bj].y) + 1.0f, d1 = bf_lo4(gb[m][bj].z, gb[m][bj].w) + 1.0f;
                        acc[ai][bj][m][0] *= f0 * d0; acc[ai][bj][m][1] *= f1 * d1;
                    } else {
                        *(u32x4*)(Mg + (size_t)row * 1024 + col0 + bj * HALF) = pack8(acc[ai][bj][m][0] * f0, acc[ai][bj][m][1] * f1);
                    }
                }
            }
        }
    }
};

struct EpiResid {
    float* out; bf16_t* XB; float* ssq_next;
    __device__ __forceinline__ bool keep(const Unit&) const { return false; }
    __device__ __forceinline__ void operator()(f32x4 (&acc)[2][2][4][2], const Unit& u, int wr, int wc, int fr, int fq) const {
        const int row0 = u.pm * BM + wr * 64 + fr, col0 = u.pn * BM + wc * 32 + 8 * fq;
#pragma unroll
        for (int ai = 0; ai < 2; ++ai) {
            u32x4 xo[2][4][2];
#pragma unroll
            for (int m = 0; m < 4; ++m)
#pragma unroll
                for (int bj = 0; bj < 2; ++bj) xo[ai][m][bj] = *(const u32x4*)(XB + (size_t)(row0 + ai * HALF + m * 16) * 1024 + col0 + bj * HALF);
#pragma unroll
            for (int m = 0; m < 4; ++m) {
                const int row = row0 + ai * HALF + m * 16; const size_t off = (size_t)row * 1024 + col0;
                float s = 0.f;
#pragma unroll
                for (int bj = 0; bj < 2; ++bj) {
                    const u32x4 xv = xo[ai][m][bj];
                    const f32x4 x0 = bf_lo4(xv.x, xv.y) + acc[ai][bj][m][0], x1 = bf_lo4(xv.z, xv.w) + acc[ai][bj][m][1];
                    if (out) { *(f32x4*)(out + off + bj * HALF) = x0; *(f32x4*)(out + off + bj * HALF + 4) = x1; }
                    else *(u32x4*)(XB + off + bj * HALF) = pack8(x0, x1);
                    s += (x0[0] * x0[0] + x0[1] * x0[1]) + (x0[2] * x0[2] + x0[3] * x0[3]) + (x1[0] * x1[0] + x1[1] * x1[1]) + (x1[2] * x1[2] + x1[3] * x1[3]);
                }
                if (ssq_next) { s += __shfl_xor(s, 16); s += __shfl_xor(s, 32); if (fq == 0) ssq_next[(size_t)row * 16 + u.pn * 4 + wc] = s; }
            }
        }
    }
};

struct EpiSwiGLU {
    const PG8_LAS float* RS; bf16_t* ACT;
    __device__ __forceinline__ bool keep(const Unit&) const { return false; }
    __device__ __forceinline__ void operator()(f32x4 (&acc)[2][2][4][2], const Unit& u, int wr, int wc, int fr, int fq) const {
        const int row0 = u.pm * BM + wr * 64 + fr, col0 = u.pn * HALF + wc * 32 + 8 * fq;
        const PG8_LAS float* rsp = RS + u.idx * BM + wr * 64 + fr;
#pragma unroll
        for (int ai = 0; ai < 2; ++ai)
#pragma unroll
            for (int m = 0; m < 4; ++m) {
                const int row = row0 + ai * HALF + m * 16;
                const float r = rsp[ai * HALF + m * 16];
                f32x4 o[2];
#pragma unroll
                for (int n = 0; n < 2; ++n) { const f32x4 g = acc[ai][0][m][n] * r, up = acc[ai][1][m][n] * r;
#pragma unroll
                    for (int j = 0; j < 4; ++j) o[n][j] = g[j] * fast_sigmoid(g[j]) * up[j]; }
                *(u32x4*)(ACT + (size_t)row * DFF + col0) = pack8(o[0], o[1]);
            }
    }
};

struct ProbSimple { const char* A; const char* B; int lda, ldb, nt;
    __device__ __forceinline__ UMem mem(const Unit& u) const { UMem m; m.A = A + (size_t)u.pm * BM * lda * 2; m.B = B + (size_t)u.pn * BM * ldb * 2; m.nt = nt; return m; } };
struct ProbMerge { const char* O; const char* CZ; const char* WM; int lda, ldb;
    __device__ __forceinline__ UMem mem(const Unit& u) const { UMem m; const size_t ar = (size_t)u.pm * BM * 512 * 2, br = (size_t)u.pn * BM * 896 * 2;
        if (u.sub == 0) { m.A = O + ar; m.B = WM + br; m.nt = 8; }
        else if (u.sub == 1) { m.A = CZ + ar; m.B = WM + br + 512 * 2; m.nt = 4; }
        else { m.A = CZ + ar + (256 + 128 * (u.pn >> 1)) * 2; m.B = WM + br + 768 * 2; m.nt = 2; }
        return m; } };

template <class Prob, class Epi, class Sched, bool ALIGN_EPI, bool SP2>
__device__ __forceinline__ void gemm_phase(PG8_LAS unsigned char* lds, const Prob& P, const Sched& S, const Epi& E) {
    const int tid = opaque_i(threadIdx.x), wid = __builtin_amdgcn_readfirstlane(tid >> 6), lane = tid & 63, wr = wid >> 2, wc = wid & 3, fr = lane & 15, fq = lane >> 4;
    unsigned voffA[2], voffB[2];
#pragma unroll
    for (int i = 0; i < 2; ++i) { int R, C; stage_rc(tid * 16 + i * 8192, R, C); const int Rb = (R & ~31) + perm32(R & 31);
        voffA[i] = (unsigned)(R * P.lda + C) * 2u; voffB[i] = (unsigned)(Rb * P.ldb + C) * 2u; }
    const size_t kstep = (size_t)(BK * 2);
    const size_t hstepA = (size_t)HALF * P.lda * 2, hstepB = (size_t)HALF * P.ldb * 2;
    const unsigned ldsw = (unsigned)wid * 1024u;
    const int aoff = lds_byte(wr * 64 + fr, fq * 8), boff = lds_byte(wc * 32 + fr, fq * 8);
#define PG8_SA(b, h) (((b) * 2 + (h)) * HTB)
#define PG8_SB(b, h) ((4 + (b) * 2 + (h)) * HTB)
#define PG8_STAGE(bufoff, gbase, voff) do { _Pragma("unroll") for (int _i = 0; _i < 2; ++_i) \
        __builtin_amdgcn_global_load_lds((const unsigned*)((const char*)(gbase) + (voff)[_i]), (PG8_LAS unsigned*)(lds + (bufoff) + ldsw + _i * 8192), 16, 0, 0); } while (0)
#define PG8_LDA(dst, b, h) do { _Pragma("unroll") for (int m = 0; m < 4; ++m) _Pragma("unroll") for (int k = 0; k < 2; ++k) dst[m][k] = *(const PG8_LAS bf16x8*)(lds + PG8_SA(b, h) + aoff + m * 2048 + k * 1024); } while (0)
#define PG8_LDB(dst, b, h) do { _Pragma("unroll") for (int n = 0; n < 2; ++n) _Pragma("unroll") for (int k = 0; k < 2; ++k) dst[n][k] = *(const PG8_LAS bf16x8*)(lds + PG8_SB(b, h) + boff + n * 2048 + k * 1024); } while (0)
#define PG8_MMA(ai, bj, At, Bt) do { __builtin_amdgcn_s_setprio(1); _Pragma("unroll") for (int m = 0; m < 4; ++m) _Pragma("unroll") for (int n = 0; n < 2; ++n) _Pragma("unroll") for (int k = 0; k < 2; ++k) \
        acc[ai][bj][m][n] = __builtin_amdgcn_mfma_f32_16x16x32_bf16(Bt[n][k], At[m][k], acc[ai][bj][m][n], 0, 0, 0); __builtin_amdgcn_s_setprio(0); } while (0)
#define PG8_WAIT_V(n) asm volatile("s_waitcnt vmcnt(" #n ")" ::: "memory")
#define PG8_WAIT_L(n) asm volatile("s_waitcnt lgkmcnt(" #n ")" ::: "memory")
#define PG8_BAR __builtin_amdgcn_s_barrier()
#define PG8_SCHED __builtin_amdgcn_sched_barrier(0)
    Unit cur, nxt; int ui = 0;
    if (!S.next(0, cur)) return;
    f32x4 acc[2][2][4][2];
#pragma unroll
    for (int a = 0; a < 2; ++a)
#pragma unroll
        for (int b = 0; b < 2; ++b)
#pragma unroll
            for (int m = 0; m < 4; ++m)
#pragma unroll
                for (int n = 0; n < 2; ++n) acc[a][b][m][n] = (f32x4){0.f, 0.f, 0.f, 0.f};
    bf16x8 At[4][2], B0[2][2], B1[2][2];
    UMem cm = P.mem(cur);
    const char* cA = cm.A; const char* cB = cm.B; int nt = cm.nt;
    if constexpr (SP2) {
        PG8_STAGE(PG8_SB(0, 0), cB, voffB); PG8_STAGE(PG8_SB(0, 1), cB + hstepB, voffB); PG8_STAGE(PG8_SA(0, 0), cA, voffA); PG8_STAGE(PG8_SA(0, 1), cA + hstepA, voffA);
        if (wr == 1) PG8_BAR;
        PG8_WAIT_V(2); PG8_BAR;
        PG8_STAGE(PG8_SB(1, 0), cB + kstep, voffB); PG8_STAGE(PG8_SA(1, 0), cA + kstep, voffA); PG8_STAGE(PG8_SB(1, 1), cB + hstepB + kstep, voffB);
        PG8_WAIT_V(6); PG8_BAR;
    } else {
        PG8_STAGE(PG8_SB(0, 0), cB, voffB); PG8_STAGE(PG8_SA(0, 0), cA, voffA); PG8_STAGE(PG8_SB(0, 1), cB + hstepB, voffB); PG8_STAGE(PG8_SA(0, 1), cA + hstepA, voffA);
        if (wr == 1) PG8_BAR;
        PG8_WAIT_V(4); PG8_BAR;
        PG8_STAGE(PG8_SB(1, 0), cB + kstep, voffB); PG8_STAGE(PG8_SA(1, 0), cA + kstep, voffA); PG8_STAGE(PG8_SB(1, 1), cB + hstepB + kstep, voffB);
        PG8_WAIT_V(6); PG8_BAR;
    }
    for (;;) {
        const bool has_next = S.next(ui + 1, nxt);
        UMem nm = cm; if (has_next) nm = P.mem(nxt);
        const char* nA = has_next ? nm.A : cA; const char* nB = has_next ? nm.B : cB;
        for (int t = 0; t < nt; t += 2) {
            const bool last = (t == nt - 2);
            const char* a1 = cA + (size_t)(t + 1) * kstep;
            const char* a2 = last ? nA : cA + (size_t)(t + 2) * kstep; const char* b2 = last ? nB : cB + (size_t)(t + 2) * kstep;
            const char* a3 = a2 + kstep; const char* b3 = b2 + kstep;
            if constexpr (SP2) {
            PG8_LDB(B0, 0, 0); PG8_LDB(B1, 0, 1); PG8_SCHED; PG8_LDA(At, 0, 0); PG8_STAGE(PG8_SA(1, 1), a1 + hstepA, voffA);
            PG8_WAIT_V(8); PG8_WAIT_L(0); PG8_BAR; PG8_MMA(0, 0, At, B0); PG8_MMA(0, 1, At, B1); PG8_BAR; PG8_SCHED;
            PG8_LDA(At, 0, 1); PG8_STAGE(PG8_SB(0, 0), b2, voffB); PG8_STAGE(PG8_SB(0, 1), b2 + hstepB, voffB); PG8_STAGE(PG8_SA(0, 0), a2, voffA);
            PG8_WAIT_V(8); PG8_WAIT_L(0); PG8_BAR; PG8_MMA(1, 0, At, B0); PG8_MMA(1, 1, At, B1); PG8_BAR; PG8_SCHED;
            PG8_LDB(B0, 1, 0); PG8_LDB(B1, 1, 1); PG8_SCHED; PG8_LDA(At, 1, 0); PG8_STAGE(PG8_SA(0, 1), a2 + hstepA, voffA);
            PG8_WAIT_V(8); PG8_WAIT_L(0); PG8_BAR; PG8_MMA(0, 0, At, B0); PG8_MMA(0, 1, At, B1); PG8_BAR; PG8_SCHED;
            PG8_LDA(At, 1, 1); PG8_STAGE(PG8_SB(1, 0), b3, voffB); PG8_STAGE(PG8_SB(1, 1), b3 + hstepB, voffB); PG8_STAGE(PG8_SA(1, 0), a3, voffA);
            PG8_WAIT_V(8); PG8_WAIT_L(0); PG8_BAR; PG8_MMA(1, 0, At, B0); PG8_MMA(1, 1, At, B1); PG8_BAR; PG8_SCHED;
            } else {
            PG8_LDB(B0, 0, 0); PG8_SCHED; PG8_LDA(At, 0, 0); PG8_STAGE(PG8_SA(1, 1), a1 + hstepA, voffA);
            PG8_WAIT_L(8); PG8_BAR; PG8_WAIT_L(0); PG8_MMA(0, 0, At, B0); PG8_BAR; PG8_SCHED;
            PG8_LDB(B1, 0, 1); PG8_STAGE(PG8_SB(0, 0), b2, voffB);
            PG8_BAR; PG8_WAIT_L(0); PG8_MMA(0, 1, At, B1); PG8_BAR;
            PG8_LDA(At, 0, 1); PG8_STAGE(PG8_SA(0, 0), a2, voffA);
            PG8_BAR; PG8_WAIT_L(0); PG8_MMA(1, 0, At, B0); PG8_BAR; PG8_SCHED;
            PG8_STAGE(PG8_SB(0, 1), b2 + hstepB, voffB);
            PG8_WAIT_V(6); PG8_BAR; PG8_MMA(1, 1, At, B1); PG8_BAR;
            PG8_LDB(B0, 1, 0); PG8_SCHED; PG8_LDA(At, 1, 0); PG8_STAGE(PG8_SA(0, 1), a2 + hstepA, voffA);
            PG8_WAIT_L(8); PG8_BAR; PG8_WAIT_L(0); PG8_MMA(0, 0, At, B0); PG8_BAR; PG8_SCHED;
            PG8_LDB(B1, 1, 1); PG8_STAGE(PG8_SB(1, 0), b3, voffB);
            PG8_BAR; PG8_WAIT_L(0); PG8_MMA(0, 1, At, B1); PG8_BAR;
            PG8_LDA(At, 1, 1); PG8_STAGE(PG8_SA(1, 0), a3, voffA);
            PG8_BAR; PG8_WAIT_L(0); PG8_MMA(1, 0, At, B0); PG8_BAR; PG8_SCHED;
            PG8_STAGE(PG8_SB(1, 1), b3 + hstepB, voffB);
            PG8_WAIT_V(6); PG8_BAR; PG8_MMA(1, 1, At, B1); PG8_BAR;
            }
        }
        if constexpr (ALIGN_EPI) { if (wr == 0) PG8_BAR; }
        E(acc, cur, wr, wc, fr, fq);
        if (!has_next) break;
        if (!E.keep(cur)) {
#pragma unroll
        for (int a = 0; a < 2; ++a)
#pragma unroll
            for (int b = 0; b < 2; ++b)
#pragma unroll
                for (int m = 0; m < 4; ++m)
#pragma unroll
                    for (int n = 0; n < 2; ++n) acc[a][b][m][n] = (f32x4){0.f, 0.f, 0.f, 0.f};
        }
        cur = nxt; cm = nm; cA = nA; cB = nB; nt = nm.nt; ++ui;
        if constexpr (ALIGN_EPI) { if (wr == 1) PG8_BAR; }
    }
    PG8_WAIT_V(0);
    if constexpr (!ALIGN_EPI) { if (wr == 0) PG8_BAR; }
    PG8_BAR;
#undef PG8_SA
#undef PG8_SB
#undef PG8_STAGE
#undef PG8_LDA
#undef PG8_LDB
#undef PG8_MMA
#undef PG8_WAIT_V
#undef PG8_WAIT_L
#undef PG8_BAR
#undef PG8_SCHED
}
}
namespace attn_body {
using bf16=__hip_bfloat16;
using bf16x8=__attribute__((ext_vector_type(8)))short;
using s16x4=__attribute__((ext_vector_type(4)))short;
using f32x16=__attribute__((ext_vector_type(16)))float;
using u32x4=__attribute__((ext_vector_type(4)))unsigned;
using f32x4v=__attribute__((ext_vector_type(4)))float;
constexpr int BATCH=8,NHEAD=8,SEQ=4096,D=64,DM=NHEAD*D;
constexpr int NW=8,QBLK=32,QB=QBLK*NW,KVBLK=64,NQB=SEQ/QB;
constexpr int ATTN_PITCH=DM, ATTN_UNIT_ROWS=QB;
__device__ __forceinline__ int crow(int r,int hi){return (r&3)+8*(r>>2)+4*hi;}
#define SBAR() __builtin_amdgcn_sched_barrier(0)
__device__ __forceinline__ void cmask(f32x16&p0,f32x16&p1,int jb,int qrel,int hi){
  const float NEG=-INFINITY; int kb=64*jb+4*hi;
  #pragma unroll
  for(int r=0;r<16;++r){int kv=kb+(r&3)+8*(r>>2); if(kv>qrel)p0[r]=NEG; if(kv+32>qrel)p1[r]=NEG;}
}

constexpr int NSLOT=3, SLOTB=8192;
constexpr int LDS_K=0, LDS_V=NSLOT*SLOTB, LDS_WS=2*NSLOT*SLOTB, LDS_OST=LDS_WS+NW*64*4, LDS_C2=LDS_OST+NW*4096, LDS_WSUM=LDS_C2+SEQ*4, LDS_KX=LDS_WSUM+64, LDS_BYTES=LDS_KX+SEQ*8;
constexpr float C2=0.125f*1.4426950408889634f;
__device__ __forceinline__ void glds16(const void*gsrc,unsigned lds_dst){unsigned keep;
  asm volatile("s_mov_b32 %0, m0\n\ts_mov_b32 m0, %2\n\ts_nop 0\n\tglobal_load_lds_dwordx4 %1, off\n\ts_mov_b32 m0, %0":"=&s"(keep):"v"(gsrc),"s"(lds_dst):"memory");}
__device__ __forceinline__ float max3f(float a,float b,float c){float r;asm("v_max3_f32 %0, %1, %2, %3":"=v"(r):"v"(a),"v"(b),"v"(c));return r;}
__device__ __forceinline__ float max2f(float a,float b){float r;asm("v_max_f32_e32 %0, %1, %2":"=v"(r):"v"(a),"v"(b));return r;}
__device__ __forceinline__ float fadd_s(float a,float b){float r;asm("v_add_f32_e32 %0, %1, %2":"=v"(r):"v"(a),"v"(b));return r;}
__device__ __forceinline__ float fsub_s(float a,float b){float r;asm("v_sub_f32_e32 %0, %1, %2":"=v"(r):"v"(a),"v"(b));return r;}
typedef float f32x2_t __attribute__((ext_vector_type(2))); typedef __bf16 bf16x2_t __attribute__((ext_vector_type(2)));
__device__ __forceinline__ unsigned cvtpk_s(float lo,float hi){f32x2_t v={lo,hi};bf16x2_t b=__builtin_convertvector(v,bf16x2_t);return __builtin_bit_cast(unsigned,b);}
#define WAIT_BAR(N) asm volatile("s_waitcnt vmcnt(" #N ") lgkmcnt(0)\n\ts_barrier":::"memory")

__device__ __forceinline__ void qkt(f32x16&p0,f32x16&p1,const char*Kslot,const bf16x8*qr,int r32,int hi){
  const char*kb=Kslot+hi*1024+r32*16;
  #pragma unroll
  for(int d0=0;d0<4;++d0){
    const bf16x8 b0=*reinterpret_cast<const bf16x8*>(kb+d0*2048);
    const bf16x8 b1=*reinterpret_cast<const bf16x8*>(kb+d0*2048+512);
    {p0=__builtin_amdgcn_mfma_f32_32x32x16_bf16(b0,qr[d0],p0,0,0,0);p1=__builtin_amdgcn_mfma_f32_32x32x16_bf16(b1,qr[d0],p1,0,0,0);}}
}
typedef __attribute__((address_space(3))) const char* lds_cptr;
typedef short v4i16_t __attribute__((ext_vector_type(4)));
__device__ __forceinline__ void kload8(bf16x8*kf,lds_cptr kp){
  kf[0]=*(const __attribute__((address_space(3))) bf16x8*)(kp);      kf[1]=*(const __attribute__((address_space(3))) bf16x8*)(kp+512);
  kf[2]=*(const __attribute__((address_space(3))) bf16x8*)(kp+2048); kf[3]=*(const __attribute__((address_space(3))) bf16x8*)(kp+2560);
  kf[4]=*(const __attribute__((address_space(3))) bf16x8*)(kp+4096); kf[5]=*(const __attribute__((address_space(3))) bf16x8*)(kp+4608);
  kf[6]=*(const __attribute__((address_space(3))) bf16x8*)(kp+6144); kf[7]=*(const __attribute__((address_space(3))) bf16x8*)(kp+6656);
}
__device__ __forceinline__ void kload2(bf16x8*kf,lds_cptr kp,int j){ kf[2*j]=*(const __attribute__((address_space(3))) bf16x8*)(kp+j*2048); kf[2*j+1]=*(const __attribute__((address_space(3))) bf16x8*)(kp+j*2048+512); }
__device__ __forceinline__ s16x4 vtr(lds_cptr p){ return __builtin_bit_cast(s16x4,__builtin_amdgcn_ds_read_tr16_b64_v4i16((__attribute__((address_space(3))) v4i16_t*)p)); }
__device__ __forceinline__ float rowmax(const f32x16&p0,const f32x16&p1){
  float a=max3f(p0[0],p0[1],p1[0]),b=max3f(p0[2],p0[3],p1[1]);a=max3f(a,p1[2],p1[3]);
  #pragma unroll
  for(int r=4;r<16;r+=4){a=max3f(a,p0[r],p0[r+1]);b=max3f(b,p0[r+2],p0[r+3]);a=max3f(a,p1[r],p1[r+1]);b=max3f(b,p1[r+2],p1[r+3]);}
  const float m=max2f(a,b);
  auto rr=__builtin_amdgcn_permlane32_swap(__float_as_uint(m),__float_as_uint(m),false,false);
  return max2f(__uint_as_float(rr[0]),__uint_as_float(rr[1]));
}
__device__ __forceinline__ void pv(f32x16*o,int vb,bf16x8 pa0,bf16x8 pa1,bf16x8 pa2,bf16x8 pa3){
  #pragma unroll
  for(int d0=0;d0<2;++d0){s16x4 lo[4],hi[4];
    #pragma unroll
    for(int ks=0;ks<4;++ks){
      asm volatile("ds_read_b64_tr_b16 %0,%1 offset:%c2":"=&v"(lo[ks]):"v"(vb),"i"(d0*4096+ks*1024):"memory");
      asm volatile("ds_read_b64_tr_b16 %0,%1 offset:%c2":"=&v"(hi[ks]):"v"(vb),"i"(d0*4096+ks*1024+512):"memory");}
    asm volatile("s_waitcnt lgkmcnt(0)":::"memory");SBAR();
    #define PK(k) (bf16x8){lo[k][0],lo[k][1],lo[k][2],lo[k][3],hi[k][0],hi[k][1],hi[k][2],hi[k][3]}
    o[d0]=__builtin_amdgcn_mfma_f32_32x32x16_bf16(pa0,PK(0),o[d0],0,0,0);
    o[d0]=__builtin_amdgcn_mfma_f32_32x32x16_bf16(pa1,PK(1),o[d0],0,0,0);
    o[d0]=__builtin_amdgcn_mfma_f32_32x32x16_bf16(pa2,PK(2),o[d0],0,0,0);
    o[d0]=__builtin_amdgcn_mfma_f32_32x32x16_bf16(pa3,PK(3),o[d0],0,0,0);
    #undef PK
  }
}

#ifndef ATTN_STORE16
#define ATTN_STORE16(p,v) (*(u32x4*)(p)=(v))
#endif
template<int THRL> __device__ __forceinline__ void attn_unit(int b,int h,int qb,const bf16*Q,const bf16*__restrict__ K,const bf16*__restrict__ V,bf16*O,char*shm,float dthr2,float mref2){
  typedef __attribute__((address_space(3))) const float* lds_cf; typedef __attribute__((address_space(3))) const f32x4v* lds_cf4;
  const int tid=opaque_i(threadIdx.x),lane=tid&63,r32=lane&31,hi=lane>>5; const int wid=__builtin_amdgcn_readfirstlane(tid>>6);
  const long rowbase=(long)b*SEQ; const int q0=qb*QB;
  const bf16*Qw=Q+(rowbase+q0+wid*QBLK)*DM+h*D;
  int T0;
  { const lds_cf c2all=(lds_cf)((lds_cptr)shm+LDS_C2); const float thr=c2all[q0]-dthr2; const bool skp=c2all[64*lane+63]<thr; const unsigned long long bal=__ballot(skp);
    const int nskip=(~bal==0ull)?64:(int)__builtin_ctzll(~bal); const int ntf=(q0+QB)/KVBLK; int t0=nskip&~1; if(t0>ntf-4)t0=ntf-4; T0=__builtin_amdgcn_readfirstlane(t0); }
  const bf16*Kh=K+(rowbase+(long)T0*KVBLK)*DM+h*D,*Vh=V+(rowbase+(long)T0*KVBLK)*DM+h*D;
  const unsigned lds0=(unsigned)(uintptr_t)shm;
  float*wsf=(float*)(shm+LDS_WS)+wid*64;
  const bf16*ksrc=Kh+(long)lane*DM+wid*8;
  const bf16*vsrc=Vh+(long)(16*(wid&3)+(lane>>2))*DM+(wid>>2)*32+(lane&3)*8;
  const unsigned kdst=lds0+LDS_K+wid*1024, vdst=lds0+LDS_V+wid*1024;
  #define DMA_K(t,slot) glds16(ksrc+(long)(t)*KVBLK*DM,(unsigned)__builtin_amdgcn_readfirstlane(kdst+(slot)))
  #define DMA_V(t,slot) glds16(vsrc+(long)(t)*KVBLK*DM,(unsigned)__builtin_amdgcn_readfirstlane(vdst+(slot)))
  const int vb0=(int)(lds0+LDS_V)+((lane>>4)&1)*32+(lane&3)*8+(4*hi+((lane&15)>>2))*64;
  const char*Kbase=shm+LDS_K; bf16x8 kf[8];
  const lds_cptr shm3=(lds_cptr)shm; const lds_cptr kp0=shm3+LDS_K+hi*1024+r32*16; const lds_cptr vp0=shm3+LDS_V+((lane>>4)&1)*32+(lane&3)*8+(4*hi+((lane&15)>>2))*64;
  const int NT=(q0+QB)/KVBLK-T0;
  DMA_K(0,0);DMA_V(0,0);DMA_K(1,SLOTB);
  bf16x8 qr[4];
  #pragma unroll
  for(int d0=0;d0<4;++d0)qr[d0]=*reinterpret_cast<const bf16x8*>(&Qw[(long)r32*DM+d0*16+hi*8]);
  float l_reg=0.f;f32x16 o[2];o[0]=f32x16{};o[1]=f32x16{};
  const float k0c=-(((lds_cf)((lds_cptr)shm+LDS_C2))[q0+wid*QBLK+r32]+mref2);
  bf16x8 qx;
  { const unsigned h_=__float_as_uint(k0c); const unsigned kh=(h_+0x7fffu+((h_>>16)&1u))>>16; const float r1_=k0c-__uint_as_float(kh<<16);
    const unsigned m_=__float_as_uint(r1_); const unsigned km=(m_+0x7fffu+((m_>>16)&1u))>>16; const float r2_=r1_-__uint_as_float(km<<16);
    const unsigned l_=__float_as_uint(r2_); const unsigned kl=(l_+0x7fffu+((l_>>16)&1u))>>16;
    u32x4 w_; w_.x=hi?0u:0x3F803F80u; w_.y=hi?0u:(0x3F80u|(kh<<16)); w_.z=hi?0u:(km|(kl<<16)); w_.w=0u; qx=__builtin_bit_cast(bf16x8,w_); }
  typedef __attribute__((address_space(3))) const unsigned long long* lds_cu64;
  const lds_cu64 kxp=(lds_cu64)((lds_cptr)shm+LDS_KX)+T0*KVBLK+r32;
  #define KXF(v_) __builtin_bit_cast(bf16x8,(u32x4){(unsigned)(v_),(unsigned)((v_)>>32),0x3F803F80u,0u})
  #define CINIT(C0,C1,t) do{ const unsigned long long a_=kxp[(t)*KVBLK], b_=kxp[(t)*KVBLK+32]; const f32x16 z_=f32x16{}; \
    C0=__builtin_amdgcn_mfma_f32_32x32x16_bf16(KXF(a_),qx,z_,0,0,0); C1=__builtin_amdgcn_mfma_f32_32x32x16_bf16(KXF(b_),qx,z_,0,0,0); }while(0)
  const int qrel=wid*QBLK+r32;
  #define CMASK(P0,P1,t) do{int jb_=(t)-(NT-4); if(jb_>=0)cmask(P0,P1,jb_,qrel,hi);}while(0)
  #define START(P0,P1) do{ _Pragma("unroll") for(int r=0;r<16;++r)P0[r]=__builtin_amdgcn_exp2f(P0[r]); }while(0)
  #define RESC() do{}while(0)
  f32x16 pA0,pA1,pB0,pB1;
  int sl_prev=0,sl_cur=0,sl_next=SLOTB;
  #define ROT() do{sl_prev=sl_cur;sl_cur=sl_next;sl_next=(sl_next==(NSLOT-1)*SLOTB)?0:sl_next+SLOTB;}while(0)
  DMA_K(2,2*SLOTB);
  WAIT_BAR(3);
  CINIT(pA0,pA1,0); qkt(pA0,pA1,Kbase,qr,r32,hi);asm volatile("s_nop 15\n\ts_nop 7":"+v"(pA0),"+v"(pA1));CMASK(pA0,pA1,0);
  START(pA0,pA1);
  _Pragma("unroll") for(int r=0;r<16;++r)pA1[r]=__builtin_amdgcn_exp2f(pA1[r]);
  WAIT_BAR(0);
  DMA_K(3,0);DMA_V(1,SLOTB);
  ROT();
  kload8(kf,kp0+sl_cur);
  WAIT_BAR(2);
  s16x4 vlo[8],vhi[8]; u32x4 pw0,pw1,pw2,pw3;
  #define PKW(P,B) cvtpk_s(P[B],P[B+1])
  #define PAF(k) __builtin_bit_cast(bf16x8,pw##k)
  #define VFR(i) (bf16x8){vlo[i][0],vlo[i][1],vlo[i][2],vlo[i][3],vhi[i][0],vhi[i][1],vhi[i][2],vhi[i][3]}
  #define PIN(x) asm volatile("":"+v"(x))
  #define MX3(a,b,c) __builtin_fmaxf(__builtin_fmaxf((a),(b)),(c))
  #define GAPA(MF,A0,A1,A2,A3,W0,W1,PW) do{ MF; sacc+=A0; sacc+=A1; sacc+=A2; sacc+=A3; PIN(sacc); W0; W1; PIN(PW); SBAR(); }while(0)
  #define EX(v) __builtin_amdgcn_exp2f(v)
  #define GAPB(MF,X,B) do{ MF; X[B]=EX(X[B]); X[B+1]=EX(X[B+1]); X[B+2]=EX(X[B+2]); X[B+3]=EX(X[B+3]); PIN(X); SBAR(); }while(0)
  #define VRD(i) do{ vlo[i]=vtr(vp_+(((i)>>2)*4096+((i)&3)*1024)); vhi[i]=vtr(vp_+(((i)>>2)*4096+((i)&3)*1024+512)); }while(0)
  #define KRD(G,j) do{ if(G){ kload2(kf,kp0+sl_next,j); SBAR(); } }while(0)
  #define STEP(C0,C1,P0,P1,t,GK,GV,GL) do{ SBAR(); CINIT(C0,C1,t); SBAR(); \
    const lds_cptr vp_=vp0+sl_prev; \
    VRD(0); SBAR(); float sacc=(P0[0]+P0[1]); \
    GAPA(C0=__builtin_amdgcn_mfma_f32_32x32x16_bf16(kf[0],qr[0],C0,0,0,0), P0[2],P0[3],P0[4],P0[5],     pw0[0]=PKW(P0,0), pw0[1]=PKW(P0,2), pw0); \
    VRD(4); SBAR(); GAPA(C1=__builtin_amdgcn_mfma_f32_32x32x16_bf16(kf[1],qr[0],C1,0,0,0), P0[6],P0[7],P0[8],P0[9],     pw0[2]=PKW(P0,4), pw0[3]=PKW(P0,6), pw0); \
    VRD(1); SBAR(); GAPA(C0=__builtin_amdgcn_mfma_f32_32x32x16_bf16(kf[2],qr[1],C0,0,0,0),   P0[10],P0[11],P0[12],P0[13], pw1[0]=PKW(P0,8), pw1[1]=PKW(P0,10), pw1); \
    VRD(5); SBAR(); GAPA(C1=__builtin_amdgcn_mfma_f32_32x32x16_bf16(kf[3],qr[1],C1,0,0,0),   P0[14],P0[15],P1[0],P1[1],   pw1[2]=PKW(P0,12),pw1[3]=PKW(P0,14), pw1); \
    VRD(2); SBAR(); GAPA(C0=__builtin_amdgcn_mfma_f32_32x32x16_bf16(kf[4],qr[2],C0,0,0,0),   P1[2],P1[3],P1[4],P1[5],     pw2[0]=PKW(P1,0), pw2[1]=PKW(P1,2), pw2); \
    VRD(6); SBAR(); GAPA(C1=__builtin_amdgcn_mfma_f32_32x32x16_bf16(kf[5],qr[2],C1,0,0,0),   P1[6],P1[7],P1[8],P1[9],     pw2[2]=PKW(P1,4), pw2[3]=PKW(P1,6), pw2); \
    VRD(3); SBAR(); GAPA(C0=__builtin_amdgcn_mfma_f32_32x32x16_bf16(kf[6],qr[3],C0,0,0,0),   P1[10],P1[11],P1[12],P1[13], pw3[0]=PKW(P1,8), pw3[1]=PKW(P1,10), pw3); \
    VRD(7); SBAR(); GAPA(C1=__builtin_amdgcn_mfma_f32_32x32x16_bf16(kf[7],qr[3],C1,0,0,0),   P1[14],P1[15],0.f,0.f,       pw3[2]=PKW(P1,12),pw3[3]=PKW(P1,14), pw3); \
    l_reg+=sacc; \
    if(GK){DMA_K((t)+3,sl_cur);} if(GV){DMA_V((t)+1,sl_next);} \
    CMASK(C0,C1,t); \
    SBAR(); \
    GAPB(o[0]=__builtin_amdgcn_mfma_f32_32x32x16_bf16(PAF(0),VFR(0),o[0],0,0,0), C0,0); \
    GAPB(o[1]=__builtin_amdgcn_mfma_f32_32x32x16_bf16(PAF(0),VFR(4),o[1],0,0,0), C0,4); \
    KRD(GL,0); GAPB(o[0]=__builtin_amdgcn_mfma_f32_32x32x16_bf16(PAF(1),VFR(1),o[0],0,0,0), C0,8); \
    KRD(GL,1); GAPB(o[1]=__builtin_amdgcn_mfma_f32_32x32x16_bf16(PAF(1),VFR(5),o[1],0,0,0), C0,12); \
    KRD(GL,2); GAPB(o[0]=__builtin_amdgcn_mfma_f32_32x32x16_bf16(PAF(2),VFR(2),o[0],0,0,0), C1,0); \
    KRD(GL,3); GAPB(o[1]=__builtin_amdgcn_mfma_f32_32x32x16_bf16(PAF(2),VFR(6),o[1],0,0,0), C1,4); \
    GAPB(o[0]=__builtin_amdgcn_mfma_f32_32x32x16_bf16(PAF(3),VFR(3),o[0],0,0,0), C1,8); \
    GAPB(o[1]=__builtin_amdgcn_mfma_f32_32x32x16_bf16(PAF(3),VFR(7),o[1],0,0,0), C1,12); \
    }while(0)
  int t=1;
  #undef CMASK
  #define CMASK(P0,P1,t) do{}while(0)
  for(;t+5<NT;t+=2){
    STEP(pB0,pB1,pA0,pA1,t,true,true,true);     WAIT_BAR(2); RESC(); ROT();
    STEP(pA0,pA1,pB0,pB1,t+1,true,true,true);   WAIT_BAR(2); RESC(); ROT();
  }
  #undef CMASK
  #define CMASK(P0,P1,t) do{int jb_=(t)-(NT-4); if(jb_>=0)cmask(P0,P1,jb_,qrel,hi);}while(0)
  #define ENDW(tt) do{ if((tt)+3<NT){WAIT_BAR(2);} else if((tt)+2<NT){WAIT_BAR(1);} else {WAIT_BAR(0);} }while(0)
  for(;t+1<NT;t+=2){
    STEP(pB0,pB1,pA0,pA1,t,(t+3<NT),(t+1<NT),(t+1<NT));       ENDW(t);   RESC(); ROT();
    STEP(pA0,pA1,pB0,pB1,t+1,(t+4<NT),(t+2<NT),(t+2<NT));     ENDW(t+1); RESC(); ROT();
  }
  STEP(pB0,pB1,pA0,pA1,NT-1,false,false,false); RESC();
  { float sacc=pB0[0]+pB0[1]; _Pragma("unroll") for(int r=2;r<16;++r)sacc+=pB0[r]; _Pragma("unroll") for(int r=0;r<16;++r)sacc+=pB1[r]; l_reg+=sacc;
    pw0=(u32x4){PKW(pB0,0),PKW(pB0,2),PKW(pB0,4),PKW(pB0,6)};pw1=(u32x4){PKW(pB0,8),PKW(pB0,10),PKW(pB0,12),PKW(pB0,14)};pw2=(u32x4){PKW(pB1,0),PKW(pB1,2),PKW(pB1,4),PKW(pB1,6)};pw3=(u32x4){PKW(pB1,8),PKW(pB1,10),PKW(pB1,12),PKW(pB1,14)};
    SBAR(); pv(o,vb0+sl_cur,PAF(0),PAF(1),PAF(2),PAF(3)); }
  #undef PKW
  #undef PAF
  #undef VFR
  #undef PIN
  #undef MX3
  #undef GAPA
  #undef GAPB
  #undef EX
  #undef VRD
  #undef KRD
  #undef STEP
  #undef ENDW
  {auto rr=__builtin_amdgcn_permlane32_swap(__float_as_uint(l_reg),__float_as_uint(l_reg),false,false);l_reg=__uint_as_float(rr[0])+__uint_as_float(rr[1]);}
  if(hi==0)wsf[32+r32]=l_reg;asm volatile("s_waitcnt lgkmcnt(0)":::"memory");
  float rli[16];
  #pragma unroll
  for(int r=0;r<16;++r)rli[r]=__builtin_amdgcn_rcpf(wsf[32+crow(r,hi)]);
  bf16*Ow=O+(rowbase+q0+wid*QBLK)*DM+h*D;
  { bf16*stg=(bf16*)(shm+LDS_OST)+wid*2048;
    #pragma unroll
    for(int r=0;r<16;++r){const int orow=crow(r,hi);
      #pragma unroll
      for(int d0=0;d0<2;++d0)stg[orow*64+d0*32+r32]=__float2bfloat16(o[d0][r]*rli[r]);}
    asm volatile("s_waitcnt lgkmcnt(0)":::"memory");
    #pragma unroll
    for(int i=0;i<4;++i){const int row=i*8+(lane>>3),ch=lane&7; const u32x4 v=*(const u32x4*)(stg+row*64+ch*8); ATTN_STORE16(Ow+(long)row*DM+ch*8,v);} }
  asm volatile("s_waitcnt lgkmcnt(0)\n\ts_barrier":::"memory");
  #undef CINIT
  #undef KXF
  #undef DMA_K
  #undef DMA_V
  #undef CMASK
  #undef START
  #undef RESC
  #undef ROT
}
constexpr int ATTN_LDS_BYTES=LDS_BYTES;
struct AttnTensors { const bf16* Q; const bf16* K; const bf16* V; bf16* O; };
struct AttnUnit { int bh; int qb; };
struct StaticOrder {
  int vcu;
  __device__ __forceinline__ explicit StaticOrder(int grid,int block):vcu((block%8)*(grid/8)+block/8){}
  __device__ __forceinline__ bool next(int i,AttnUnit&u)const{ if(i>=4)return false; const int s=vcu&3; u.bh=vcu>>2; u.qb=(i==0)?15-s:(i==1)?8+s:(i==2)?7-s:s; return true; }
  __device__ __forceinline__ void a_ready(const AttnUnit&)const{}
  __device__ __forceinline__ void done(const AttnUnit&)const{}
};
template<class Sched,int THRL=8> __device__ __forceinline__ void attn_phase(char*lds,const AttnTensors&T,const Sched&S){
  AttnUnit u;
  for(int i=0;S.next(i,u);++i){ S.a_ready(u); attn_unit<THRL>(u.bh/NHEAD,u.bh%NHEAD,u.qb,T.Q,T.K,T.V,T.O,lds,1e30f,16.0f); S.done(u); }
}
#undef SBAR
#undef WAIT_BAR
}
constexpr size_t MiB = 1u << 20;
constexpr size_t WS_SSQ_MIX = 0;
constexpr size_t WS_LOGF = 2 * MiB;
constexpr size_t WS_BAR = 3 * MiB + 512 * 1024;
constexpr size_t WS_WF = 3 * MiB;
constexpr size_t WS_W = 4 * MiB, W_PAR = 32 * MiB;
constexpr size_t W_WIN = 0, W_WM = 11 * MiB, W_WO = 13 * MiB, W_WFI = 15 * MiB, W_WFO = 26 * MiB;
constexpr size_t WS_XB = 68 * MiB;
constexpr size_t WS_Q = 132 * MiB, WS_K = 164 * MiB, WS_V = 196 * MiB;
constexpr size_t WS_CP = 228 * MiB;
constexpr size_t WS_G = 292 * MiB;
constexpr size_t WS_SSQ_FFN = 484 * MiB;
constexpr size_t WS_END = 486 * MiB;
constexpr int LDS_BYTES = 147456;
constexpr int NWAVES = 8;

#define GAS __attribute__((address_space(1)))
#define LAS __attribute__((address_space(3)))
typedef unsigned short bf16;
typedef unsigned v4u __attribute__((ext_vector_type(4)));
typedef float f32x4 __attribute__((ext_vector_type(4)));
#define LDS_WAIT() asm volatile("s_waitcnt lgkmcnt(0)" ::: "memory")
__device__ __forceinline__ unsigned f2bf(float f) { unsigned u = __builtin_bit_cast(unsigned, f); return (u + 0x7fffu + ((u >> 16) & 1u)) >> 16; }
__device__ __forceinline__ unsigned pk2(float lo, float hi) { return f2bf(lo) | (f2bf(hi) << 16); }
__device__ __forceinline__ float wave_sum(float v) {
#pragma unroll
    for (int o = 1; o < 64; o <<= 1) v += __shfl_xor(v, o);
    return v;
}

__device__ __forceinline__ void tr_item(const float* W, int ldn, int n0, int k0, const float* gain, bf16* WT, int ldk, int drow0, int koff, LAS float* scr, int lane) {
    { const int c4 = lane & 7, kr = lane >> 3;
#pragma unroll
      for (int i = 0; i < 8; ++i) { const int kk = 8 * i + kr; f32x4 w = *(const f32x4*)(W + (size_t)(k0 + kk) * ldn + n0 + 4 * c4); if (gain) w *= gain[k0 + kk];
          LAS float* d = scr + kk * 33 + 4 * c4; d[0] = w.x; d[1] = w.y; d[2] = w.z; d[3] = w.w; } }
    LDS_WAIT(); asm volatile("" ::: "memory");
    const int c = lane & 7;
#pragma unroll
    for (int j = 0; j < 4; ++j) { const int n = (lane >> 3) + 8 * j; const LAS float* s = scr + (8 * c) * 33 + n;
        v4u o; o.x = pk2(s[0 * 33], s[1 * 33]); o.y = pk2(s[2 * 33], s[3 * 33]); o.z = pk2(s[4 * 33], s[5 * 33]); o.w = pk2(s[6 * 33], s[7 * 33]);
        *(v4u*)(WT + (size_t)(drow0 + n) * ldk + koff + k0 + 8 * c) = o; }
    LDS_WAIT(); asm volatile("" ::: "memory");
}

#define XB_TMO      128
#define XB_XCNT(j)  (256  + 64 * (j))
#define XB_XSUB(j)  (1280 + 64 * (j))
#define XB_XGEN(j)  (2304 + 64 * (j))
#define XB_TOP      3328
#define XB_TOPGEN   3392
#define XCD_BAR_WORDS 3456
#define XB_SPIN_CAP (1u << 18)

__device__ __forceinline__ unsigned xb_ld(unsigned* p)              { return __hip_atomic_load(p, __ATOMIC_RELAXED, __HIP_MEMORY_SCOPE_AGENT); }
__device__ __forceinline__ unsigned xb_add(unsigned* p, unsigned v) { return __hip_atomic_fetch_add(p, v, __ATOMIC_RELAXED, __HIP_MEMORY_SCOPE_AGENT); }
__device__ __forceinline__ unsigned xb_xcc_id() { return (unsigned)__builtin_amdgcn_s_getreg((3 << 11) | 20) & 0xFu; }
#define XB_SPIN(cond, bar) do { unsigned _sp = 0; while (cond) { __builtin_amdgcn_s_sleep(1); \
    if ((++_sp & 255u) == 0u) { if (xb_ld(&(bar)[XB_TMO])) break; if (_sp > XB_SPIN_CAP) { atomicAdd(&(bar)[XB_TMO], 1u); break; } } } } while (0)

struct XcdBarrier {
    unsigned* bar; unsigned x;
    volatile LAS unsigned* st;
};

__device__ __forceinline__ XcdBarrier xcd_barrier_post(unsigned* bar, volatile LAS unsigned* st) {
    XcdBarrier b; b.bar = bar; b.x = xb_xcc_id(); b.st = st;
    if (threadIdx.x == 0) (void)xb_add(&bar[XB_XCNT(b.x)], 1u);
    return b;
}
__device__ __forceinline__ void xcd_barrier_complete(unsigned* bar, unsigned x, unsigned& nloc, unsigned& nx) {
    const unsigned G = gridDim.x * gridDim.y * gridDim.z;
    unsigned sum, cnt, mine, sp = 0u;
    for (;;) {
        sum = 0u; cnt = 0u; mine = 0u;
#pragma unroll
        for (unsigned j = 0; j < 16; ++j) { const unsigned c = xb_ld(&bar[XB_XCNT(j)]); sum += c; cnt += (c > 0u) ? 1u : 0u; mine = (j == x) ? c : mine; }
        if (sum == G) break;
        __builtin_amdgcn_s_sleep(1);
        if ((++sp & 255u) == 0u) { if (xb_ld(&bar[XB_TMO])) break; if (sp > XB_SPIN_CAP) { atomicAdd(&bar[XB_TMO], 1u); break; } }
    }
    nloc = mine > 0u ? mine : 1u; nx = cnt > 0u ? cnt : 1u;
}

__device__ __forceinline__ void xcd_barrier(const XcdBarrier& b) {
    asm volatile("s_waitcnt vmcnt(0)" ::: "memory");
    __syncthreads();
    if (threadIdx.x == 0) {
        unsigned* bar = b.bar; const unsigned myx = xb_xcc_id();
        __builtin_amdgcn_s_waitcnt(0);
        unsigned nloc = b.st[0], nx = b.st[1];
        if (nloc == 0u) { xcd_barrier_complete(bar, myx, nloc, nx); b.st[0] = nloc; b.st[1] = nx; }
        const unsigned old = xb_add(&bar[XB_XSUB(myx)], 1u);
        const unsigned gen = old / nloc;
        if (old + 1u == (gen + 1u) * nloc) {
            __builtin_amdgcn_fence(__ATOMIC_RELEASE, "agent");
            asm volatile("s_waitcnt vmcnt(0)" ::: "memory");
            const unsigned og = xb_add(&bar[XB_TOP], 1u);
            const unsigned tg = og / nx;
            if (og + 1u == (tg + 1u) * nx) xb_add(&bar[XB_TOPGEN], 1u);
            else XB_SPIN(xb_ld(&bar[XB_TOPGEN]) == tg, bar);
            __builtin_amdgcn_fence(__ATOMIC_ACQUIRE, "agent");
            xb_add(&bar[XB_XGEN(myx)], 1u);
            asm volatile("s_waitcnt vmcnt(0)" ::: "memory");
        } else {
            XB_SPIN(xb_ld(&bar[XB_XGEN(myx)]) == gen, bar);
            __builtin_amdgcn_fence(__ATOMIC_ACQUIRE, "agent");
            asm volatile("s_waitcnt vmcnt(0)" ::: "memory");
        }
    }
    __syncthreads();
}

struct Args { const float* in[15]; float* out; unsigned char* ws; };

__device__ __forceinline__ void convert_layer(const Args& a, int l, int par, LAS unsigned char* lds, int gw, int NGW, int wave, int lane) {
    lane = opaque_i(lane);
    LAS float* scr = (LAS float*)(lds + wave * 16384);
    unsigned char* wb = a.ws + WS_W + (size_t)par * W_PAR;
    bf16* WIN = (bf16*)(wb + W_WIN); bf16* WM = (bf16*)(wb + W_WM); bf16* WO = (bf16*)(wb + W_WO); bf16* WFI = (bf16*)(wb + W_WFI); bf16* WFO = (bf16*)(wb + W_WFO);
    bf16* WFB = (bf16*)(a.ws + WS_WF) + (size_t)par * 16384;
    const float* g_mix = a.in[1] + (size_t)l * 1024; const float* w_in = a.in[2] + (size_t)l * 1024 * DIN_SRC;
    const float* w_ao = a.in[6] + (size_t)l * 512 * 1024; const float* w_co = a.in[8] + (size_t)l * 256 * 1024;
    const float* pool_w = a.in[9] + (size_t)l * 4 * 64 * 256; const float* pool_s = a.in[10] + (size_t)l * 1024;
    const float* w_o = a.in[11] + (size_t)l * 1024 * 1024; const float* g_ffn = a.in[12] + (size_t)l * 1024;
    const float* w_fi = a.in[13] + (size_t)l * 1024 * 5632; const float* w_fo = a.in[14] + (size_t)l * 2816 * 1024;
    constexpr int I_WIN = 16 * 176, I_WFI = 16 * 176, I_WO = 16 * 32, I_WFO = 44 * 32, I_WA = 8 * 32, I_WC = 4 * 32, I_WP = 1024, I_WF = 8;
    constexpr int NITEMS = I_WIN + I_WFI + I_WO + I_WFO + I_WA + I_WC + I_WP + I_WF;
    for (int it = gw; it < NITEMS; it += NGW) {
        int r = it;
        if (r < I_WIN) { const int kb = r / 176, nb = r % 176, pn = nb >> 3, rem = nb & 7, bj = rem >> 2, w = rem & 3; const int nl = 256 * pn + 64 * w + 32 * bj; const int src = nl < 1536 ? nl : nl + 8;
            tr_item(w_in, DIN_SRC, src, 64 * kb, g_mix, WIN, 1024, 32 * nb, 0, scr, lane); continue; } r -= I_WIN;
        if (r < I_WFI) { const int kb = r / 176, nb = r % 176, pn = nb >> 3, rem = nb & 7, bj = rem >> 2, w = rem & 3; const int src = bj * DFF + 128 * pn + 32 * w;
            tr_item(w_fi, 5632, src, 64 * kb, g_ffn, WFI, 1024, 32 * nb, 0, scr, lane); continue; } r -= I_WFI;
        if (r < I_WO) { const int kb = r >> 5, nb = r & 31; tr_item(w_o, 1024, 32 * nb, 64 * kb, nullptr, WO, 1024, 32 * nb, 0, scr, lane); continue; } r -= I_WO;
        if (r < I_WFO) { const int kb = r >> 5, nb = r & 31; tr_item(w_fo, 1024, 32 * nb, 64 * kb, nullptr, WFO, DFF, 32 * nb, 0, scr, lane); continue; } r -= I_WFO;
        if (r < I_WA) { const int kb = r >> 5, nb = r & 31; tr_item(w_ao, 1024, 32 * nb, 64 * kb, nullptr, WM, 896, 32 * nb, 0, scr, lane); continue; } r -= I_WA;
        if (r < I_WC) { const int kb = r >> 5, nb = r & 31; tr_item(w_co, 1024, 32 * nb, 64 * kb, nullptr, WM, 896, 32 * nb, 512, scr, lane); continue; } r -= I_WC;
        if (r < I_WP) { const int n = r, g = n >> 8, d = n & 255; const float w = pool_w[((size_t)g * 64 + lane) * 256 + d] * pool_s[n]; const bf16 wv = (bf16)f2bf(w);
            WM[(size_t)n * 896 + 768 + lane] = (g & 1) ? (bf16)0 : wv; WM[(size_t)n * 896 + 768 + 64 + lane] = (g & 1) ? wv : (bf16)0; continue; } r -= I_WP;
        { const int h = r;
#pragma unroll 4
            for (int i = 0; i < 16; ++i) { const int k = lane + 64 * i; const float w = w_in[(size_t)k * DIN_SRC + 1536 + h] * g_mix[k]; const unsigned hi = f2bf(w);
                WFB[h * 1024 + k] = (bf16)hi; WFB[(8 + h) * 1024 + k] = (bf16)f2bf(w - __uint_as_float(hi << 16)); } }
    }
}

constexpr int RS_OFF = 131072;
template <class Sched> __device__ __forceinline__ void build_row_scales(LAS unsigned char* lds, const Sched& S, const float* ssq, int tid) {
    LAS float* RS = (LAS float*)(lds + RS_OFF);
    const int half = tid >> 8, r = tid & 255;
    f32x4 v[6][4]; bool ok[6];
#pragma unroll
    for (int k = 0; k < 6; ++k) { pg8::Unit u; ok[k] = S.next(2 * k + half, u); const f32x4* q = (const f32x4*)(ssq + (size_t)((ok[k] ? u.pm : 0) * 256 + r) * 16);
#pragma unroll
        for (int j = 0; j < 4; ++j) v[k][j] = q[j]; }
#pragma unroll
    for (int k = 0; k < 6; ++k) { const f32x4 t = (v[k][0] + v[k][1]) + (v[k][2] + v[k][3]); const float sum = (t[0] + t[1]) + (t[2] + t[3]);
        if (ok[k]) RS[(2 * k + half) * 256 + r] = rsqrtf(sum * (1.0f / 1024.0f) + EPSN); }
    __syncthreads();
}

__global__ void __launch_bounds__(NWAVES * 64, 2) fwd_kernel(Args args) {
    extern __shared__ __attribute__((aligned(16))) unsigned char lds[];
    cg::grid_group grid = cg::this_grid();
#define GSYNC0() do { asm volatile("s_waitcnt vmcnt(0)" ::: "memory"); grid.sync(); __builtin_amdgcn_fence(__ATOMIC_ACQUIRE, "agent"); asm volatile("s_waitcnt vmcnt(0)" ::: "memory"); } while (0)
    LAS unsigned char* ldsl = (LAS unsigned char*)lds;
    const int tid = threadIdx.x, lane = tid & 63, wave = __builtin_amdgcn_readfirstlane(tid >> 6);
    const int G = gridDim.x; const int bx = blockIdx.x; const int vcu = (G % 8 == 0) ? (bx % 8) * (G / 8) + bx / 8 : bx;
    const int gw = vcu * NWAVES + wave, NGW = G * NWAVES;
#ifdef PROBE
    LAS unsigned long long* TACC = (LAS unsigned long long*)(ldsl + LDS_BYTES - 128);
    if (bx == 0 && tid == 0) { for (int i = 0; i < 14; ++i) TACC[i] = 0ull; TACC[13] = 1ull; TACC[12] = __builtin_amdgcn_s_memrealtime(); }
#define TSTAMP(k) do { if (bx == 0 && tid == 0) { const unsigned long long t_ = __builtin_amdgcn_s_memrealtime(); if (TACC[13]) TACC[k] += t_ - TACC[12]; TACC[12] = t_; } } while (0)
#else
#define TSTAMP(k) do {} while (0)
#endif
    unsigned char* ws = args.ws;
    float* SSQ_MIX = (float*)(ws + WS_SSQ_MIX); float* SSQ_FFN = (float*)(ws + WS_SSQ_FFN); float* LOGF = (float*)(ws + WS_LOGF);
    bf16* XB = (bf16*)(ws + WS_XB); bf16* CZ = (bf16*)args.out;     bf16* QO = (bf16*)(ws + WS_Q); bf16* KB = (bf16*)(ws + WS_K); bf16* VB = (bf16*)(ws + WS_V); bf16* MG = KB;
    bf16* CP = (bf16*)(ws + WS_CP); bf16* GT = (bf16*)(ws + WS_G); bf16* ACT = GT;
    const float* x_in = args.in[0]; float* out = args.out;

    unsigned* barw = (unsigned*)(ws + WS_BAR);
    volatile LAS unsigned* bst = (volatile LAS unsigned*)(ldsl + LDS_BYTES - 256);
    if (tid < 2) bst[tid] = 0u;
    __syncthreads();
    XcdBarrier xbar = xcd_barrier_post(barw, bst);
#define GSYNC() xcd_barrier(xbar)
    if (args.ws == nullptr) GSYNC0();
    convert_layer(args, 0, 0, ldsl, gw, NGW, wave, lane);
    for (int m = gw; m < MTOK; m += 4 * NGW) {
        const int lane = opaque_i(tid) & 63;
        f32x4 v[4][4];
#pragma unroll
        for (int r = 0; r < 4; ++r) { const f32x4* xr = (const f32x4*)(x_in + (size_t)(m + r * NGW) * 1024) + lane;
#pragma unroll
            for (int j = 0; j < 4; ++j) v[r][j] = xr[64 * j]; }
#pragma unroll
        for (int r = 0; r < 4; ++r) { const int mr = m + r * NGW; float s = 0.f;
#pragma unroll
            for (int j = 0; j < 4; ++j) s += (v[r][j].x * v[r][j].x + v[r][j].y * v[r][j].y) + (v[r][j].z * v[r][j].z + v[r][j].w * v[r][j].w);
            s = wave_sum(s);
            unsigned long long* o8 = (unsigned long long*)(XB + (size_t)mr * 1024) + lane;
#pragma unroll
            for (int j = 0; j < 4; ++j) o8[64 * j] = (unsigned long long)pk2(v[r][j].x, v[r][j].y) | ((unsigned long long)pk2(v[r][j].z, v[r][j].w) << 32);
            if (lane < 16) SSQ_MIX[(size_t)mr * 16 + lane] = lane == 0 ? s : 0.f; }
    }
    GSYNC();
    TSTAMP(0);

    for (int l = 0; l < NLAYER; ++l) {
#ifdef PROBE
        if (bx == 0 && tid == 0) TACC[13] = 1ull;
#endif
        const int par = l & 1;
        unsigned char* wb = ws + WS_W + (size_t)par * W_PAR;
        const float* ssq_mix = SSQ_MIX; float* ssq_ffn = SSQ_FFN;
        float* ssq_nextmix = (l + 1 < NLAYER) ? SSQ_MIX : nullptr;

#if (PHM >> 1) & 1
        {
        unsigned char* wsl = ws; asm volatile("" : "+s"(wsl));     float* SSQ_MIX = (float*)(wsl + WS_SSQ_MIX); float* SSQ_FFN = (float*)(wsl + WS_SSQ_FFN); float* LOGF = (float*)(wsl + WS_LOGF); bf16* XB = (bf16*)(wsl + WS_XB); bf16* QO = (bf16*)(wsl + WS_Q); bf16* KB = (bf16*)(wsl + WS_K); bf16* VB = (bf16*)(wsl + WS_V); bf16* MG = KB; bf16* CP = (bf16*)(wsl + WS_CP); bf16* GT = (bf16*)(wsl + WS_G); bf16* ACT = GT; unsigned* barw = (unsigned*)(wsl + WS_BAR); unsigned char* wb = wsl + WS_W + (size_t)par * W_PAR; const float* ssq_mix = SSQ_MIX; float* ssq_ffn = SSQ_FFN; float* ssq_nextmix = (l + 1 < NLAYER) ? SSQ_MIX : nullptr; (void)LOGF; (void)XB; (void)QO; (void)VB; (void)MG; (void)CP; (void)ACT; (void)barw; (void)wb; (void)ssq_mix; (void)ssq_ffn; (void)ssq_nextmix;
            const bf16* WFB = (const bf16*)(ws + WS_WF) + (size_t)par * 16384; const float* fb = args.in[3] + l * 8;
            for (int ch = gw; ch < MTOK / 16; ch += NGW) {
                const int lane = opaque_i(tid) & 63, fr = lane & 15, fq = lane >> 4, m0 = ch * 16;
                const bf16* xa = XB + (size_t)(m0 + fr) * 1024 + 8 * fq; const bf16* wbp = WFB + (size_t)fr * 1024 + 8 * fq;
                f32x4 acc = {0.f, 0.f, 0.f, 0.f};
#pragma unroll 16
                for (int kk = 0; kk < 32; ++kk) { const pg8::bf16x8 av = *(const pg8::bf16x8*)(xa + 32 * kk), bv = *(const pg8::bf16x8*)(wbp + 32 * kk);
                    acc = __builtin_amdgcn_mfma_f32_16x16x32_bf16(av, bv, acc, 0, 0, 0); }
                f32x4 tot; tot.x = acc.x + __shfl_xor(acc.x, 8); tot.y = acc.y + __shfl_xor(acc.y, 8); tot.z = acc.z + __shfl_xor(acc.z, 8); tot.w = acc.w + __shfl_xor(acc.w, 8);
                if (fr < 8) { const float fbh = fb[fr]; f32x4 lf;
#pragma unroll
                    for (int r = 0; r < 4; ++r) { const int row = m0 + 4 * fq + r; const float rr = rsqrtf(pg8::row_ssq(ssq_mix, row) * (1.0f / 1024.0f) + EPSN); const float f = tot[r] * rr + fbh;
                        lf[r] = fminf(f, 0.f) - log1pf(expf(-fabsf(f))); }
                    *(f32x4*)(LOGF + ((size_t)(m0 >> 12) * 8 + fr) * SEQ_ + (m0 & (SEQ_ - 1)) + 4 * fq) = lf; }
            }
            TSTAMP(1);
            pg8::ProbSimple P{(const char*)XB, (const char*)(wb + W_WIN), 1024, 1024, 16}; pg8::StaticOrder<1> S; S.init(MTOK, NIN, G, bx);
            build_row_scales(ldsl, S, ssq_mix, opaque_i(tid));
            pg8::EpiInProj E{(const LAS float*)(ldsl + RS_OFF), args.in[4] + l * 64, args.in[5] + l * 64, QO, KB, VB, CP, GT};
            pg8::gemm_phase<pg8::ProbSimple, pg8::EpiInProj, pg8::StaticOrder<1>, true, true>(ldsl, P, S, E);
        }
#endif
        GSYNC();
        TSTAMP(2);
#ifdef PROBE
        GSYNC(); TSTAMP(11);
#endif

#if (PHM >> 2) & 1
        {
        unsigned char* wsl = ws; asm volatile("" : "+s"(wsl));     float* SSQ_MIX = (float*)(wsl + WS_SSQ_MIX); float* SSQ_FFN = (float*)(wsl + WS_SSQ_FFN); float* LOGF = (float*)(wsl + WS_LOGF); bf16* XB = (bf16*)(wsl + WS_XB); bf16* QO = (bf16*)(wsl + WS_Q); bf16* KB = (bf16*)(wsl + WS_K); bf16* VB = (bf16*)(wsl + WS_V); bf16* MG = KB; bf16* CP = (bf16*)(wsl + WS_CP); bf16* GT = (bf16*)(wsl + WS_G); bf16* ACT = GT; unsigned* barw = (unsigned*)(wsl + WS_BAR); unsigned char* wb = wsl + WS_W + (size_t)par * W_PAR; const float* ssq_mix = SSQ_MIX; float* ssq_ffn = SSQ_FFN; float* ssq_nextmix = (l + 1 < NLAYER) ? SSQ_MIX : nullptr; (void)LOGF; (void)XB; (void)QO; (void)VB; (void)MG; (void)CP; (void)ACT; (void)barw; (void)wb; (void)ssq_mix; (void)ssq_ffn; (void)ssq_nextmix;
            if (l + 1 < NLAYER) convert_layer(args, l + 1, (l + 1) & 1, ldsl, gw, NGW, wave, lane);
            TSTAMP(3);
            {
                const float* cw = args.in[7] + (size_t)l * 3 * 256;
                const int lane = opaque_i(tid) & 63; const bool isconv = lane < 32; const int c0 = 8 * (lane & 31), g = (lane & 31) >> 3, wwin = 2 << g;
                const int R0 = vcu * 128 + wave * 16, tl0 = R0 & (SEQ_ - 1); const bool halo = tl0 != 0;
                const int colA = isconv ? c0 : 768 + c0, colB = isconv ? 512 + c0 : 768 + c0, colC = isconv ? 256 + c0 : 768 + c0;
                const f32x4 w0a = *(const f32x4*)(cw + c0), w0b = *(const f32x4*)(cw + c0 + 4), w1a = *(const f32x4*)(cw + 256 + c0), w1b = *(const f32x4*)(cw + 256 + c0 + 4), w2a = *(const f32x4*)(cw + 512 + c0), w2b = *(const f32x4*)(cw + 512 + c0 + 4);
                const v4u zero4 = {0u, 0u, 0u, 0u}; const f32x4 zf = {0.f, 0.f, 0.f, 0.f};
                v4u ring[16];
#pragma unroll
                for (int i = 0; i < 16; ++i) ring[i] = zero4;
                f32x4 S0 = zf, S1 = zf, z1a = zf, z1b = zf, z2a = zf, z2b = zf;
#pragma unroll
                for (int i = -15; i < 16; ++i) {
                    const bool valid = (i >= 0) || halo;
                    const bf16* rp = CP + (size_t)(R0 + i) * 1024;
                    v4u av = zero4; if (valid) av = *(const v4u*)(rp + colA);
                    const f32x4 u0 = pg8::bf_lo4(av.x, av.y), u1 = pg8::bf_lo4(av.z, av.w);
                    S0 += u0; S1 += u1;
                    { const v4u o2 = (i - 2 >= -15) ? ring[(i - 2 + 16) & 15] : zero4, o4 = (i - 4 >= -15) ? ring[(i - 4 + 16) & 15] : zero4, o8 = (i - 8 >= -15) ? ring[(i - 8 + 16) & 15] : zero4, o16 = (i - 16 >= -15) ? ring[(i - 16 + 16) & 15] : zero4;
                      const v4u o = g == 0 ? o2 : g == 1 ? o4 : g == 2 ? o8 : o16;
                      S0 -= pg8::bf_lo4(o.x, o.y); S1 -= pg8::bf_lo4(o.z, o.w); }
                    ring[(i + 16) & 15] = av;
                    f32x4 za = zf, zb = zf;
                    if (i >= -2) { v4u bv = zero4; if (valid) bv = *(const v4u*)(rp + colB); za = u0 * pg8::bf_lo4(bv.x, bv.y); zb = u1 * pg8::bf_lo4(bv.z, bv.w); }
                    if (i >= 0) {
                        const v4u cv = *(const v4u*)(rp + colC);
                        const f32x4 oc0 = pg8::bf_lo4(cv.x, cv.y) * (w0a * z2a + w1a * z1a + w2a * za), oc1 = pg8::bf_lo4(cv.z, cv.w) * (w0b * z2b + w1b * z1b + w2b * zb);
                        const int tl = tl0 + i, n = (tl + 1) < wwin ? (tl + 1) : wwin; const float inv = 1.0f / (float)n;
                        const f32x4 op0 = S0 * inv - u0, op1 = S1 * inv - u1;
                        *(v4u*)(CZ + (size_t)(R0 + i) * 512 + (isconv ? c0 : 256 + c0)) = pg8::pack8(isconv ? oc0 : op0, isconv ? oc1 : op1);
                    }
                    if (i >= -2) { z2a = z1a; z2b = z1b; z1a = za; z1b = zb; }
                }
            }
            TSTAMP(4);
            {
                __syncthreads();
                const int tid = opaque_i(threadIdx.x), lane = tid & 63;
                float dthr2, mref2;
                { float mq = fabsf((args.in[4] + l * 64)[lane]), mk = fabsf((args.in[5] + l * 64)[lane]);
#pragma unroll
                  for (int o = 1; o < 64; o <<= 1) { mq = fmaxf(mq, __shfl_xor(mq, o)); mk = fmaxf(mk, __shfl_xor(mk, o)); }
                  mref2 = 8.0f * 1.02f * mq * mk * LOG2E; dthr2 = 2.0f * mref2 + 26.0f * LOG2E; }
                LAS float* c2 = (LAS float*)(ldsl + attn_body::LDS_C2); LAS float* wsum = (LAS float*)(ldsl + attn_body::LDS_WSUM); volatile LAS unsigned* uq = (volatile LAS unsigned*)(ldsl + attn_body::LDS_WSUM + 32);
                unsigned* qctr = barw + 4096 + 64 * l;
                for (;;) {
                    if (tid == 0) *uq = __hip_atomic_fetch_add(qctr, 1u, __ATOMIC_RELAXED, __HIP_MEMORY_SCOPE_AGENT);
                    __syncthreads();
                    const unsigned u = *uq;
                    if (u >= (unsigned)(NB * NHEADS * (SEQ_ / 256))) break;
                    const int qb = (SEQ_ / 256 - 1) - (int)(u >> 6), bh = (int)(u & 63);
                    const f32x4* p = (const f32x4*)(LOGF + (size_t)bh * SEQ_ + tid * 8); const f32x4 a = p[0], b = p[1];
                    float v0 = a.x, v1 = v0 + a.y, v2 = v1 + a.z, v3 = v2 + a.w, v4 = v3 + b.x, v5 = v4 + b.y, v6 = v5 + b.z, v7 = v6 + b.w;
                    float sc = v7;
#pragma unroll
                    for (int o = 1; o < 64; o <<= 1) { const float y = __shfl_up(sc, o); if (lane >= o) sc += y; }
                    if (lane == 63) wsum[wave] = sc;
                    __syncthreads();
                    float off = 0.f;
#pragma unroll
                    for (int w = 0; w < 8; ++w) { const float t = wsum[w]; if (w < wave) off += t; }
                    const float e = off + sc - v7;
                    f32x4 r0 = {-(e + v0) * LOG2E, -(e + v1) * LOG2E, -(e + v2) * LOG2E, -(e + v3) * LOG2E}, r1 = {-(e + v4) * LOG2E, -(e + v5) * LOG2E, -(e + v6) * LOG2E, -(e + v7) * LOG2E};
                    *(LAS f32x4*)(c2 + tid * 8) = r0; *(LAS f32x4*)(c2 + tid * 8 + 4) = r1;
                    { LAS unsigned long long* kx = (LAS unsigned long long*)(ldsl + attn_body::LDS_KX) + tid * 8;
#pragma unroll
                      for (int j = 0; j < 8; ++j) { const float cv = j < 4 ? r0[j & 3] : r1[j & 3]; const unsigned hh = f2bf(cv); const float q1 = cv - __uint_as_float(hh << 16);
                          const unsigned mm = f2bf(q1); const float q2 = q1 - __uint_as_float(mm << 16); const unsigned ll = f2bf(q2);
                          kx[j] = (unsigned long long)(hh | (mm << 16)) | ((unsigned long long)(ll | (0x3F80u << 16)) << 32); } }
                    __syncthreads();
                    attn_body::attn_unit<8>(bh >> 3, bh & 7, qb, (const attn_body::bf16*)QO, (const attn_body::bf16*)KB, (const attn_body::bf16*)VB, (attn_body::bf16*)QO, (char*)lds, dthr2, mref2);
                }
            }
            TSTAMP(5);
        }
#endif
        GSYNC();
        TSTAMP(6);

#if (PHM >> 3) & 1
        {
        unsigned char* wsl = ws; asm volatile("" : "+s"(wsl));     float* SSQ_MIX = (float*)(wsl + WS_SSQ_MIX); float* SSQ_FFN = (float*)(wsl + WS_SSQ_FFN); float* LOGF = (float*)(wsl + WS_LOGF); bf16* XB = (bf16*)(wsl + WS_XB); bf16* QO = (bf16*)(wsl + WS_Q); bf16* KB = (bf16*)(wsl + WS_K); bf16* VB = (bf16*)(wsl + WS_V); bf16* MG = KB; bf16* CP = (bf16*)(wsl + WS_CP); bf16* GT = (bf16*)(wsl + WS_G); bf16* ACT = GT; unsigned* barw = (unsigned*)(wsl + WS_BAR); unsigned char* wb = wsl + WS_W + (size_t)par * W_PAR; const float* ssq_mix = SSQ_MIX; float* ssq_ffn = SSQ_FFN; float* ssq_nextmix = (l + 1 < NLAYER) ? SSQ_MIX : nullptr; (void)LOGF; (void)XB; (void)QO; (void)VB; (void)MG; (void)CP; (void)ACT; (void)barw; (void)wb; (void)ssq_mix; (void)ssq_ffn; (void)ssq_nextmix;
            pg8::ProbMerge P{(const char*)QO, (const char*)CZ, (const char*)(wb + W_WM), 512, 896}; pg8::StaticOrder<3> S; S.init(MTOK, 1024, G, bx);
            pg8::EpiMerge E{GT, MG};
            pg8::gemm_phase<pg8::ProbMerge, pg8::EpiMerge, pg8::StaticOrder<3>, true, true>(ldsl, P, S, E);
        }
#endif
        GSYNC();
        TSTAMP(7);

#if (PHM >> 4) & 1
        {
        unsigned char* wsl = ws; asm volatile("" : "+s"(wsl));     float* SSQ_MIX = (float*)(wsl + WS_SSQ_MIX); float* SSQ_FFN = (float*)(wsl + WS_SSQ_FFN); float* LOGF = (float*)(wsl + WS_LOGF); bf16* XB = (bf16*)(wsl + WS_XB); bf16* QO = (bf16*)(wsl + WS_Q); bf16* KB = (bf16*)(wsl + WS_K); bf16* VB = (bf16*)(wsl + WS_V); bf16* MG = KB; bf16* CP = (bf16*)(wsl + WS_CP); bf16* GT = (bf16*)(wsl + WS_G); bf16* ACT = GT; unsigned* barw = (unsigned*)(wsl + WS_BAR); unsigned char* wb = wsl + WS_W + (size_t)par * W_PAR; const float* ssq_mix = SSQ_MIX; float* ssq_ffn = SSQ_FFN; float* ssq_nextmix = (l + 1 < NLAYER) ? SSQ_MIX : nullptr; (void)LOGF; (void)XB; (void)QO; (void)VB; (void)MG; (void)CP; (void)ACT; (void)barw; (void)wb; (void)ssq_mix; (void)ssq_ffn; (void)ssq_nextmix;
            pg8::ProbSimple P{(const char*)MG, (const char*)(wb + W_WO), 1024, 1024, 16}; pg8::StaticOrder<1> S; S.init(MTOK, 1024, G, bx);
            pg8::EpiResid E{nullptr, XB, ssq_ffn};
            pg8::gemm_phase<pg8::ProbSimple, pg8::EpiResid, pg8::StaticOrder<1>, true, true>(ldsl, P, S, E);
        }
#endif
        GSYNC();
        TSTAMP(8);

#if (PHM >> 5) & 1
        {
        unsigned char* wsl = ws; asm volatile("" : "+s"(wsl));     float* SSQ_MIX = (float*)(wsl + WS_SSQ_MIX); float* SSQ_FFN = (float*)(wsl + WS_SSQ_FFN); float* LOGF = (float*)(wsl + WS_LOGF); bf16* XB = (bf16*)(wsl + WS_XB); bf16* QO = (bf16*)(wsl + WS_Q); bf16* KB = (bf16*)(wsl + WS_K); bf16* VB = (bf16*)(wsl + WS_V); bf16* MG = KB; bf16* CP = (bf16*)(wsl + WS_CP); bf16* GT = (bf16*)(wsl + WS_G); bf16* ACT = GT; unsigned* barw = (unsigned*)(wsl + WS_BAR); unsigned char* wb = wsl + WS_W + (size_t)par * W_PAR; const float* ssq_mix = SSQ_MIX; float* ssq_ffn = SSQ_FFN; float* ssq_nextmix = (l + 1 < NLAYER) ? SSQ_MIX : nullptr; (void)LOGF; (void)XB; (void)QO; (void)VB; (void)MG; (void)CP; (void)ACT; (void)barw; (void)wb; (void)ssq_mix; (void)ssq_ffn; (void)ssq_nextmix;
            pg8::ProbSimple P{(const char*)XB, (const char*)(wb + W_WFI), 1024, 1024, 16}; pg8::StaticOrder<1> S; S.init(MTOK, 2 * DFF, G, bx);
            build_row_scales(ldsl, S, ssq_ffn, opaque_i(tid));
            pg8::EpiSwiGLU E{(const LAS float*)(ldsl + RS_OFF), ACT};
            pg8::gemm_phase<pg8::ProbSimple, pg8::EpiSwiGLU, pg8::StaticOrder<1>, true, true>(ldsl, P, S, E);
        }
#endif
        GSYNC();
        TSTAMP(9);

#if (PHM >> 6) & 1
        {
        unsigned char* wsl = ws; asm volatile("" : "+s"(wsl));     float* SSQ_MIX = (float*)(wsl + WS_SSQ_MIX); float* SSQ_FFN = (float*)(wsl + WS_SSQ_FFN); float* LOGF = (float*)(wsl + WS_LOGF); bf16* XB = (bf16*)(wsl + WS_XB); bf16* QO = (bf16*)(wsl + WS_Q); bf16* KB = (bf16*)(wsl + WS_K); bf16* VB = (bf16*)(wsl + WS_V); bf16* MG = KB; bf16* CP = (bf16*)(wsl + WS_CP); bf16* GT = (bf16*)(wsl + WS_G); bf16* ACT = GT; unsigned* barw = (unsigned*)(wsl + WS_BAR); unsigned char* wb = wsl + WS_W + (size_t)par * W_PAR; const float* ssq_mix = SSQ_MIX; float* ssq_ffn = SSQ_FFN; float* ssq_nextmix = (l + 1 < NLAYER) ? SSQ_MIX : nullptr; (void)LOGF; (void)XB; (void)QO; (void)VB; (void)MG; (void)CP; (void)ACT; (void)barw; (void)wb; (void)ssq_mix; (void)ssq_ffn; (void)ssq_nextmix;
            pg8::ProbSimple P{(const char*)ACT, (const char*)(wb + W_WFO), DFF, DFF, DFF / 64}; pg8::StaticOrder<1> S; S.init(MTOK, 1024, G, bx);
            pg8::EpiResid E{(l + 1 < NLAYER) ? nullptr : out, XB, ssq_nextmix};
            pg8::gemm_phase<pg8::ProbSimple, pg8::EpiResid, pg8::StaticOrder<1>, true, true>(ldsl, P, S, E);
        }
#endif
        if (l + 1 < NLAYER) GSYNC();
        TSTAMP(10);
    }
#ifdef PROBE
    GSYNC();
    if (bx == 0 && tid == 0) out[0] += (float)TACC[PROBE] * 0.0005f;
#endif
}

extern "C" void kernel_launch(void* const* d_in, const int* in_sizes, int n_in, void* d_out, int out_size, void* d_ws, size_t ws_size, hipStream_t stream) {
    static int grid = 0;
    if (grid == 0) {
        if (n_in != 15 || out_size != MTOK * DMODEL || ws_size < WS_END) { fprintf(stderr, "kernel_launch: unexpected shapes (n_in %d out %d ws %zu)\n", n_in, out_size, ws_size); grid = -1; return; }
        int dev = 0, cus = 0, per_cu = 0;
        hipGetDevice(&dev); hipDeviceGetAttribute(&cus, hipDeviceAttributeMultiprocessorCount, dev);
        if (hipFuncSetAttribute((const void*)fwd_kernel, hipFuncAttributeMaxDynamicSharedMemorySize, LDS_BYTES) != hipSuccess) { fprintf(stderr, "kernel_launch: hipFuncSetAttribute failed\n"); grid = -1; return; }
        if (hipOccupancyMaxActiveBlocksPerMultiprocessor(&per_cu, (const void*)fwd_kernel, NWAVES * 64, LDS_BYTES) != hipSuccess || per_cu < 1) { fprintf(stderr, "kernel_launch: occupancy query says %d\n", per_cu); per_cu = 1; }
        (void)hipGetLastError();
        grid = cus;
        if (grid != 256) fprintf(stderr, "kernel_launch: %d CUs (built for 256)\n", grid);
    }
    if (grid < 0) return;
    (void)hipMemsetAsync((char*)d_ws + WS_BAR, 0, (4096 + 4 * 64) * 4, stream);
    Args a{};
    for (int i = 0; i < 15; ++i) a.in[i] = (const float*)d_in[i];
    a.out = (float*)d_out; a.ws = (unsigned char*)d_ws;
    void* kargs[] = {&a};
    hipError_t e = hipLaunchCooperativeKernel((const void*)fwd_kernel, dim3(grid), dim3(NWAVES * 64), kargs, LDS_BYTES, stream);
    if (e != hipSuccess) fprintf(stderr, "cooperative launch failed: %s (grid %d)\n", hipGetErrorString(e), grid);
}
```

```cpp
#include <hip/hip_runtime.h>
#include <hip/hip_cooperative_groups.h>
#include <hip/hip_bf16.h>
#include <cstdio>
#include <cstdint>
#include <cmath>
namespace cg = cooperative_groups;

#ifndef PHM
#define PHM 0xff
#endif
constexpr int NB = 8, SEQ_ = 4096, DMODEL = 1024, NLAYER = 4;
constexpr int MTOK = NB * SEQ_;
constexpr int DATT = 512, NHEADS = 8, DCONV = 256, DPOOL = 256, DFF = 2816;
constexpr int DIN_SRC = 5640;
constexpr int NIN = 5632;
constexpr float EPSN = 1e-6f;
constexpr float LOG2E = 1.4426950408889634f;
constexpr float QSCALE = 0.125f * LOG2E;

__device__ __forceinline__ int opaque_i(int v) { asm volatile("" : "+v"(v)); return v; }
namespace pg8 {
#define PG8_LAS __attribute__((address_space(3)))
typedef unsigned short bf16_t;
typedef short bf16x8 __attribute__((ext_vector_type(8)));
typedef float f32x4 __attribute__((ext_vector_type(4)));
typedef unsigned u32x4 __attribute__((ext_vector_type(4)));
constexpr int BM = 256, BK = 64, HALF = 128, HTB = HALF * BK * 2, STAGE_BYTES = 8 * HTB, NXCD = 8, WGM = 8;

__host__ __device__ __forceinline__ int lds_byte(int r, int c) { const int st = (r >> 4) * 2 + (c >> 5), rr = r & 15, cc = c & 31, ob = rr * 64 + cc * 2; return st * 1024 + (ob ^ (((ob >> 9) & 1) << 5)); }
__host__ __device__ __forceinline__ void stage_rc(int b, int& R, int& C) { const int st = b / 1024, sb = b % 1024, swz = sb ^ (((sb >> 9) & 1) << 5); R = (st >> 1) * 16 + swz / 64; C = (st & 1) * 32 + (swz % 64) / 2; }
__host__ __device__ __forceinline__ int perm32(int rho) { const int n = rho >> 4, i = rho & 15; return 8 * (i >> 2) + 4 * n + (i & 3); }

struct Unit { int pm, pn, sub, idx; };
struct UMem { const char* A; const char* B; int nt; };

template <int NSUB> struct StaticOrder {
    int nM, nN, nwg, G, c;
    __device__ void init(int M, int N, int G_, int c_) { nM = M / BM; nN = N / BM; nwg = nM * nN; G = G_; c = c_; }
    __device__ bool next(int i, Unit& u) const {
        const int it = i / NSUB; u.sub = i - it * NSUB; u.idx = it;
        const long L = (long)it * G + c; if (L >= nwg) return false;
        int wgid = (int)L; { const int q = nwg / NXCD, r = nwg % NXCD, xcd = wgid % NXCD, off = wgid / NXCD; wgid = (xcd < r ? xcd * (q + 1) : r * (q + 1) + (xcd - r) * q) + off; }
        const int nig = WGM * nN, gid = wgid / nig, fm = gid * WGM, gsz = (nM - fm) < WGM ? (nM - fm) : WGM;
        u.pm = fm + ((wgid % nig) % gsz); u.pn = (wgid % nig) / gsz; return true;
    }
};

__device__ __forceinline__ unsigned cvt_pk_bf16(float lo, float hi) { unsigned r; asm volatile("v_cvt_pk_bf16_f32 %0, %1, %2" : "=v"(r) : "v"(lo), "v"(hi)); return r; }
__device__ __forceinline__ f32x4 bf_lo4(unsigned a, unsigned b) { return (f32x4){__uint_as_float(a << 16), __uint_as_float(a & 0xffff0000u), __uint_as_float(b << 16), __uint_as_float(b & 0xffff0000u)}; }
__device__ __forceinline__ u32x4 pack8(f32x4 v0, f32x4 v1) { u32x4 w; w.x = cvt_pk_bf16(v0[0], v0[1]); w.y = cvt_pk_bf16(v0[2], v0[3]); w.z = cvt_pk_bf16(v1[0], v1[1]); w.w = cvt_pk_bf16(v1[2], v1[3]); return w; }
__device__ __forceinline__ float row_ssq(const float* p, int row) { const f32x4* q = (const f32x4*)(p + (size_t)row * 16); const f32x4 s = (q[0] + q[1]) + (q[2] + q[3]); return (s[0] + s[1]) + (s[2] + s[3]); }
__device__ __forceinline__ float row_ssq_q(const float* p, int row, int fq) { const f32x4 v = *(const f32x4*)(p + (size_t)row * 16 + 4 * fq); float s = (v[0] + v[1]) + (v[2] + v[3]); s += __shfl_xor(s, 16); s += __shfl_xor(s, 32); return s; }
__device__ __forceinline__ float fast_sigmoid(float v) { return __builtin_amdgcn_rcpf(1.0f + __expf(-v)); }


struct EpiInProj {
    const PG8_LAS float* RS; const float* qg; const float* kg; bf16_t* Q; bf16_t* Kb; bf16_t* V; bf16_t* CP; bf16_t* G;
    __device__ __forceinline__ bool keep(const Unit&) const { return false; }
    __device__ __forceinline__ void operator()(f32x4 (&acc)[2][2][4][2], const Unit& u, int wr, int wc, int fr, int fq) const {
        const int pn = u.pn; bf16_t* base; int ld, colt, mode; float post = 1.f; const float* gain = qg;
        if (pn < 2) { base = Q; ld = 512; colt = pn * 256; mode = 1; post = QSCALE; gain = qg; }
        else if (pn < 4) { base = Kb; ld = 512; colt = (pn - 2) * 256; mode = 1; gain = kg; }
        else if (pn < 6) { base = V; ld = 512; colt = (pn - 4) * 256; mode = 0; }
        else if (pn < 10) { base = CP; ld = 1024; colt = (pn - 6) * 256; mode = 0; }
        else { base = G; ld = 3072; colt = (pn - 10) * 256; mode = 2; }
        const int row0 = u.pm * BM + wr * 64 + fr, colw = colt + 64 * wc + 8 * fq;
        f32x4 gv[2][2];
#pragma unroll
        for (int bj = 0; bj < 2; ++bj)
#pragma unroll
            for (int n = 0; n < 2; ++n) gv[bj][n] = *(const f32x4*)(gain + 32 * bj + 8 * fq + 4 * n) * post;
        const PG8_LAS float* rsp = RS + u.idx * BM + wr * 64 + fr;
#pragma unroll
        for (int ai = 0; ai < 2; ++ai) {
#pragma unroll
            for (int m = 0; m < 4; ++m) {
                const int row = row0 + ai * HALF + m * 16;
                const float r = rsp[ai * HALF + m * 16];
                f32x4 v[2][2];
#pragma unroll
                for (int bj = 0; bj < 2; ++bj)
#pragma unroll
                    for (int n = 0; n < 2; ++n) v[bj][n] = acc[ai][bj][m][n] * r;
                if (mode == 1) {
                    float s = 0.f;
#pragma unroll
                    for (int bj = 0; bj < 2; ++bj)
#pragma unroll
                        for (int n = 0; n < 2; ++n) { const f32x4 x = v[bj][n]; s += (x[0] * x[0] + x[1] * x[1]) + (x[2] * x[2] + x[3] * x[3]); }
                    s += __shfl_xor(s, 16); s += __shfl_xor(s, 32);
                    const float rn = rsqrtf(s * (1.0f / 64.0f) + EPSN);
#pragma unroll
                    for (int bj = 0; bj < 2; ++bj)
#pragma unroll
                        for (int n = 0; n < 2; ++n) v[bj][n] = v[bj][n] * rn * gv[bj][n];
                } else if (mode == 2) {
#pragma unroll
                    for (int bj = 0; bj < 2; ++bj)
#pragma unroll
                        for (int n = 0; n < 2; ++n) { f32x4 x = v[bj][n];
                            x[0] = fminf(__expf(-x[0]), 1e30f); x[1] = fminf(__expf(-x[1]), 1e30f); x[2] = fminf(__expf(-x[2]), 1e30f); x[3] = fminf(__expf(-x[3]), 1e30f); v[bj][n] = x; }
                }
                bf16_t* rowp = base + (size_t)row * ld + colw;
#pragma unroll
                for (int bj = 0; bj < 2; ++bj) *(u32x4*)(rowp + 32 * bj) = pack8(v[bj][0], v[bj][1]);
            }
        }
    }
};

struct EpiMerge {
    const bf16_t* G; bf16_t* Mg;
    __device__ __forceinline__ bool keep(const Unit& u) const { return u.sub < 2; }
    __device__ __forceinline__ void operator()(f32x4 (&acc)[2][2][4][2], const Unit& u, int wr, int wc, int fr, int fq) const {
        const int row0 = u.pm * BM + wr * 64 + fr, col0 = u.pn * BM + wc * 32 + 8 * fq, sub = u.sub;
        const bf16_t* gbase = G + (size_t)row0 * 3072 + col0 + (sub == 0 ? 0 : sub == 1 ? 1024 : 2048);
#pragma unroll
        for (int aih = 0; aih < 4; ++aih) { const int ai = aih >> 1, mlo = (aih & 1) * 2;
            u32x4 ga[4][2], gb[4][2];
#pragma unroll
            for (int m = mlo; m < mlo + 2; ++m)
#pragma unroll
                for (int bj = 0; bj < 2; ++bj) { const bf16_t* gp = gbase + (size_t)(ai * HALF + m * 16) * 3072 + bj * HALF;
                    ga[m][bj] = *(const u32x4*)gp; gb[m][bj] = ga[m][bj]; if (sub < 2) gb[m][bj] = *(const u32x4*)(gp + 1024); }
#pragma unroll
            for (int m = mlo; m < mlo + 2; ++m) {
                const int row = row0 + ai * HALF + m * 16;
#pragma unroll
                for (int bj = 0; bj < 2; ++bj) {
                    f32x4 f0 = bf_lo4(ga[m][bj].x, ga[m][bj].y) + 1.0f, f1 = bf_lo4(ga[m][bj].z, ga[m][bj].w) + 1.0f;
#pragma unroll
                    for (int j = 0; j < 4; ++j) { f0[j] = __builtin_amdgcn_rcpf(f0[j]); f1[j] = __builtin_amdgcn_rcpf(f1[j]); }
                    if (sub < 2) {
                        const f32x4 d0 = bf_lo4(gb[m][bj].x, gb[m][bj].y) + 1.0f, d1 = bf_lo4(gb[m][bj].z, gb[m][bj].w) + 1.0f;
                        acc[ai][bj][m][0] *= f0 * d0; acc[ai][bj][m][1] *= f1 * d1;
                    } else {
                        *(u32x4*)(Mg + (size_t)row * 1024 + col0 + bj * HALF) = pack8(acc[ai][bj][m][0] * f0, acc[ai][bj][m][1] * f1);
                    }
                }
            }
        }
    }
};

struct EpiResid {
    float* out; bf16_t* XB; float* ssq_next;
    __device__ __forceinline__ bool keep(const Unit&) const { return false; }
    __device__ __forceinline__ void operator()(f32x4 (&acc)[2][2][4][2], const Unit& u, int wr, int wc, int fr, int fq) const {
        char* xu = (char*)(XB + (size_t)(u.pm * BM + wr * 64) * 1024 + u.pn * BM + wc * 32);
        const unsigned xl = (unsigned)(fr * 1024 + 8 * fq) * 2u;
        const int row0 = u.pm * BM + wr * 64 + fr, col0 = u.pn * BM + wc * 32 + 8 * fq;
        u32x4 xo[2][4][2];
#pragma unroll
        for (int ai = 0; ai < 2; ++ai)
#pragma unroll
            for (int m = 0; m < 4; ++m)
#pragma unroll
                for (int bj = 0; bj < 2; ++bj) xo[ai][m][bj] = *(const u32x4*)(xu + (size_t)(ai * HALF + m * 16) * 2048 + bj * 256 + xl);
#pragma unroll
        for (int ai = 0; ai < 2; ++ai) {
#pragma unroll
            for (int m = 0; m < 4; ++m) {
                const int row = row0 + ai * HALF + m * 16; const size_t off = (size_t)row * 1024 + col0;
                float s = 0.f;
#pragma unroll
                for (int bj = 0; bj < 2; ++bj) {
                    const u32x4 xv = xo[ai][m][bj];
                    const f32x4 x0 = bf_lo4(xv.x, xv.y) + acc[ai][bj][m][0], x1 = bf_lo4(xv.z, xv.w) + acc[ai][bj][m][1];
                    if (out) { *(f32x4*)(out + off + bj * HALF) = x0; *(f32x4*)(out + off + bj * HALF + 4) = x1; }
                    else *(u32x4*)(xu + (size_t)(ai * HALF + m * 16) * 2048 + bj * 256 + xl) = pack8(x0, x1);
                    s += (x0[0] * x0[0] + x0[1] * x0[1]) + (x0[2] * x0[2] + x0[3] * x0[3]) + (x1[0] * x1[0] + x1[1] * x1[1]) + (x1[2] * x1[2] + x1[3] * x1[3]);
                }
                if (ssq_next) { s += __shfl_xor(s, 16); s += __shfl_xor(s, 32); if (fq == 0) ssq_next[(size_t)row * 16 + u.pn * 4 + wc] = s; }
            }
        }
    }
};

struct EpiSwiGLU {
    const PG8_LAS float* RS; bf16_t* ACT;
    __device__ __forceinline__ bool keep(const Unit&) const { return false; }
    __device__ __forceinline__ void operator()(f32x4 (&acc)[2][2][4][2], const Unit& u, int wr, int wc, int fr, int fq) const {
        const int row0 = u.pm * BM + wr * 64 + fr, col0 = u.pn * HALF + wc * 32 + 8 * fq;
        const PG8_LAS float* rsp = RS + u.idx * BM + wr * 64 + fr;
#pragma unroll
        for (int ai = 0; ai < 2; ++ai)
#pragma unroll
            for (int m = 0; m < 4; ++m) {
                const int row = row0 + ai * HALF + m * 16;
                const float r = rsp[ai * HALF + m * 16];
                f32x4 o[2];
#pragma unroll
                for (int n = 0; n < 2; ++n) { const f32x4 g = acc[ai][0][m][n] * r, up = acc[ai][1][m][n] * r;
#pragma unroll
                    for (int j = 0; j < 4; ++j) o[n][j] = g[j] * fast_sigmoid(g[j]) * up[j]; }
                *(u32x4*)(ACT + (size_t)row * DFF + col0) = pack8(o[0], o[1]);
            }
    }
};

struct ProbSimple { const char* A; const char* B; int lda, ldb, nt;
    __device__ __forceinline__ UMem mem(const Unit& u) const { UMem m; m.A = A + (size_t)u.pm * BM * lda * 2; m.B = B + (size_t)u.pn * BM * ldb * 2; m.nt = nt; return m; } };
struct ProbMerge { const char* O; const char* CZ; const char* WM; int lda, ldb;
    __device__ __forceinline__ UMem mem(const Unit& u) const { UMem m; const size_t ar = (size_t)u.pm * BM * 512 * 2, br = (size_t)u.pn * BM * 896 * 2;
        if (u.sub == 0) { m.A = O + ar; m.B = WM + br; m.nt = 8; }
        else if (u.sub == 1) { m.A = CZ + ar; m.B = WM + br + 512 * 2; m.nt = 4; }
        else { m.A = CZ + ar + (256 + 128 * (u.pn >> 1)) * 2; m.B = WM + br + 768 * 2; m.nt = 2; }
        return m; } };

template <class Prob, class Epi, class Sched, bool ALIGN_EPI, bool SP2>
__device__ __forceinline__ void gemm_phase(PG8_LAS unsigned char* lds, const Prob& P, const Sched& S, const Epi& E) {
    const int tid = opaque_i(threadIdx.x), wid = __builtin_amdgcn_readfirstlane(tid >> 6), lane = tid & 63, wr = wid >> 2, wc = wid & 3, fr = lane & 15, fq = lane >> 4;
    unsigned voffA[2], voffB[2];
#pragma unroll
    for (int i = 0; i < 2; ++i) { int R, C; stage_rc(tid * 16 + i * 8192, R, C); const int Rb = (R & ~31) + perm32(R & 31);
        voffA[i] = (unsigned)(R * P.lda + C) * 2u; voffB[i] = (unsigned)(Rb * P.ldb + C) * 2u; }
    const size_t kstep = (size_t)(BK * 2);
    const size_t hstepA = (size_t)HALF * P.lda * 2, hstepB = (size_t)HALF * P.ldb * 2;
    const unsigned ldsw = (unsigned)wid * 1024u;
    const int aoff = lds_byte(wr * 64 + fr, fq * 8), boff = lds_byte(wc * 32 + fr, fq * 8);
#define PG8_SA(b, h) (((b) * 2 + (h)) * HTB)
#define PG8_SB(b, h) ((4 + (b) * 2 + (h)) * HTB)
#define PG8_STAGE(bufoff, gbase, voff) do { _Pragma("unroll") for (int _i = 0; _i < 2; ++_i) \
        __builtin_amdgcn_global_load_lds((const unsigned*)((const char*)(gbase) + (voff)[_i]), (PG8_LAS unsigned*)(lds + (bufoff) + ldsw + _i * 8192), 16, 0, 0); } while (0)
#define PG8_LDA(dst, b, h) do { _Pragma("unroll") for (int m = 0; m < 4; ++m) _Pragma("unroll") for (int k = 0; k < 2; ++k) dst[m][k] = *(const PG8_LAS bf16x8*)(lds + PG8_SA(b, h) + aoff + m * 2048 + k * 1024); } while (0)
#define PG8_LDB(dst, b, h) do { _Pragma("unroll") for (int n = 0; n < 2; ++n) _Pragma("unroll") for (int k = 0; k < 2; ++k) dst[n][k] = *(const PG8_LAS bf16x8*)(lds + PG8_SB(b, h) + boff + n * 2048 + k * 1024); } while (0)
#define PG8_MMA(ai, bj, At, Bt) do { __builtin_amdgcn_s_setprio(1); _Pragma("unroll") for (int m = 0; m < 4; ++m) _Pragma("unroll") for (int n = 0; n < 2; ++n) _Pragma("unroll") for (int k = 0; k < 2; ++k) \
        acc[ai][bj][m][n] = __builtin_amdgcn_mfma_f32_16x16x32_bf16(Bt[n][k], At[m][k], acc[ai][bj][m][n], 0, 0, 0); __builtin_amdgcn_s_setprio(0); } while (0)
#define PG8_WAIT_V(n) asm volatile("s_waitcnt vmcnt(" #n ")" ::: "memory")
#define PG8_WAIT_L(n) asm volatile("s_waitcnt lgkmcnt(" #n ")" ::: "memory")
#define PG8_BAR __builtin_amdgcn_s_barrier()
#define PG8_SCHED __builtin_amdgcn_sched_barrier(0)
    Unit cur, nxt; int ui = 0;
    if (!S.next(0, cur)) return;
    f32x4 acc[2][2][4][2];
#pragma unroll
    for (int a = 0; a < 2; ++a)
#pragma unroll
        for (int b = 0; b < 2; ++b)
#pragma unroll
            for (int m = 0; m < 4; ++m)
#pragma unroll
                for (int n = 0; n < 2; ++n) acc[a][b][m][n] = (f32x4){0.f, 0.f, 0.f, 0.f};
    bf16x8 At[4][2], B0[2][2], B1[2][2];
    UMem cm = P.mem(cur);
    const char* cA = cm.A; const char* cB = cm.B; int nt = cm.nt;
    if constexpr (SP2) {
        PG8_STAGE(PG8_SB(0, 0), cB, voffB); PG8_STAGE(PG8_SB(0, 1), cB + hstepB, voffB); PG8_STAGE(PG8_SA(0, 0), cA, voffA); PG8_STAGE(PG8_SA(0, 1), cA + hstepA, voffA);
        if (wr == 1) PG8_BAR;
        PG8_WAIT_V(2); PG8_BAR;
        PG8_STAGE(PG8_SB(1, 0), cB + kstep, voffB); PG8_STAGE(PG8_SA(1, 0), cA + kstep, voffA); PG8_STAGE(PG8_SB(1, 1), cB + hstepB + kstep, voffB);
        PG8_WAIT_V(6); PG8_BAR;
    } else {
        PG8_STAGE(PG8_SB(0, 0), cB, voffB); PG8_STAGE(PG8_SA(0, 0), cA, voffA); PG8_STAGE(PG8_SB(0, 1), cB + hstepB, voffB); PG8_STAGE(PG8_SA(0, 1), cA + hstepA, voffA);
        if (wr == 1) PG8_BAR;
        PG8_WAIT_V(4); PG8_BAR;
        PG8_STAGE(PG8_SB(1, 0), cB + kstep, voffB); PG8_STAGE(PG8_SA(1, 0), cA + kstep, voffA); PG8_STAGE(PG8_SB(1, 1), cB + hstepB + kstep, voffB);
        PG8_WAIT_V(6); PG8_BAR;
    }
    for (;;) {
        const bool has_next = S.next(ui + 1, nxt);
        UMem nm = cm; if (has_next) nm = P.mem(nxt);
        const char* nA = has_next ? nm.A : cA; const char* nB = has_next ? nm.B : cB;
        for (int t = 0; t < nt; t += 2) {
            const bool last = (t == nt - 2);
            const char* a1 = cA + (size_t)(t + 1) * kstep;
            const char* a2 = last ? nA : cA + (size_t)(t + 2) * kstep; const char* b2 = last ? nB : cB + (size_t)(t + 2) * kstep;
            const char* a3 = a2 + kstep; const char* b3 = b2 + kstep;
            if constexpr (SP2) {
            PG8_LDB(B0, 0, 0); PG8_LDB(B1, 0, 1); PG8_SCHED; PG8_LDA(At, 0, 0); PG8_STAGE(PG8_SA(1, 1), a1 + hstepA, voffA);
            PG8_WAIT_V(8); PG8_WAIT_L(0); PG8_BAR; PG8_MMA(0, 0, At, B0); PG8_MMA(0, 1, At, B1); PG8_BAR; PG8_SCHED;
            PG8_LDA(At, 0, 1); PG8_STAGE(PG8_SB(0, 0), b2, voffB); PG8_STAGE(PG8_SB(0, 1), b2 + hstepB, voffB); PG8_STAGE(PG8_SA(0, 0), a2, voffA);
            PG8_WAIT_V(8); PG8_WAIT_L(0); PG8_BAR; PG8_MMA(1, 0, At, B0); PG8_MMA(1, 1, At, B1); PG8_BAR; PG8_SCHED;
            PG8_LDB(B0, 1, 0); PG8_LDB(B1, 1, 1); PG8_SCHED; PG8_LDA(At, 1, 0); PG8_STAGE(PG8_SA(0, 1), a2 + hstepA, voffA);
            PG8_WAIT_V(8); PG8_WAIT_L(0); PG8_BAR; PG8_MMA(0, 0, At, B0); PG8_MMA(0, 1, At, B1); PG8_BAR; PG8_SCHED;
            PG8_LDA(At, 1, 1); PG8_STAGE(PG8_SB(1, 0), b3, voffB); PG8_STAGE(PG8_SB(1, 1), b3 + hstepB, voffB); PG8_STAGE(PG8_SA(1, 0), a3, voffA);
            PG8_WAIT_V(8); PG8_WAIT_L(0); PG8_BAR; PG8_MMA(1, 0, At, B0); PG8_MMA(1, 1, At, B1); PG8_BAR; PG8_SCHED;
            } else {
            PG8_LDB(B0, 0, 0); PG8_SCHED; PG8_LDA(At, 0, 0); PG8_STAGE(PG8_SA(1, 1), a1 + hstepA, voffA);
            PG8_WAIT_L(8); PG8_BAR; PG8_WAIT_L(0); PG8_MMA(0, 0, At, B0); PG8_BAR; PG8_SCHED;
            PG8_LDB(B1, 0, 1); PG8_STAGE(PG8_SB(0, 0), b2, voffB);
            PG8_BAR; PG8_WAIT_L(0); PG8_MMA(0, 1, At, B1); PG8_BAR;
            PG8_LDA(At, 0, 1); PG8_STAGE(PG8_SA(0, 0), a2, voffA);
            PG8_BAR; PG8_WAIT_L(0); PG8_MMA(1, 0, At, B0); PG8_BAR; PG8_SCHED;
            PG8_STAGE(PG8_SB(0, 1), b2 + hstepB, voffB);
            PG8_WAIT_V(6); PG8_BAR; PG8_MMA(1, 1, At, B1); PG8_BAR;
            PG8_LDB(B0, 1, 0); PG8_SCHED; PG8_LDA(At, 1, 0); PG8_STAGE(PG8_SA(0, 1), a2 + hstepA, voffA);
            PG8_WAIT_L(8); PG8_BAR; PG8_WAIT_L(0); PG8_MMA(0, 0, At, B0); PG8_BAR; PG8_SCHED;
            PG8_LDB(B1, 1, 1); PG8_STAGE(PG8_SB(1, 0), b3, voffB);
            PG8_BAR; PG8_WAIT_L(0); PG8_MMA(0, 1, At, B1); PG8_BAR;
            PG8_LDA(At, 1, 1); PG8_STAGE(PG8_SA(1, 0), a3, voffA);
            PG8_BAR; PG8_WAIT_L(0); PG8_MMA(1, 0, At, B0); PG8_BAR; PG8_SCHED;
            PG8_STAGE(PG8_SB(1, 1), b3 + hstepB, voffB);
            PG8_WAIT_V(6); PG8_BAR; PG8_MMA(1, 1, At, B1); PG8_BAR;
            }
        }
        if constexpr (ALIGN_EPI) { if (wr == 0) PG8_BAR; }
        E(acc, cur, wr, wc, fr, fq);
        if (!has_next) break;
        if (!E.keep(cur)) {
#pragma unroll
        for (int a = 0; a < 2; ++a)
#pragma unroll
            for (int b = 0; b < 2; ++b)
#pragma unroll
                for (int m = 0; m < 4; ++m)
#pragma unroll
                    for (int n = 0; n < 2; ++n) acc[a][b][m][n] = (f32x4){0.f, 0.f, 0.f, 0.f};
        }
        cur = nxt; cm = nm; cA = nA; cB = nB; nt = nm.nt; ++ui;
        if constexpr (ALIGN_EPI) { if (wr == 1) PG8_BAR; }
    }
    PG8_WAIT_V(0);
    if constexpr (!ALIGN_EPI) { if (wr == 0) PG8_BAR; }
    PG8_BAR;
#undef PG8_SA
#undef PG8_SB
#undef PG8_STAGE
#undef PG8_LDA
#undef PG8_LDB
#undef PG8_MMA
#undef PG8_WAIT_V
#undef PG8_WAIT_L
#undef PG8_BAR
#undef PG8_SCHED
}
}
namespace attn_body {
using bf16=__hip_bfloat16;
using bf16x8=__attribute__((ext_vector_type(8)))short;
using s16x4=__attribute__((ext_vector_type(4)))short;
using f32x16=__attribute__((ext_vector_type(16)))float;
using u32x4=__attribute__((ext_vector_type(4)))unsigned;
using f32x4v=__attribute__((ext_vector_type(4)))float;
constexpr int BATCH=8,NHEAD=8,SEQ=4096,D=64,DM=NHEAD*D;
constexpr int NW=8,QBLK=32,QB=QBLK*NW,KVBLK=64,NQB=SEQ/QB;
constexpr int ATTN_PITCH=DM, ATTN_UNIT_ROWS=QB;
__device__ __forceinline__ int crow(int r,int hi){return (r&3)+8*(r>>2)+4*hi;}
#define SBAR() __builtin_amdgcn_sched_barrier(0)
__device__ __forceinline__ void cmask(f32x16&p0,f32x16&p1,int jb,int qrel,int hi){
  const float NEG=-INFINITY; int kb=64*jb+4*hi;
  #pragma unroll
  for(int r=0;r<16;++r){int kv=kb+(r&3)+8*(r>>2); if(kv>qrel)p0[r]=NEG; if(kv+32>qrel)p1[r]=NEG;}
}

constexpr int NSLOT=3, SLOTB=8192;
constexpr int LDS_K=0, LDS_V=NSLOT*SLOTB, LDS_WS=2*NSLOT*SLOTB, LDS_OST=LDS_WS+NW*64*4, LDS_C2=LDS_OST+NW*4096, LDS_WSUM=LDS_C2+SEQ*4, LDS_KX=LDS_WSUM+64, LDS_BYTES=LDS_KX+SEQ*8;
constexpr float C2=0.125f*1.4426950408889634f;
__device__ __forceinline__ void glds16(const void*gsrc,unsigned lds_dst){unsigned keep;
  asm volatile("s_mov_b32 %0, m0\n\ts_mov_b32 m0, %2\n\ts_nop 0\n\tglobal_load_lds_dwordx4 %1, off\n\ts_mov_b32 m0, %0":"=&s"(keep):"v"(gsrc),"s"(lds_dst):"memory");}
__device__ __forceinline__ float max3f(float a,float b,float c){float r;asm("v_max3_f32 %0, %1, %2, %3":"=v"(r):"v"(a),"v"(b),"v"(c));return r;}
__device__ __forceinline__ float max2f(float a,float b){float r;asm("v_max_f32_e32 %0, %1, %2":"=v"(r):"v"(a),"v"(b));return r;}
__device__ __forceinline__ float fadd_s(float a,float b){float r;asm("v_add_f32_e32 %0, %1, %2":"=v"(r):"v"(a),"v"(b));return r;}
__device__ __forceinline__ float fsub_s(float a,float b){float r;asm("v_sub_f32_e32 %0, %1, %2":"=v"(r):"v"(a),"v"(b));return r;}
typedef float f32x2_t __attribute__((ext_vector_type(2))); typedef __bf16 bf16x2_t __attribute__((ext_vector_type(2)));
__device__ __forceinline__ unsigned cvtpk_s(float lo,float hi){f32x2_t v={lo,hi};bf16x2_t b=__builtin_convertvector(v,bf16x2_t);return __builtin_bit_cast(unsigned,b);}
#define WAIT_BAR(N) asm volatile("s_waitcnt vmcnt(" #N ") lgkmcnt(0)\n\ts_barrier":::"memory")

__device__ __forceinline__ void qkt(f32x16&p0,f32x16&p1,const char*Kslot,const bf16x8*qr,int r32,int hi){
  const char*kb=Kslot+hi*1024+r32*16;
  #pragma unroll
  for(int d0=0;d0<4;++d0){
    const bf16x8 b0=*reinterpret_cast<const bf16x8*>(kb+d0*2048);
    const bf16x8 b1=*reinterpret_cast<const bf16x8*>(kb+d0*2048+512);
    {p0=__builtin_amdgcn_mfma_f32_32x32x16_bf16(b0,qr[d0],p0,0,0,0);p1=__builtin_amdgcn_mfma_f32_32x32x16_bf16(b1,qr[d0],p1,0,0,0);}}
}
typedef __attribute__((address_space(3))) const char* lds_cptr;
typedef short v4i16_t __attribute__((ext_vector_type(4)));
__device__ __forceinline__ void kload8(bf16x8*kf,lds_cptr kp){
  kf[0]=*(const __attribute__((address_space(3))) bf16x8*)(kp);      kf[1]=*(const __attribute__((address_space(3))) bf16x8*)(kp+512);
  kf[2]=*(const __attribute__((address_space(3))) bf16x8*)(kp+2048); kf[3]=*(const __attribute__((address_space(3))) bf16x8*)(kp+2560);
  kf[4]=*(const __attribute__((address_space(3))) bf16x8*)(kp+4096); kf[5]=*(const __attribute__((address_space(3))) bf16x8*)(kp+4608);
  kf[6]=*(const __attribute__((address_space(3))) bf16x8*)(kp+6144); kf[7]=*(const __attribute__((address_space(3))) bf16x8*)(kp+6656);
}
__device__ __forceinline__ void kload2(bf16x8*kf,lds_cptr kp,int j){ kf[2*j]=*(const __attribute__((address_space(3))) bf16x8*)(kp+j*2048); kf[2*j+1]=*(const __attribute__((address_space(3))) bf16x8*)(kp+j*2048+512); }
__device__ __forceinline__ s16x4 vtr(lds_cptr p){ return __builtin_bit_cast(s16x4,__builtin_amdgcn_ds_read_tr16_b64_v4i16((__attribute__((address_space(3))) v4i16_t*)p)); }
__device__ __forceinline__ float rowmax(const f32x16&p0,const f32x16&p1){
  float a=max3f(p0[0],p0[1],p1[0]),b=max3f(p0[2],p0[3],p1[1]);a=max3f(a,p1[2],p1[3]);
  #pragma unroll
  for(int r=4;r<16;r+=4){a=max3f(a,p0[r],p0[r+1]);b=max3f(b,p0[r+2],p0[r+3]);a=max3f(a,p1[r],p1[r+1]);b=max3f(b,p1[r+2],p1[r+3]);}
  const float m=max2f(a,b);
  auto rr=__builtin_amdgcn_permlane32_swap(__float_as_uint(m),__float_as_uint(m),false,false);
  return max2f(__uint_as_float(rr[0]),__uint_as_float(rr[1]));
}
__device__ __forceinline__ void pv(f32x16*o,int vb,bf16x8 pa0,bf16x8 pa1,bf16x8 pa2,bf16x8 pa3){
  #pragma unroll
  for(int d0=0;d0<2;++d0){s16x4 lo[4],hi[4];
    #pragma unroll
    for(int ks=0;ks<4;++ks){
      asm volatile("ds_read_b64_tr_b16 %0,%1 offset:%c2":"=&v"(lo[ks]):"v"(vb),"i"(d0*4096+ks*1024):"memory");
      asm volatile("ds_read_b64_tr_b16 %0,%1 offset:%c2":"=&v"(hi[ks]):"v"(vb),"i"(d0*4096+ks*1024+512):"memory");}
    asm volatile("s_waitcnt lgkmcnt(0)":::"memory");SBAR();
    #define PK(k) (bf16x8){lo[k][0],lo[k][1],lo[k][2],lo[k][3],hi[k][0],hi[k][1],hi[k][2],hi[k][3]}
    o[d0]=__builtin_amdgcn_mfma_f32_32x32x16_bf16(pa0,PK(0),o[d0],0,0,0);
    o[d0]=__builtin_amdgcn_mfma_f32_32x32x16_bf16(pa1,PK(1),o[d0],0,0,0);
    o[d0]=__builtin_amdgcn_mfma_f32_32x32x16_bf16(pa2,PK(2),o[d0],0,0,0);
    o[d0]=__builtin_amdgcn_mfma_f32_32x32x16_bf16(pa3,PK(3),o[d0],0,0,0);
    #undef PK
  }
}

#ifndef ATTN_STORE16
#define ATTN_STORE16(p,v) (*(u32x4*)(p)=(v))
#endif
template<int THRL> __device__ __forceinline__ void attn_unit(int b,int h,int qb,const bf16*Q,const bf16*__restrict__ K,const bf16*__restrict__ V,bf16*O,char*shm,float dthr2,float mref2){
  typedef __attribute__((address_space(3))) const float* lds_cf; typedef __attribute__((address_space(3))) const f32x4v* lds_cf4;
  const int tid=opaque_i(threadIdx.x),lane=tid&63,r32=lane&31,hi=lane>>5; const int wid=__builtin_amdgcn_readfirstlane(tid>>6);
  const long rowbase=(long)b*SEQ; const int q0=qb*QB;
  const bf16*Qw=Q+(rowbase+q0+wid*QBLK)*DM+h*D;
  int T0;
  { const lds_cf c2all=(lds_cf)((lds_cptr)shm+LDS_C2); const float thr=c2all[q0]-dthr2; const bool skp=c2all[64*lane+63]<thr; const unsigned long long bal=__ballot(skp);
    const int nskip=(~bal==0ull)?64:(int)__builtin_ctzll(~bal); const int ntf=(q0+QB)/KVBLK; int t0=nskip&~1; if(t0>ntf-4)t0=ntf-4; T0=__builtin_amdgcn_readfirstlane(t0); }
  const bf16*Kh=K+(rowbase+(long)T0*KVBLK)*DM+h*D,*Vh=V+(rowbase+(long)T0*KVBLK)*DM+h*D;
  const unsigned lds0=(unsigned)(uintptr_t)shm;
  float*wsf=(float*)(shm+LDS_WS)+wid*64;
  const bf16*ksrc=Kh+(long)lane*DM+wid*8;
  const bf16*vsrc=Vh+(long)(16*(wid&3)+(lane>>2))*DM+(wid>>2)*32+(lane&3)*8;
  const unsigned kdst=lds0+LDS_K+wid*1024, vdst=lds0+LDS_V+wid*1024;
  #define DMA_K(t,slot) glds16(ksrc+(long)(t)*KVBLK*DM,(unsigned)__builtin_amdgcn_readfirstlane(kdst+(slot)))
  #define DMA_V(t,slot) glds16(vsrc+(long)(t)*KVBLK*DM,(unsigned)__builtin_amdgcn_readfirstlane(vdst+(slot)))
  const int vb0=(int)(lds0+LDS_V)+((lane>>4)&1)*32+(lane&3)*8+(4*hi+((lane&15)>>2))*64;
  const char*Kbase=shm+LDS_K; bf16x8 kf[8];
  const lds_cptr shm3=(lds_cptr)shm; const lds_cptr kp0=shm3+LDS_K+hi*1024+r32*16; const lds_cptr vp0=shm3+LDS_V+((lane>>4)&1)*32+(lane&3)*8+(4*hi+((lane&15)>>2))*64;
  const int NT=(q0+QB)/KVBLK-T0;
  DMA_K(0,0);DMA_V(0,0);DMA_K(1,SLOTB);
  bf16x8 qr[4];
  #pragma unroll
  for(int d0=0;d0<4;++d0)qr[d0]=*reinterpret_cast<const bf16x8*>(&Qw[(long)r32*DM+d0*16+hi*8]);
  float l_reg=0.f;f32x16 o[2];o[0]=f32x16{};o[1]=f32x16{};
  const float k0c=-(((lds_cf)((lds_cptr)shm+LDS_C2))[q0+wid*QBLK+r32]+mref2);
  bf16x8 qx;
  { const unsigned h_=__float_as_uint(k0c); const unsigned kh=(h_+0x7fffu+((h_>>16)&1u))>>16; const float r1_=k0c-__uint_as_float(kh<<16);
    const unsigned m_=__float_as_uint(r1_); const unsigned km=(m_+0x7fffu+((m_>>16)&1u))>>16; const float r2_=r1_-__uint_as_float(km<<16);
    const unsigned l_=__float_as_uint(r2_); const unsigned kl=(l_+0x7fffu+((l_>>16)&1u))>>16;
    u32x4 w_; w_.x=hi?0u:0x3F803F80u; w_.y=hi?0u:(0x3F80u|(kh<<16)); w_.z=hi?0u:(km|(kl<<16)); w_.w=0u; qx=__builtin_bit_cast(bf16x8,w_); }
  typedef __attribute__((address_space(3))) const unsigned long long* lds_cu64;
  const lds_cu64 kxp=(lds_cu64)((lds_cptr)shm+LDS_KX)+T0*KVBLK+r32;
  #define KXF(v_) __builtin_bit_cast(bf16x8,(u32x4){(unsigned)(v_),(unsigned)((v_)>>32),0x3F803F80u,0u})
  #define CINIT(C0,C1,t) do{ const unsigned long long a_=kxp[(t)*KVBLK], b_=kxp[(t)*KVBLK+32]; const f32x16 z_=f32x16{}; \
    C0=__builtin_amdgcn_mfma_f32_32x32x16_bf16(KXF(a_),qx,z_,0,0,0); C1=__builtin_amdgcn_mfma_f32_32x32x16_bf16(KXF(b_),qx,z_,0,0,0); }while(0)
  const int qrel=wid*QBLK+r32;
  #define CMASK(P0,P1,t) do{int jb_=(t)-(NT-4); if(jb_>=0)cmask(P0,P1,jb_,qrel,hi);}while(0)
  #define START(P0,P1) do{ _Pragma("unroll") for(int r=0;r<16;++r)P0[r]=__builtin_amdgcn_exp2f(P0[r]); }while(0)
  #define RESC() do{}while(0)
  f32x16 pA0,pA1,pB0,pB1;
  int sl_prev=0,sl_cur=0,sl_next=SLOTB;
  #define ROT() do{sl_prev=sl_cur;sl_cur=sl_next;sl_next=(sl_next==(NSLOT-1)*SLOTB)?0:sl_next+SLOTB;}while(0)
  DMA_K(2,2*SLOTB);
  WAIT_BAR(3);
  CINIT(pA0,pA1,0); qkt(pA0,pA1,Kbase,qr,r32,hi);asm volatile("s_nop 15\n\ts_nop 7":"+v"(pA0),"+v"(pA1));CMASK(pA0,pA1,0);
  START(pA0,pA1);
  _Pragma("unroll") for(int r=0;r<16;++r)pA1[r]=__builtin_amdgcn_exp2f(pA1[r]);
  WAIT_BAR(0);
  DMA_K(3,0);DMA_V(1,SLOTB);
  ROT();
  kload8(kf,kp0+sl_cur);
  WAIT_BAR(2);
  s16x4 vlo[8],vhi[8]; u32x4 pw0,pw1,pw2,pw3;
  #define PKW(P,B) cvtpk_s(P[B],P[B+1])
  #define PAF(k) __builtin_bit_cast(bf16x8,pw##k)
  #define VFR(i) (bf16x8){vlo[i][0],vlo[i][1],vlo[i][2],vlo[i][3],vhi[i][0],vhi[i][1],vhi[i][2],vhi[i][3]}
  #define PIN(x) asm volatile("":"+v"(x))
  #define MX3(a,b,c) __builtin_fmaxf(__builtin_fmaxf((a),(b)),(c))
  #define GAPA(MF,A0,A1,A2,A3,W0,W1,PW) do{ MF; sacc+=A0; sacc+=A1; sacc+=A2; sacc+=A3; PIN(sacc); W0; W1; PIN(PW); SBAR(); }while(0)
  #define EX(v) __builtin_amdgcn_exp2f(v)
  #define GAPB(MF,X,B) do{ MF; X[B]=EX(X[B]); X[B+1]=EX(X[B+1]); X[B+2]=EX(X[B+2]); X[B+3]=EX(X[B+3]); PIN(X); SBAR(); }while(0)
  #define VRD(i) do{ vlo[i]=vtr(vp_+(((i)>>2)*4096+((i)&3)*1024)); vhi[i]=vtr(vp_+(((i)>>2)*4096+((i)&3)*1024+512)); }while(0)
  #define KRD(G,j) do{ if(G){ kload2(kf,kp0+sl_next,j); SBAR(); } }while(0)
  #define STEP(C0,C1,P0,P1,t,GK,GV,GL) do{ SBAR(); CINIT(C0,C1,t); SBAR(); \
    const lds_cptr vp_=vp0+sl_prev; \
    VRD(0); SBAR(); float sacc=(P0[0]+P0[1]); \
    GAPA(C0=__builtin_amdgcn_mfma_f32_32x32x16_bf16(kf[0],qr[0],C0,0,0,0), P0[2],P0[3],P0[4],P0[5],     pw0[0]=PKW(P0,0), pw0[1]=PKW(P0,2), pw0); \
    VRD(4); SBAR(); GAPA(C1=__builtin_amdgcn_mfma_f32_32x32x16_bf16(kf[1],qr[0],C1,0,0,0), P0[6],P0[7],P0[8],P0[9],     pw0[2]=PKW(P0,4), pw0[3]=PKW(P0,6), pw0); \
    VRD(1); SBAR(); GAPA(C0=__builtin_amdgcn_mfma_f32_32x32x16_bf16(kf[2],qr[1],C0,0,0,0),   P0[10],P0[11],P0[12],P0[13], pw1[0]=PKW(P0,8), pw1[1]=PKW(P0,10), pw1); \
    VRD(5); SBAR(); GAPA(C1=__builtin_amdgcn_mfma_f32_32x32x16_bf16(kf[3],qr[1],C1,0,0,0),   P0[14],P0[15],P1[0],P1[1],   pw1[2]=PKW(P0,12),pw1[3]=PKW(P0,14), pw1); \
    VRD(2); SBAR(); GAPA(C0=__builtin_amdgcn_mfma_f32_32x32x16_bf16(kf[4],qr[2],C0,0,0,0),   P1[2],P1[3],P1[4],P1[5],     pw2[0]=PKW(P1,0), pw2[1]=PKW(P1,2), pw2); \
    VRD(6); SBAR(); GAPA(C1=__builtin_amdgcn_mfma_f32_32x32x16_bf16(kf[5],qr[2],C1,0,0,0),   P1[6],P1[7],P1[8],P1[9],     pw2[2]=PKW(P1,4), pw2[3]=PKW(P1,6), pw2); \
    VRD(3); SBAR(); GAPA(C0=__builtin_amdgcn_mfma_f32_32x32x16_bf16(kf[6],qr[3],C0,0,0,0),   P1[10],P1[11],P1[12],P1[13], pw3[0]=PKW(P1,8), pw3[1]=PKW(P1,10), pw3); \
    VRD(7); SBAR(); GAPA(C1=__builtin_amdgcn_mfma_f32_32x32x16_bf16(kf[7],qr[3],C1,0,0,0),   P1[14],P1[15],0.f,0.f,       pw3[2]=PKW(P1,12),pw3[3]=PKW(P1,14), pw3); \
    l_reg+=sacc; \
    if(GK){DMA_K((t)+3,sl_cur);} if(GV){DMA_V((t)+1,sl_next);} \
    CMASK(C0,C1,t); \
    SBAR(); \
    GAPB(o[0]=__builtin_amdgcn_mfma_f32_32x32x16_bf16(PAF(0),VFR(0),o[0],0,0,0), C0,0); \
    GAPB(o[1]=__builtin_amdgcn_mfma_f32_32x32x16_bf16(PAF(0),VFR(4),o[1],0,0,0), C0,4); \
    KRD(GL,0); GAPB(o[0]=__builtin_amdgcn_mfma_f32_32x32x16_bf16(PAF(1),VFR(1),o[0],0,0,0), C0,8); \
    KRD(GL,1); GAPB(o[1]=__builtin_amdgcn_mfma_f32_32x32x16_bf16(PAF(1),VFR(5),o[1],0,0,0), C0,12); \
    KRD(GL,2); GAPB(o[0]=__builtin_amdgcn_mfma_f32_32x32x16_bf16(PAF(2),VFR(2),o[0],0,0,0), C1,0); \
    KRD(GL,3); GAPB(o[1]=__builtin_amdgcn_mfma_f32_32x32x16_bf16(PAF(2),VFR(6),o[1],0,0,0), C1,4); \
    GAPB(o[0]=__builtin_amdgcn_mfma_f32_32x32x16_bf16(PAF(3),VFR(3),o[0],0,0,0), C1,8); \
    GAPB(o[1]=__builtin_amdgcn_mfma_f32_32x32x16_bf16(PAF(3),VFR(7),o[1],0,0,0), C1,12); \
    }while(0)
  int t=1;
  #undef CMASK
  #define CMASK(P0,P1,t) do{}while(0)
  for(;t+5<NT;t+=2){
    STEP(pB0,pB1,pA0,pA1,t,true,true,true);     WAIT_BAR(2); RESC(); ROT();
    STEP(pA0,pA1,pB0,pB1,t+1,true,true,true);   WAIT_BAR(2); RESC(); ROT();
  }
  #undef CMASK
  #define CMASK(P0,P1,t) do{int jb_=(t)-(NT-4); if(jb_>=0)cmask(P0,P1,jb_,qrel,hi);}while(0)
  #define ENDW(tt) do{ if((tt)+3<NT){WAIT_BAR(2);} else if((tt)+2<NT){WAIT_BAR(1);} else {WAIT_BAR(0);} }while(0)
  for(;t+1<NT;t+=2){
    STEP(pB0,pB1,pA0,pA1,t,(t+3<NT),(t+1<NT),(t+1<NT));       ENDW(t);   RESC(); ROT();
    STEP(pA0,pA1,pB0,pB1,t+1,(t+4<NT),(t+2<NT),(t+2<NT));     ENDW(t+1); RESC(); ROT();
  }
  STEP(pB0,pB1,pA0,pA1,NT-1,false,false,false); RESC();
  { float sacc=pB0[0]+pB0[1]; _Pragma("unroll") for(int r=2;r<16;++r)sacc+=pB0[r]; _Pragma("unroll") for(int r=0;r<16;++r)sacc+=pB1[r]; l_reg+=sacc;
    pw0=(u32x4){PKW(pB0,0),PKW(pB0,2),PKW(pB0,4),PKW(pB0,6)};pw1=(u32x4){PKW(pB0,8),PKW(pB0,10),PKW(pB0,12),PKW(pB0,14)};pw2=(u32x4){PKW(pB1,0),PKW(pB1,2),PKW(pB1,4),PKW(pB1,6)};pw3=(u32x4){PKW(pB1,8),PKW(pB1,10),PKW(pB1,12),PKW(pB1,14)};
    SBAR(); pv(o,vb0+sl_cur,PAF(0),PAF(1),PAF(2),PAF(3)); }
  #undef PKW
  #undef PAF
  #undef VFR
  #undef PIN
  #undef MX3
  #undef GAPA
  #undef GAPB
  #undef EX
  #undef VRD
  #undef KRD
  #undef STEP
  #undef ENDW
  {auto rr=__builtin_amdgcn_permlane32_swap(__float_as_uint(l_reg),__float_as_uint(l_reg),false,false);l_reg=__uint_as_float(rr[0])+__uint_as_float(rr[1]);}
  if(hi==0)wsf[32+r32]=l_reg;asm volatile("s_waitcnt lgkmcnt(0)":::"memory");
  float rli[16];
  #pragma unroll
  for(int r=0;r<16;++r)rli[r]=__builtin_amdgcn_rcpf(wsf[32+crow(r,hi)]);
  bf16*Ow=O+(rowbase+q0+wid*QBLK)*DM+h*D;
  { bf16*stg=(bf16*)(shm+LDS_OST)+wid*2048;
    #pragma unroll
    for(int r=0;r<16;++r){const int orow=crow(r,hi);
      #pragma unroll
      for(int d0=0;d0<2;++d0)stg[orow*64+d0*32+r32]=__float2bfloat16(o[d0][r]*rli[r]);}
    asm volatile("s_waitcnt lgkmcnt(0)":::"memory");
    #pragma unroll
    for(int i=0;i<4;++i){const int row=i*8+(lane>>3),ch=lane&7; const u32x4 v=*(const u32x4*)(stg+row*64+ch*8); ATTN_STORE16(Ow+(long)row*DM+ch*8,v);} }
  asm volatile("s_waitcnt lgkmcnt(0)\n\ts_barrier":::"memory");
  #undef CINIT
  #undef KXF
  #undef DMA_K
  #undef DMA_V
  #undef CMASK
  #undef START
  #undef RESC
  #undef ROT
}
constexpr int ATTN_LDS_BYTES=LDS_BYTES;
struct AttnTensors { const bf16* Q; const bf16* K; const bf16* V; bf16* O; };
struct AttnUnit { int bh; int qb; };
struct StaticOrder {
  int vcu;
  __device__ __forceinline__ explicit StaticOrder(int grid,int block):vcu((block%8)*(grid/8)+block/8){}
  __device__ __forceinline__ bool next(int i,AttnUnit&u)const{ if(i>=4)return false; const int s=vcu&3; u.bh=vcu>>2; u.qb=(i==0)?15-s:(i==1)?8+s:(i==2)?7-s:s; return true; }
  __device__ __forceinline__ void a_ready(const AttnUnit&)const{}
  __device__ __forceinline__ void done(const AttnUnit&)const{}
};
template<class Sched,int THRL=8> __device__ __forceinline__ void attn_phase(char*lds,const AttnTensors&T,const Sched&S){
  AttnUnit u;
  for(int i=0;S.next(i,u);++i){ S.a_ready(u); attn_unit<THRL>(u.bh/NHEAD,u.bh%NHEAD,u.qb,T.Q,T.K,T.V,T.O,lds,1e30f,16.0f); S.done(u); }
}
#undef SBAR
#undef WAIT_BAR
}
constexpr size_t MiB = 1u << 20;
constexpr size_t WS_SSQ_MIX = 0;
constexpr size_t WS_LOGF = 2 * MiB;
constexpr size_t WS_BAR = 3 * MiB + 512 * 1024;
constexpr size_t WS_WF = 3 * MiB;
constexpr size_t WS_W = 4 * MiB, W_PAR = 32 * MiB;
constexpr size_t W_WIN = 0, W_WM = 11 * MiB, W_WO = 13 * MiB, W_WFI = 15 * MiB, W_WFO = 26 * MiB;
constexpr size_t WS_XB = 68 * MiB;
constexpr size_t WS_Q = 132 * MiB, WS_K = 164 * MiB, WS_V = 196 * MiB;
constexpr size_t WS_CP = 228 * MiB;
constexpr size_t WS_G = 292 * MiB;
constexpr size_t WS_SSQ_FFN = 484 * MiB;
constexpr size_t WS_END = 486 * MiB;
constexpr int LDS_BYTES = 147456;
constexpr int NWAVES = 8;

#define GAS __attribute__((address_space(1)))
#define LAS __attribute__((address_space(3)))
typedef unsigned short bf16;
typedef unsigned v4u __attribute__((ext_vector_type(4)));
typedef float f32x4 __attribute__((ext_vector_type(4)));
#define LDS_WAIT() asm volatile("s_waitcnt lgkmcnt(0)" ::: "memory")
__device__ __forceinline__ unsigned f2bf(float f) { unsigned u = __builtin_bit_cast(unsigned, f); return (u + 0x7fffu + ((u >> 16) & 1u)) >> 16; }
__device__ __forceinline__ unsigned pk2(float lo, float hi) { return f2bf(lo) | (f2bf(hi) << 16); }
__device__ __forceinline__ float wave_sum(float v) {
#pragma unroll
    for (int o = 1; o < 64; o <<= 1) v += __shfl_xor(v, o);
    return v;
}

__device__ __forceinline__ void tr_item(const float* W, int ldn, int n0, int k0, const float* gain, bf16* WT, int ldk, int drow0, int koff, LAS float* scr, int lane) {
    { const int c4 = lane & 7, kr = lane >> 3;
#pragma unroll
      for (int i = 0; i < 8; ++i) { const int kk = 8 * i + kr; f32x4 w = *(const f32x4*)(W + (size_t)(k0 + kk) * ldn + n0 + 4 * c4); if (gain) w *= gain[k0 + kk];
          LAS float* d = scr + kk * 33 + 4 * c4; d[0] = w.x; d[1] = w.y; d[2] = w.z; d[3] = w.w; } }
    LDS_WAIT(); asm volatile("" ::: "memory");
    const int c = lane & 7;
#pragma unroll
    for (int j = 0; j < 4; ++j) { const int n = (lane >> 3) + 8 * j; const LAS float* s = scr + (8 * c) * 33 + n;
        v4u o; o.x = pk2(s[0 * 33], s[1 * 33]); o.y = pk2(s[2 * 33], s[3 * 33]); o.z = pk2(s[4 * 33], s[5 * 33]); o.w = pk2(s[6 * 33], s[7 * 33]);
        *(v4u*)(WT + (size_t)(drow0 + n) * ldk + koff + k0 + 8 * c) = o; }
    LDS_WAIT(); asm volatile("" ::: "memory");
}

#define XB_TMO      128
#define XB_XCNT(j)  (256  + 64 * (j))
#define XB_XSUB(j)  (1280 + 64 * (j))
#define XB_XGEN(j)  (2304 + 64 * (j))
#define XB_TOP      3328
#define XB_TOPGEN   3392
#define XCD_BAR_WORDS 3456
#define XB_SPIN_CAP (1u << 18)

__device__ __forceinline__ unsigned xb_ld(unsigned* p)              { return __hip_atomic_load(p, __ATOMIC_RELAXED, __HIP_MEMORY_SCOPE_AGENT); }
__device__ __forceinline__ unsigned xb_add(unsigned* p, unsigned v) { return __hip_atomic_fetch_add(p, v, __ATOMIC_RELAXED, __HIP_MEMORY_SCOPE_AGENT); }
__device__ __forceinline__ unsigned xb_xcc_id() { return (unsigned)__builtin_amdgcn_s_getreg((3 << 11) | 20) & 0xFu; }
#define XB_SPIN(cond, bar) do { unsigned _sp = 0; while (cond) { __builtin_amdgcn_s_sleep(1); \
    if ((++_sp & 255u) == 0u) { if (xb_ld(&(bar)[XB_TMO])) break; if (_sp > XB_SPIN_CAP) { atomicAdd(&(bar)[XB_TMO], 1u); break; } } } } while (0)

struct XcdBarrier {
    unsigned* bar; unsigned x;
    volatile LAS unsigned* st;
};

__device__ __forceinline__ XcdBarrier xcd_barrier_post(unsigned* bar, volatile LAS unsigned* st) {
    XcdBarrier b; b.bar = bar; b.x = xb_xcc_id(); b.st = st;
    if (threadIdx.x == 0) (void)xb_add(&bar[XB_XCNT(b.x)], 1u);
    return b;
}
__device__ __forceinline__ void xcd_barrier_complete(unsigned* bar, unsigned x, unsigned& nloc, unsigned& nx) {
    const unsigned G = gridDim.x * gridDim.y * gridDim.z;
    unsigned sum, cnt, mine, sp = 0u;
    for (;;) {
        sum = 0u; cnt = 0u; mine = 0u;
#pragma unroll
        for (unsigned j = 0; j < 16; ++j) { const unsigned c = xb_ld(&bar[XB_XCNT(j)]); sum += c; cnt += (c > 0u) ? 1u : 0u; mine = (j == x) ? c : mine; }
        if (sum == G) break;
        __builtin_amdgcn_s_sleep(1);
        if ((++sp & 255u) == 0u) { if (xb_ld(&bar[XB_TMO])) break; if (sp > XB_SPIN_CAP) { atomicAdd(&bar[XB_TMO], 1u); break; } }
    }
    nloc = mine > 0u ? mine : 1u; nx = cnt > 0u ? cnt : 1u;
}

__device__ __forceinline__ void xcd_barrier(const XcdBarrier& b) {
    asm volatile("s_waitcnt vmcnt(0)" ::: "memory");
    __syncthreads();
    if (threadIdx.x == 0) {
        unsigned* bar = b.bar; const unsigned myx = xb_xcc_id();
        __builtin_amdgcn_s_waitcnt(0);
        unsigned nloc = b.st[0], nx = b.st[1];
        if (nloc == 0u) { xcd_barrier_complete(bar, myx, nloc, nx); b.st[0] = nloc; b.st[1] = nx; }
        const unsigned old = xb_add(&bar[XB_XSUB(myx)], 1u);
        const unsigned gen = old / nloc;
        if (old + 1u == (gen + 1u) * nloc) {
            __builtin_amdgcn_fence(__ATOMIC_RELEASE, "agent");
            asm volatile("s_waitcnt vmcnt(0)" ::: "memory");
            const unsigned og = xb_add(&bar[XB_TOP], 1u);
            const unsigned tg = og / nx;
            if (og + 1u == (tg + 1u) * nx) xb_add(&bar[XB_TOPGEN], 1u);
            else XB_SPIN(xb_ld(&bar[XB_TOPGEN]) == tg, bar);
            __builtin_amdgcn_fence(__ATOMIC_ACQUIRE, "agent");
            xb_add(&bar[XB_XGEN(myx)], 1u);
            asm volatile("s_waitcnt vmcnt(0)" ::: "memory");
        } else {
            XB_SPIN(xb_ld(&bar[XB_XGEN(myx)]) == gen, bar);
            __builtin_amdgcn_fence(__ATOMIC_ACQUIRE, "agent");
            asm volatile("s_waitcnt vmcnt(0)" ::: "memory");
        }
    }
    __syncthreads();
}

struct Args { const float* in[15]; float* out; unsigned char* ws; };

__device__ __forceinline__ void convert_layer(const Args& a, int l, int par, LAS unsigned char* lds, int gw, int NGW, int wave, int lane) {
    lane = opaque_i(lane);
    LAS float* scr = (LAS float*)(lds + wave * 16384);
    unsigned char* wb = a.ws + WS_W + (size_t)par * W_PAR;
    bf16* WIN = (bf16*)(wb + W_WIN); bf16* WM = (bf16*)(wb + W_WM); bf16* WO = (bf16*)(wb + W_WO); bf16* WFI = (bf16*)(wb + W_WFI); bf16* WFO = (bf16*)(wb + W_WFO);
    bf16* WFB = (bf16*)(a.ws + WS_WF) + (size_t)par * 16384;
    const float* g_mix = a.in[1] + (size_t)l * 1024; const float* w_in = a.in[2] + (size_t)l * 1024 * DIN_SRC;
    const float* w_ao = a.in[6] + (size_t)l * 512 * 1024; const float* w_co = a.in[8] + (size_t)l * 256 * 1024;
    const float* pool_w = a.in[9] + (size_t)l * 4 * 64 * 256; const float* pool_s = a.in[10] + (size_t)l * 1024;
    const float* w_o = a.in[11] + (size_t)l * 1024 * 1024; const float* g_ffn = a.in[12] + (size_t)l * 1024;
    const float* w_fi = a.in[13] + (size_t)l * 1024 * 5632; const float* w_fo = a.in[14] + (size_t)l * 2816 * 1024;
    constexpr int I_WIN = 16 * 176, I_WFI = 16 * 176, I_WO = 16 * 32, I_WFO = 44 * 32, I_WA = 8 * 32, I_WC = 4 * 32, I_WP = 1024, I_WF = 8;
    constexpr int NITEMS = I_WIN + I_WFI + I_WO + I_WFO + I_WA + I_WC + I_WP + I_WF;
    for (int it = gw; it < NITEMS; it += NGW) {
        int r = it;
        if (r < I_WIN) { const int kb = r / 176, nb = r % 176, pn = nb >> 3, rem = nb & 7, bj = rem >> 2, w = rem & 3; const int nl = 256 * pn + 64 * w + 32 * bj; const int src = nl < 1536 ? nl : nl + 8;
            tr_item(w_in, DIN_SRC, src, 64 * kb, g_mix, WIN, 1024, 32 * nb, 0, scr, lane); continue; } r -= I_WIN;
        if (r < I_WFI) { const int kb = r / 176, nb = r % 176, pn = nb >> 3, rem = nb & 7, bj = rem >> 2, w = rem & 3; const int src = bj * DFF + 128 * pn + 32 * w;
            tr_item(w_fi, 5632, src, 64 * kb, g_ffn, WFI, 1024, 32 * nb, 0, scr, lane); continue; } r -= I_WFI;
        if (r < I_WO) { const int kb = r >> 5, nb = r & 31; tr_item(w_o, 1024, 32 * nb, 64 * kb, nullptr, WO, 1024, 32 * nb, 0, scr, lane); continue; } r -= I_WO;
        if (r < I_WFO) { const int kb = r >> 5, nb = r & 31; tr_item(w_fo, 1024, 32 * nb, 64 * kb, nullptr, WFO, DFF, 32 * nb, 0, scr, lane); continue; } r -= I_WFO;
        if (r < I_WA) { const int kb = r >> 5, nb = r & 31; tr_item(w_ao, 1024, 32 * nb, 64 * kb, nullptr, WM, 896, 32 * nb, 0, scr, lane); continue; } r -= I_WA;
        if (r < I_WC) { const int kb = r >> 5, nb = r & 31; tr_item(w_co, 1024, 32 * nb, 64 * kb, nullptr, WM, 896, 32 * nb, 512, scr, lane); continue; } r -= I_WC;
        if (r < I_WP) { const int n = r, g = n >> 8, d = n & 255; const float w = pool_w[((size_t)g * 64 + lane) * 256 + d] * pool_s[n]; const bf16 wv = (bf16)f2bf(w);
            WM[(size_t)n * 896 + 768 + lane] = (g & 1) ? (bf16)0 : wv; WM[(size_t)n * 896 + 768 + 64 + lane] = (g & 1) ? wv : (bf16)0; continue; } r -= I_WP;
        { const int h = r;
#pragma unroll 4
            for (int i = 0; i < 16; ++i) { const int k = lane + 64 * i; const float w = w_in[(size_t)k * DIN_SRC + 1536 + h] * g_mix[k]; const unsigned hi = f2bf(w);
                WFB[h * 1024 + k] = (bf16)hi; WFB[(8 + h) * 1024 + k] = (bf16)f2bf(w - __uint_as_float(hi << 16)); } }
    }
}

constexpr int RS_OFF = 131072;
template <class Sched> __device__ __forceinline__ void build_row_scales(LAS unsigned char* lds, const Sched& S, const float* ssq, int tid) {
    LAS float* RS = (LAS float*)(lds + RS_OFF);
    const int half = tid >> 8, r = tid & 255;
    f32x4 v[6][4]; bool ok[6];
#pragma unroll
    for (int k = 0; k < 6; ++k) { pg8::Unit u; ok[k] = S.next(2 * k + half, u); const f32x4* q = (const f32x4*)(ssq + (size_t)((ok[k] ? u.pm : 0) * 256 + r) * 16);
#pragma unroll
        for (int j = 0; j < 4; ++j) v[k][j] = q[j]; }
#pragma unroll
    for (int k = 0; k < 6; ++k) { const f32x4 t = (v[k][0] + v[k][1]) + (v[k][2] + v[k][3]); const float sum = (t[0] + t[1]) + (t[2] + t[3]);
        if (ok[k]) RS[(2 * k + half) * 256 + r] = rsqrtf(sum * (1.0f / 1024.0f) + EPSN); }
    __syncthreads();
}

__global__ void __launch_bounds__(NWAVES * 64, 2) fwd_kernel(Args args) {
    extern __shared__ __attribute__((aligned(16))) unsigned char lds[];
    cg::grid_group grid = cg::this_grid();
#define GSYNC0() do { asm volatile("s_waitcnt vmcnt(0)" ::: "memory"); grid.sync(); __builtin_amdgcn_fence(__ATOMIC_ACQUIRE, "agent"); asm volatile("s_waitcnt vmcnt(0)" ::: "memory"); } while (0)
    LAS unsigned char* ldsl = (LAS unsigned char*)lds;
    const int tid = threadIdx.x, lane = tid & 63, wave = __builtin_amdgcn_readfirstlane(tid >> 6);
    const int G = gridDim.x; const int bx = blockIdx.x; const int vcu = (G % 8 == 0) ? (bx % 8) * (G / 8) + bx / 8 : bx;
    const int gw = vcu * NWAVES + wave, NGW = G * NWAVES;
#ifdef PROBE
    LAS unsigned long long* TACC = (LAS unsigned long long*)(ldsl + LDS_BYTES - 128);
    if (bx == 0 && tid == 0) { for (int i = 0; i < 14; ++i) TACC[i] = 0ull; TACC[13] = 1ull; TACC[12] = __builtin_amdgcn_s_memrealtime(); }
#define TSTAMP(k) do { if (bx == 0 && tid == 0) { const unsigned long long t_ = __builtin_amdgcn_s_memrealtime(); if (TACC[13]) TACC[k] += t_ - TACC[12]; TACC[12] = t_; } } while (0)
#else
#define TSTAMP(k) do {} while (0)
#endif
    unsigned char* ws = args.ws;
    float* SSQ_MIX = (float*)(ws + WS_SSQ_MIX); float* SSQ_FFN = (float*)(ws + WS_SSQ_FFN); float* LOGF = (float*)(ws + WS_LOGF);
    bf16* XB = (bf16*)(ws + WS_XB); bf16* CZ = (bf16*)args.out;     bf16* QO = (bf16*)(ws + WS_Q); bf16* KB = (bf16*)(ws + WS_K); bf16* VB = (bf16*)(ws + WS_V); bf16* MG = KB;
    bf16* CP = (bf16*)(ws + WS_CP); bf16* GT = (bf16*)(ws + WS_G); bf16* ACT = GT;
    const float* x_in = args.in[0]; float* out = args.out;

    unsigned* barw = (unsigned*)(ws + WS_BAR);
    volatile LAS unsigned* bst = (volatile LAS unsigned*)(ldsl + LDS_BYTES - 256);
    if (tid < 2) bst[tid] = 0u;
    __syncthreads();
    XcdBarrier xbar = xcd_barrier_post(barw, bst);
#define GSYNC() xcd_barrier(xbar)
    if (args.ws == nullptr) GSYNC0();
    convert_layer(args, 0, 0, ldsl, gw, NGW, wave, lane);
    for (int m = gw; m < MTOK; m += 4 * NGW) {
        const int lane = opaque_i(tid) & 63;
        f32x4 v[4][4];
#pragma unroll
        for (int r = 0; r < 4; ++r) { const f32x4* xr = (const f32x4*)(x_in + (size_t)(m + r * NGW) * 1024) + lane;
#pragma unroll
            for (int j = 0; j < 4; ++j) v[r][j] = xr[64 * j]; }
#pragma unroll
        for (int r = 0; r < 4; ++r) { const int mr = m + r * NGW; float s = 0.f;
#pragma unroll
            for (int j = 0; j < 4; ++j) s += (v[r][j].x * v[r][j].x + v[r][j].y * v[r][j].y) + (v[r][j].z * v[r][j].z + v[r][j].w * v[r][j].w);
            s = wave_sum(s);
            unsigned long long* o8 = (unsigned long long*)(XB + (size_t)mr * 1024) + lane;
#pragma unroll
            for (int j = 0; j < 4; ++j) o8[64 * j] = (unsigned long long)pk2(v[r][j].x, v[r][j].y) | ((unsigned long long)pk2(v[r][j].z, v[r][j].w) << 32);
            if (lane < 16) SSQ_MIX[(size_t)mr * 16 + lane] = lane == 0 ? s : 0.f; }
    }
    GSYNC();
    TSTAMP(0);

    for (int l = 0; l < NLAYER; ++l) {
#ifdef PROBE
        if (bx == 0 && tid == 0) TACC[13] = 1ull;
#endif
        const int par = l & 1;
        unsigned char* wb = ws + WS_W + (size_t)par * W_PAR;
        const float* ssq_mix = SSQ_MIX; float* ssq_ffn = SSQ_FFN;
        float* ssq_nextmix = (l + 1 < NLAYER) ? SSQ_MIX : nullptr;

#if (PHM >> 1) & 1
        {
        unsigned char* wsl = ws; asm volatile("" : "+s"(wsl));     float* SSQ_MIX = (float*)(wsl + WS_SSQ_MIX); float* SSQ_FFN = (float*)(wsl + WS_SSQ_FFN); float* LOGF = (float*)(wsl + WS_LOGF); bf16* XB = (bf16*)(wsl + WS_XB); bf16* QO = (bf16*)(wsl + WS_Q); bf16* KB = (bf16*)(wsl + WS_K); bf16* VB = (bf16*)(wsl + WS_V); bf16* MG = KB; bf16* CP = (bf16*)(wsl + WS_CP); bf16* GT = (bf16*)(wsl + WS_G); bf16* ACT = GT; unsigned* barw = (unsigned*)(wsl + WS_BAR); unsigned char* wb = wsl + WS_W + (size_t)par * W_PAR; const float* ssq_mix = SSQ_MIX; float* ssq_ffn = SSQ_FFN; float* ssq_nextmix = (l + 1 < NLAYER) ? SSQ_MIX : nullptr; (void)LOGF; (void)XB; (void)QO; (void)VB; (void)MG; (void)CP; (void)ACT; (void)barw; (void)wb; (void)ssq_mix; (void)ssq_ffn; (void)ssq_nextmix;
            const bf16* WFB = (const bf16*)(ws + WS_WF) + (size_t)par * 16384; const float* fb = args.in[3] + l * 8;
            for (int ch = gw; ch < MTOK / 16; ch += NGW) {
                const int lane = opaque_i(tid) & 63, fr = lane & 15, fq = lane >> 4, m0 = ch * 16;
                const bf16* xa = XB + (size_t)(m0 + fr) * 1024 + 8 * fq; const bf16* wbp = WFB + (size_t)fr * 1024 + 8 * fq;
                f32x4 acc = {0.f, 0.f, 0.f, 0.f};
#pragma unroll 16
                for (int kk = 0; kk < 32; ++kk) { const pg8::bf16x8 av = *(const pg8::bf16x8*)(xa + 32 * kk), bv = *(const pg8::bf16x8*)(wbp + 32 * kk);
                    acc = __builtin_amdgcn_mfma_f32_16x16x32_bf16(av, bv, acc, 0, 0, 0); }
                f32x4 tot; tot.x = acc.x + __shfl_xor(acc.x, 8); tot.y = acc.y + __shfl_xor(acc.y, 8); tot.z = acc.z + __shfl_xor(acc.z, 8); tot.w = acc.w + __shfl_xor(acc.w, 8);
                if (fr < 8) { const float fbh = fb[fr]; f32x4 lf;
#pragma unroll
                    for (int r = 0; r < 4; ++r) { const int row = m0 + 4 * fq + r; const float rr = rsqrtf(pg8::row_ssq(ssq_mix, row) * (1.0f / 1024.0f) + EPSN); const float f = tot[r] * rr + fbh;
                        lf[r] = fminf(f, 0.f) - log1pf(expf(-fabsf(f))); }
                    *(f32x4*)(LOGF + ((size_t)(m0 >> 12) * 8 + fr) * SEQ_ + (m0 & (SEQ_ - 1)) + 4 * fq) = lf; }
            }
            TSTAMP(1);
            pg8::ProbSimple P{(const char*)XB, (const char*)(wb + W_WIN), 1024, 1024, 16}; pg8::StaticOrder<1> S; S.init(MTOK, NIN, G, bx);
            build_row_scales(ldsl, S, ssq_mix, opaque_i(tid));
            pg8::EpiInProj E{(const LAS float*)(ldsl + RS_OFF), args.in[4] + l * 64, args.in[5] + l * 64, QO, KB, VB, CP, GT};
            pg8::gemm_phase<pg8::ProbSimple, pg8::EpiInProj, pg8::StaticOrder<1>, true, true>(ldsl, P, S, E);
        }
#endif
        GSYNC();
        TSTAMP(2);
#ifdef PROBE
        GSYNC(); TSTAMP(11);
#endif

#if (PHM >> 2) & 1
        {
        unsigned char* wsl = ws; asm volatile("" : "+s"(wsl));     float* SSQ_MIX = (float*)(wsl + WS_SSQ_MIX); float* SSQ_FFN = (float*)(wsl + WS_SSQ_FFN); float* LOGF = (float*)(wsl + WS_LOGF); bf16* XB = (bf16*)(wsl + WS_XB); bf16* QO = (bf16*)(wsl + WS_Q); bf16* KB = (bf16*)(wsl + WS_K); bf16* VB = (bf16*)(wsl + WS_V); bf16* MG = KB; bf16* CP = (bf16*)(wsl + WS_CP); bf16* GT = (bf16*)(wsl + WS_G); bf16* ACT = GT; unsigned* barw = (unsigned*)(wsl + WS_BAR); unsigned char* wb = wsl + WS_W + (size_t)par * W_PAR; const float* ssq_mix = SSQ_MIX; float* ssq_ffn = SSQ_FFN; float* ssq_nextmix = (l + 1 < NLAYER) ? SSQ_MIX : nullptr; (void)LOGF; (void)XB; (void)QO; (void)VB; (void)MG; (void)CP; (void)ACT; (void)barw; (void)wb; (void)ssq_mix; (void)ssq_ffn; (void)ssq_nextmix;
            if (l + 1 < NLAYER) convert_layer(args, l + 1, (l + 1) & 1, ldsl, gw, NGW, wave, lane);
            TSTAMP(3);
            {
                const float* cw = args.in[7] + (size_t)l * 3 * 256;
                const int lane = opaque_i(tid) & 63; const bool isconv = lane < 32; const int c0 = 8 * (lane & 31), g = (lane & 31) >> 3, wwin = 2 << g;
                const int R0 = vcu * 128 + wave * 16, tl0 = R0 & (SEQ_ - 1); const bool halo = tl0 != 0;
                const int colA = isconv ? c0 : 768 + c0, colB = isconv ? 512 + c0 : 768 + c0, colC = isconv ? 256 + c0 : 768 + c0;
                const f32x4 w0a = *(const f32x4*)(cw + c0), w0b = *(const f32x4*)(cw + c0 + 4), w1a = *(const f32x4*)(cw + 256 + c0), w1b = *(const f32x4*)(cw + 256 + c0 + 4), w2a = *(const f32x4*)(cw + 512 + c0), w2b = *(const f32x4*)(cw + 512 + c0 + 4);
                const v4u zero4 = {0u, 0u, 0u, 0u}; const f32x4 zf = {0.f, 0.f, 0.f, 0.f};
                v4u ring[16];
#pragma unroll
                for (int i = 0; i < 16; ++i) ring[i] = zero4;
                f32x4 S0 = zf, S1 = zf, z1a = zf, z1b = zf, z2a = zf, z2b = zf;
#pragma unroll
                for (int i = -15; i < 16; ++i) {
                    const bool valid = (i >= 0) || halo;
                    const bf16* rp = CP + (size_t)(R0 + i) * 1024;
                    v4u av = zero4; if (valid) av = *(const v4u*)(rp + colA);
                    const f32x4 u0 = pg8::bf_lo4(av.x, av.y), u1 = pg8::bf_lo4(av.z, av.w);
                    S0 += u0; S1 += u1;
                    { const v4u o2 = (i - 2 >= -15) ? ring[(i - 2 + 16) & 15] : zero4, o4 = (i - 4 >= -15) ? ring[(i - 4 + 16) & 15] : zero4, o8 = (i - 8 >= -15) ? ring[(i - 8 + 16) & 15] : zero4, o16 = (i - 16 >= -15) ? ring[(i - 16 + 16) & 15] : zero4;
                      const v4u o = g == 0 ? o2 : g == 1 ? o4 : g == 2 ? o8 : o16;
                      S0 -= pg8::bf_lo4(o.x, o.y); S1 -= pg8::bf_lo4(o.z, o.w); }
                    ring[(i + 16) & 15] = av;
                    f32x4 za = zf, zb = zf;
                    if (i >= -2) { v4u bv = zero4; if (valid) bv = *(const v4u*)(rp + colB); za = u0 * pg8::bf_lo4(bv.x, bv.y); zb = u1 * pg8::bf_lo4(bv.z, bv.w); }
                    if (i >= 0) {
                        const v4u cv = *(const v4u*)(rp + colC);
                        const f32x4 oc0 = pg8::bf_lo4(cv.x, cv.y) * (w0a * z2a + w1a * z1a + w2a * za), oc1 = pg8::bf_lo4(cv.z, cv.w) * (w0b * z2b + w1b * z1b + w2b * zb);
                        const int tl = tl0 + i, n = (tl + 1) < wwin ? (tl + 1) : wwin; const float inv = 1.0f / (float)n;
                        const f32x4 op0 = S0 * inv - u0, op1 = S1 * inv - u1;
                        *(v4u*)(CZ + (size_t)(R0 + i) * 512 + (isconv ? c0 : 256 + c0)) = pg8::pack8(isconv ? oc0 : op0, isconv ? oc1 : op1);
                    }
                    if (i >= -2) { z2a = z1a; z2b = z1b; z1a = za; z1b = zb; }
                }
            }
            TSTAMP(4);
            {
                __syncthreads();
                const int tid = opaque_i(threadIdx.x), lane = tid & 63;
                float dthr2, mref2;
                { float mq = fabsf((args.in[4] + l * 64)[lane]), mk = fabsf((args.in[5] + l * 64)[lane]);
#pragma unroll
                  for (int o = 1; o < 64; o <<= 1) { mq = fmaxf(mq, __shfl_xor(mq, o)); mk = fmaxf(mk, __shfl_xor(mk, o)); }
                  mref2 = 8.0f * 1.02f * mq * mk * LOG2E; dthr2 = 2.0f * mref2 + 26.0f * LOG2E; }
                LAS float* c2 = (LAS float*)(ldsl + attn_body::LDS_C2); LAS float* wsum = (LAS float*)(ldsl + attn_body::LDS_WSUM); volatile LAS unsigned* uq = (volatile LAS unsigned*)(ldsl + attn_body::LDS_WSUM + 32);
                unsigned* qctr = barw + 4096 + 64 * l;
                for (;;) {
                    if (tid == 0) *uq = __hip_atomic_fetch_add(qctr, 1u, __ATOMIC_RELAXED, __HIP_MEMORY_SCOPE_AGENT);
                    __syncthreads();
                    const unsigned u = *uq;
                    if (u >= (unsigned)(NB * NHEADS * (SEQ_ / 256))) break;
                    const int qb = (SEQ_ / 256 - 1) - (int)(u >> 6), bh = (int)(u & 63);
                    const f32x4* p = (const f32x4*)(LOGF + (size_t)bh * SEQ_ + tid * 8); const f32x4 a = p[0], b = p[1];
                    float v0 = a.x, v1 = v0 + a.y, v2 = v1 + a.z, v3 = v2 + a.w, v4 = v3 + b.x, v5 = v4 + b.y, v6 = v5 + b.z, v7 = v6 + b.w;
                    float sc = v7;
#pragma unroll
                    for (int o = 1; o < 64; o <<= 1) { const float y = __shfl_up(sc, o); if (lane >= o) sc += y; }
                    if (lane == 63) wsum[wave] = sc;
                    __syncthreads();
                    float off = 0.f;
#pragma unroll
                    for (int w = 0; w < 8; ++w) { const float t = wsum[w]; if (w < wave) off += t; }
                    const float e = off + sc - v7;
                    f32x4 r0 = {-(e + v0) * LOG2E, -(e + v1) * LOG2E, -(e + v2) * LOG2E, -(e + v3) * LOG2E}, r1 = {-(e + v4) * LOG2E, -(e + v5) * LOG2E, -(e + v6) * LOG2E, -(e + v7) * LOG2E};
                    *(LAS f32x4*)(c2 + tid * 8) = r0; *(LAS f32x4*)(c2 + tid * 8 + 4) = r1;
                    { LAS unsigned long long* kx = (LAS unsigned long long*)(ldsl + attn_body::LDS_KX) + tid * 8;
#pragma unroll
                      for (int j = 0; j < 8; ++j) { const float cv = j < 4 ? r0[j & 3] : r1[j & 3]; const unsigned hh = f2bf(cv); const float q1 = cv - __uint_as_float(hh << 16);
                          const unsigned mm = f2bf(q1); const float q2 = q1 - __uint_as_float(mm << 16); const unsigned ll = f2bf(q2);
                          kx[j] = (unsigned long long)(hh | (mm << 16)) | ((unsigned long long)(ll | (0x3F80u << 16)) << 32); } }
                    __syncthreads();
                    attn_body::attn_unit<8>(bh >> 3, bh & 7, qb, (const attn_body::bf16*)QO, (const attn_body::bf16*)KB, (const attn_body::bf16*)VB, (attn_body::bf16*)QO, (char*)lds, dthr2, mref2);
                }
            }
            TSTAMP(5);
        }
#endif
        GSYNC();
        TSTAMP(6);

#if (PHM >> 3) & 1
        {
        unsigned char* wsl = ws; asm volatile("" : "+s"(wsl));     float* SSQ_MIX = (float*)(wsl + WS_SSQ_MIX); float* SSQ_FFN = (float*)(wsl + WS_SSQ_FFN); float* LOGF = (float*)(wsl + WS_LOGF); bf16* XB = (bf16*)(wsl + WS_XB); bf16* QO = (bf16*)(wsl + WS_Q); bf16* KB = (bf16*)(wsl + WS_K); bf16* VB = (bf16*)(wsl + WS_V); bf16* MG = KB; bf16* CP = (bf16*)(wsl + WS_CP); bf16* GT = (bf16*)(wsl + WS_G); bf16* ACT = GT; unsigned* barw = (unsigned*)(wsl + WS_BAR); unsigned char* wb = wsl + WS_W + (size_t)par * W_PAR; const float* ssq_mix = SSQ_MIX; float* ssq_ffn = SSQ_FFN; float* ssq_nextmix = (l + 1 < NLAYER) ? SSQ_MIX : nullptr; (void)LOGF; (void)XB; (void)QO; (void)VB; (void)MG; (void)CP; (void)ACT; (void)barw; (void)wb; (void)ssq_mix; (void)ssq_ffn; (void)ssq_nextmix;
            pg8::ProbMerge P{(const char*)QO, (const char*)CZ, (const char*)(wb + W_WM), 512, 896}; pg8::StaticOrder<3> S; S.init(MTOK, 1024, G, bx);
            pg8::EpiMerge E{GT, MG};
            pg8::gemm_phase<pg8::ProbMerge, pg8::EpiMerge, pg8::StaticOrder<3>, true, true>(ldsl, P, S, E);
        }
#endif
        GSYNC();
        TSTAMP(7);

#if (PHM >> 4) & 1
        {
        unsigned char* wsl = ws; asm volatile("" : "+s"(wsl));     float* SSQ_MIX = (float*)(wsl + WS_SSQ_MIX); float* SSQ_FFN = (float*)(wsl + WS_SSQ_FFN); float* LOGF = (float*)(wsl + WS_LOGF); bf16* XB = (bf16*)(wsl + WS_XB); bf16* QO = (bf16*)(wsl + WS_Q); bf16* KB = (bf16*)(wsl + WS_K); bf16* VB = (bf16*)(wsl + WS_V); bf16* MG = KB; bf16* CP = (bf16*)(wsl + WS_CP); bf16* GT = (bf16*)(wsl + WS_G); bf16* ACT = GT; unsigned* barw = (unsigned*)(wsl + WS_BAR); unsigned char* wb = wsl + WS_W + (size_t)par * W_PAR; const float* ssq_mix = SSQ_MIX; float* ssq_ffn = SSQ_FFN; float* ssq_nextmix = (l + 1 < NLAYER) ? SSQ_MIX : nullptr; (void)LOGF; (void)XB; (void)QO; (void)VB; (void)MG; (void)CP; (void)ACT; (void)barw; (void)wb; (void)ssq_mix; (void)ssq_ffn; (void)ssq_nextmix;
            pg8::ProbSimple P{(const char*)MG, (const char*)(wb + W_WO), 1024, 1024, 16}; pg8::StaticOrder<1> S; S.init(MTOK, 1024, G, bx);
            pg8::EpiResid E{nullptr, XB, ssq_ffn};
            pg8::gemm_phase<pg8::ProbSimple, pg8::EpiResid, pg8::StaticOrder<1>, true, true>(ldsl, P, S, E);
        }
#endif
        GSYNC();
        TSTAMP(8);

#if (PHM >> 5) & 1
        {
        unsigned char* wsl = ws; asm volatile("" : "+s"(wsl));     float* SSQ_MIX = (float*)(wsl + WS_SSQ_MIX); float* SSQ_FFN = (float*)(wsl + WS_SSQ_FFN); float* LOGF = (float*)(wsl + WS_LOGF); bf16* XB = (bf16*)(wsl + WS_XB); bf16* QO = (bf16*)(wsl + WS_Q); bf16* KB = (bf16*)(wsl + WS_K); bf16* VB = (bf16*)(wsl + WS_V); bf16* MG = KB; bf16* CP = (bf16*)(wsl + WS_CP); bf16* GT = (bf16*)(wsl + WS_G); bf16* ACT = GT; unsigned* barw = (unsigned*)(wsl + WS_BAR); unsigned char* wb = wsl + WS_W + (size_t)par * W_PAR; const float* ssq_mix = SSQ_MIX; float* ssq_ffn = SSQ_FFN; float* ssq_nextmix = (l + 1 < NLAYER) ? SSQ_MIX : nullptr; (void)LOGF; (void)XB; (void)QO; (void)VB; (void)MG; (void)CP; (void)ACT; (void)barw; (void)wb; (void)ssq_mix; (void)ssq_ffn; (void)ssq_nextmix;
            pg8::ProbSimple P{(const char*)XB, (const char*)(wb + W_WFI), 1024, 1024, 16}; pg8::StaticOrder<1> S; S.init(MTOK, 2 * DFF, G, bx);
            build_row_scales(ldsl, S, ssq_ffn, opaque_i(tid));
            pg8::EpiSwiGLU E{(const LAS float*)(ldsl + RS_OFF), ACT};
            pg8::gemm_phase<pg8::ProbSimple, pg8::EpiSwiGLU, pg8::StaticOrder<1>, true, true>(ldsl, P, S, E);
        }
#endif
        GSYNC();
        TSTAMP(9);

#if (PHM >> 6) & 1
        {
        unsigned char* wsl = ws; asm volatile("" : "+s"(wsl));     float* SSQ_MIX = (float*)(wsl + WS_SSQ_MIX); float* SSQ_FFN = (float*)(wsl + WS_SSQ_FFN); float* LOGF = (float*)(wsl + WS_LOGF); bf16* XB = (bf16*)(wsl + WS_XB); bf16* QO = (bf16*)(wsl + WS_Q); bf16* KB = (bf16*)(wsl + WS_K); bf16* VB = (bf16*)(wsl + WS_V); bf16* MG = KB; bf16* CP = (bf16*)(wsl + WS_CP); bf16* GT = (bf16*)(wsl + WS_G); bf16* ACT = GT; unsigned* barw = (unsigned*)(wsl + WS_BAR); unsigned char* wb = wsl + WS_W + (size_t)par * W_PAR; const float* ssq_mix = SSQ_MIX; float* ssq_ffn = SSQ_FFN; float* ssq_nextmix = (l + 1 < NLAYER) ? SSQ_MIX : nullptr; (void)LOGF; (void)XB; (void)QO; (void)VB; (void)MG; (void)CP; (void)ACT; (void)barw; (void)wb; (void)ssq_mix; (void)ssq_ffn; (void)ssq_nextmix;
            pg8::ProbSimple P{(const char*)ACT, (const char*)(wb + W_WFO), DFF, DFF, DFF / 64}; pg8::StaticOrder<1> S; S.init(MTOK, 1024, G, bx);
            pg8::EpiResid E{(l + 1 < NLAYER) ? nullptr : out, XB, ssq_nextmix};
            pg8::gemm_phase<pg8::ProbSimple, pg8::EpiResid, pg8::StaticOrder<1>, true, true>(ldsl, P, S, E);
        }
#endif
        if (l + 1 < NLAYER) GSYNC();
        TSTAMP(10);
    }
#ifdef PROBE
    GSYNC();
    if (bx == 0 && tid == 0) out[0] += (float)TACC[PROBE] * 0.0005f;
#endif
}

extern "C" void kernel_launch(void* const* d_in, const int* in_sizes, int n_in, void* d_out, int out_size, void* d_ws, size_t ws_size, hipStream_t stream) {
    static int grid = 0;
    if (grid == 0) {
        if (n_in != 15 || out_size != MTOK * DMODEL || ws_size < WS_END) { fprintf(stderr, "kernel_launch: unexpected shapes (n_in %d out %d ws %zu)\n", n_in, out_size, ws_size); grid = -1; return; }
        int dev = 0, cus = 0, per_cu = 0;
        hipGetDevice(&dev); hipDeviceGetAttribute(&cus, hipDeviceAttributeMultiprocessorCount, dev);
        if (hipFuncSetAttribute((const void*)fwd_kernel, hipFuncAttributeMaxDynamicSharedMemorySize, LDS_BYTES) != hipSuccess) { fprintf(stderr, "kernel_launch: hipFuncSetAttribute failed\n"); grid = -1; return; }
        if (hipOccupancyMaxActiveBlocksPerMultiprocessor(&per_cu, (const void*)fwd_kernel, NWAVES * 64, LDS_BYTES) != hipSuccess || per_cu < 1) { fprintf(stderr, "kernel_launch: occupancy query says %d\n", per_cu); per_cu = 1; }
        (void)hipGetLastError();
        grid = cus;
        if (grid != 256) fprintf(stderr, "kernel_launch: %d CUs (built for 256)\n", grid);
    }
    if (grid < 0) return;
    (void)hipMemsetAsync((char*)d_ws + WS_BAR, 0, (4096 + 4 * 64) * 4, stream);
    Args a{};
    for (int i = 0; i < 15; ++i) a.in[i] = (const float*)d_in[i];
    a.out = (float*)d_out; a.ws = (unsigned char*)d_ws;
    void* kargs[] = {&a};
    hipError_t e = hipLaunchCooperativeKernel((const void*)fwd_kernel, dim3(grid), dim3(NWAVES * 64), kargs, LDS_BYTES, stream);
    if (e != hipSuccess) fprintf(stderr, "cooperative launch failed: %s (grid %d)\n", hipGetErrorString(e), grid);
}
```
